# Optimizing an MI355X kernel written in HIP

```python
import math
import jax
import jax.numpy as jnp
from jax import lax
import numpy as np

D_MODEL = 2048
BATCH = 2
SEQ = 16384
DEPTH = 1

ATT_HEADS = 8
ATT_HEAD_DIM = 128
ATT_WIDTH = ATT_HEADS * ATT_HEAD_DIM
DILATED_BRANCHES = ((128, 1), (512, 4), (2048, 16))
BAND_BLOCK = 128
ROPE_THETA = 500000.0
ROPE_DIM = ATT_HEAD_DIM // 4
ML_HEADS = 4
ML_QK_DIM = 128
ML_V_DIM = 256
ML_QK_WIDTH = ML_HEADS * ML_QK_DIM
ML_V_WIDTH = ML_HEADS * ML_V_DIM
ML_CHUNK = 128
ML_CONV = 4
ML_F_BIAS = 3.0
MIX_WIDTH = ATT_WIDTH + ML_V_WIDTH
SPLITS = (ATT_WIDTH, ATT_WIDTH, ATT_WIDTH, ML_QK_WIDTH, ML_QK_WIDTH, ML_V_WIDTH, ML_V_WIDTH, ML_HEADS, ML_HEADS)
IN_WIDTH = sum(SPLITS)
SPLIT_POINTS = [int(s) for s in np.cumsum(SPLITS)[:-1]]
N_EXPERTS = 32
TOP_K = 4
D_FF = D_MODEL
SWIGLU_ALPHA = 1.702
SWIGLU_LIMIT = 7.0
MOE_ROWS = 512
NORM_EPS = 1e-6

kernel_name = "hybrid_dilated_attn_mlstm_moe"


def rms_norm(x, g):
    xf = x.astype(jnp.float32)
    y = xf * lax.rsqrt(jnp.mean(xf * xf, axis=-1, keepdims=True) + NORM_EPS)
    return y * g.astype(jnp.float32)


def partial_rope(x, pos):
    half = ROPE_DIM // 2
    inv = ROPE_THETA ** (-jnp.arange(half, dtype=jnp.float32) * 2.0 / ROPE_DIM)
    ang = pos[:, None] * inv[None, :]
    cos = jnp.cos(ang)[None, :, None, :]
    sin = jnp.sin(ang)[None, :, None, :]
    x1 = x[..., :half]
    x2 = x[..., half:ROPE_DIM]
    return jnp.concatenate([x1 * cos - x2 * sin, x2 * cos + x1 * sin, x[..., ROPE_DIM:]], axis=-1)


def dilated_branch(q, k, v, window, dilation):
    n_w = window // dilation
    assert n_w <= BAND_BLOCK
    B, S, H, E = q.shape
    seg = dilation * BAND_BLOCK
    Sp = -(-S // seg) * seg
    nb = Sp // seg
    pad = ((0, 0), (0, Sp - S), (0, 0), (0, 0))

    def split(t):
        return jnp.pad(t, pad).reshape(B, nb, BAND_BLOCK, dilation, H, E)

    def with_prev(t):
        prev = jnp.pad(t[:, :-1], ((0, 0), (1, 0), (0, 0), (0, 0), (0, 0), (0, 0)))
        return jnp.concatenate([prev, t], axis=2)

    qb = split(q)
    kk = with_prev(split(k))
    vv = with_prev(split(v))
    s = jnp.einsum('bnirhe,bnjrhe->bnrhij', qb, kk) / math.sqrt(E)
    i = jnp.arange(BAND_BLOCK)[:, None]
    j = jnp.arange(2 * BAND_BLOCK)[None, :]
    dist = BAND_BLOCK + i - j
    blk = jnp.arange(nb)[:, None, None]
    valid = (dist >= 0) & (dist <= n_w) & ((blk > 0) | (j >= BAND_BLOCK))
    s = jnp.where(valid[None, :, None, None], s, -jnp.inf)
    m = jnp.max(s, axis=-1, keepdims=True)
    p = jnp.exp(s - m)
    l = jnp.sum(p, axis=-1, keepdims=True)
    o = jnp.einsum('bnrhij,bnjrhe->bnirhe', p / l, vv).reshape(B, Sp, H, E)[:, :S]
    lse = (m + jnp.log(l))[..., 0]
    lse = lse.transpose(0, 1, 4, 2, 3).reshape(B, Sp, H)[:, :S]
    return o, lse


def dilated_attention(q, k, v):
    outs, lses = [], []
    for window, dilation in DILATED_BRANCHES:
        o, lse = dilated_branch(q, k, v, window, dilation)
        outs.append(o)
        lses.append(lse)
    w = jax.nn.softmax(jnp.stack(lses, axis=0), axis=0)
    return jnp.sum(w[..., None] * jnp.stack(outs, axis=0), axis=0)


def causal_conv(x, w, b):
    C = x.shape[-1]
    out = lax.conv_general_dilated(x, w.astype(x.dtype)[:, None, :], window_strides=(1,),
                                   padding=((ML_CONV - 1, 0),),
                                   dimension_numbers=('NWC', 'WIO', 'NWC'),
                                   feature_group_count=C)
    return out + b.astype(x.dtype)


def mlstm_chunkwise(q, k, v, ig, fg):
    B, S, H, DK = q.shape
    DV = v.shape[-1]
    L = ML_CHUNK
    NC = S // L

    def chunk(t):
        return t.reshape(B, NC, L, H, -1).transpose(0, 3, 1, 2, 4)

    q = chunk(q)
    k = chunk(k) / math.sqrt(DK)
    v = chunk(v)
    ig = ig.reshape(B, NC, L, H).transpose(0, 3, 1, 2)
    logf = jax.nn.log_sigmoid(fg.reshape(B, NC, L, H).transpose(0, 3, 1, 2))
    b = jnp.cumsum(logf, axis=-1)
    g = b[..., -1]
    a = g[..., None] - b + ig
    m_loc = jnp.max(a, axis=-1)
    wk = jnp.exp(a - m_loc[..., None])
    c_loc = jnp.einsum('bhcsk,bhcsv->bhckv', wk[..., None] * k, v)
    n_loc = jnp.einsum('bhcs,bhcsk->bhck', wk, k)

    def step(carry, inp):
        c, n, m = carry
        g_c, m_l, c_l, n_l = inp
        m_new = jnp.maximum(g_c + m, m_l)
        d_old = jnp.exp(g_c + m - m_new)
        d_new = jnp.exp(m_l - m_new)
        c2 = d_old[..., None, None] * c + d_new[..., None, None] * c_l
        n2 = d_old[..., None] * n + d_new[..., None] * n_l
        return (c2, n2, m_new), (c, n, m)

    init = (jnp.zeros((B, H, DK, DV), jnp.float32), jnp.zeros((B, H, DK), jnp.float32),
            jnp.zeros((B, H), jnp.float32))
    xs = (jnp.moveaxis(g, 2, 0), jnp.moveaxis(m_loc, 2, 0), jnp.moveaxis(c_loc, 2, 0),
          jnp.moveaxis(n_loc, 2, 0))
    _, (c_prev, n_prev, m_prev) = lax.scan(step, init, xs)
    c_prev = jnp.moveaxis(c_prev, 0, 2)
    n_prev = jnp.moveaxis(n_prev, 0, 2)
    m_prev = jnp.moveaxis(m_prev, 0, 2)

    causal = jnp.tril(jnp.ones((L, L), dtype=bool))
    dmat = jnp.where(causal, b[..., :, None] - b[..., None, :] + ig[..., None, :], -jnp.inf)
    inter = b + m_prev[..., None]
    m_t = jnp.maximum(inter, jnp.max(dmat, axis=-1))
    pw = jnp.exp(dmat - m_t[..., None]) * jnp.einsum('bhctk,bhcsk->bhcts', q, k)
    wi = jnp.exp(inter - m_t)
    num = wi[..., None] * jnp.einsum('bhctk,bhckv->bhctv', q, c_prev) + jnp.einsum('bhcts,bhcsv->bhctv', pw, v)
    den = wi * jnp.einsum('bhctk,bhck->bhct', q, n_prev) + jnp.sum(pw, axis=-1)
    h = num / jnp.maximum(jnp.abs(den), jnp.exp(-m_t))[..., None]
    return h.transpose(0, 2, 3, 1, 4).reshape(B, S, H, DV)


def moe_ffn(xf, router_w, router_b, w_up, b_up, w_down, b_down):
    N, D = xf.shape
    R = MOE_ROWS
    logits = xf.astype(jnp.float32) @ router_w.astype(jnp.float32) + router_b.astype(jnp.float32)
    vals, idx = lax.top_k(logits, TOP_K)
    gates = jax.nn.softmax(vals, axis=-1)
    e_flat = idx.reshape(-1).astype(jnp.int32)
    tok_flat = (jnp.arange(N * TOP_K, dtype=jnp.int32) // TOP_K)
    w_flat = gates.reshape(-1)
    order = jnp.argsort(e_flat, stable=True)
    e_s = e_flat[order]
    tok_s = tok_flat[order]
    w_s = w_flat[order]
    counts = jnp.bincount(e_flat, length=N_EXPERTS)
    start = jnp.cumsum(counts) - counts
    pcounts = (counts + R - 1) // R * R
    pend = jnp.cumsum(pcounts)
    pstart = pend - pcounts
    rank = jnp.arange(N * TOP_K, dtype=jnp.int32) - start[e_s]
    dest = pstart[e_s] + rank
    NB = -(-(N * TOP_K) // R) + N_EXPERTS
    row_tok = jnp.full((NB * R,), N, dtype=jnp.int32).at[dest].set(tok_s)
    row_w = jnp.zeros((NB * R,), jnp.float32).at[dest].set(w_s)
    blk_e = jnp.minimum(jnp.searchsorted(pend, jnp.arange(NB) * R, side='right'), N_EXPERTS - 1).astype(jnp.int32)
    x_pad = jnp.concatenate([xf, jnp.zeros((1, D), xf.dtype)], axis=0)

    def step(acc, inp):
        toks, ws, e = inp
        h = x_pad[toks] @ w_up[e] + b_up[e]
        glu = jnp.minimum(h[:, ::2].astype(jnp.float32), SWIGLU_LIMIT)
        lin = jnp.clip(h[:, 1::2].astype(jnp.float32), -SWIGLU_LIMIT, SWIGLU_LIMIT)
        act = (glu * jax.nn.sigmoid(SWIGLU_ALPHA * glu) * (lin + 1.0)).astype(xf.dtype)
        y = (act @ w_down[e] + b_down[e]).astype(jnp.float32)
        return acc.at[toks].add(y * ws[:, None]), None

    acc, _ = lax.scan(step, jnp.zeros((N + 1, D), jnp.float32),
                      (row_tok.reshape(NB, R), row_w.reshape(NB, R), blk_e))
    return acc[:N]


def setup_inputs(seed: int = 0) -> dict:
    key = jax.random.key(seed)
    ks = jax.random.split(key, 20)
    f32 = jnp.float32
    nrm = lambda k, s: jax.random.normal(k, s, f32)
    return {
        "x": nrm(ks[0], (BATCH, SEQ, D_MODEL)),
        "attn_norm_g": 1.0 + 0.02 * nrm(ks[1], (DEPTH, D_MODEL)),
        "w_in": nrm(ks[2], (DEPTH, D_MODEL, IN_WIDTH)) * D_MODEL ** -0.5,
        "q_norm_g": 1.0 + 0.02 * nrm(ks[3], (DEPTH, ATT_HEAD_DIM)),
        "k_norm_g": 1.0 + 0.02 * nrm(ks[4], (DEPTH, ATT_HEAD_DIM)),
        "ml_conv_w": nrm(ks[5], (DEPTH, ML_CONV, 2 * ML_QK_WIDTH)) * ML_CONV ** -0.5,
        "ml_conv_b": 0.01 * nrm(ks[6], (DEPTH, 2 * ML_QK_WIDTH)),
        "ml_i_b": 0.1 * nrm(ks[7], (DEPTH, ML_HEADS)),
        "ml_f_b": ML_F_BIAS + 0.1 * nrm(ks[8], (DEPTH, ML_HEADS)),
        "ml_out_norm_g": 1.0 + 0.02 * nrm(ks[9], (DEPTH, ML_V_WIDTH)),
        "w_out": nrm(ks[10], (DEPTH, MIX_WIDTH, D_MODEL)) * MIX_WIDTH ** -0.5,
        "ffn_norm_g": 1.0 + 0.02 * nrm(ks[11], (DEPTH, D_MODEL)),
        "router_w": nrm(ks[12], (DEPTH, D_MODEL, N_EXPERTS)) * D_MODEL ** -0.5,
        "router_b": 0.01 * nrm(ks[13], (DEPTH, N_EXPERTS)),
        "w_up": nrm(ks[14], (DEPTH, N_EXPERTS, D_MODEL, 2 * D_FF)) * D_MODEL ** -0.5,
        "b_up": 0.01 * nrm(ks[15], (DEPTH, N_EXPERTS, 2 * D_FF)),
        "w_down": nrm(ks[16], (DEPTH, N_EXPERTS, D_FF, D_MODEL)) * D_FF ** -0.5,
        "b_down": 0.01 * nrm(ks[17], (DEPTH, N_EXPERTS, D_MODEL)),
    }


def reference(x, attn_norm_g, w_in, q_norm_g, k_norm_g, ml_conv_w, ml_conv_b, ml_i_b, ml_f_b,
              ml_out_norm_g, w_out, ffn_norm_g, router_w, router_b, w_up, b_up, w_down, b_down):
    B, S, D = x.shape
    pos = jnp.arange(S, dtype=jnp.float32)
    for l in range(DEPTH):
        h = rms_norm(x, attn_norm_g[l]).astype(x.dtype)
        proj = h @ w_in[l]
        aq, ak, av, mq, mk, mv, mo, mi, mf = jnp.split(proj, SPLIT_POINTS, axis=-1)
        aq = partial_rope(rms_norm(aq.reshape(B, S, ATT_HEADS, ATT_HEAD_DIM), q_norm_g[l]), pos)
        ak = partial_rope(rms_norm(ak.reshape(B, S, ATT_HEADS, ATT_HEAD_DIM), k_norm_g[l]), pos)
        av = av.astype(jnp.float32).reshape(B, S, ATT_HEADS, ATT_HEAD_DIM)
        att = dilated_attention(aq, ak, av).reshape(B, S, ATT_WIDTH)
        qk = jax.nn.silu(causal_conv(jnp.concatenate([mq, mk], axis=-1).astype(jnp.float32),
                                     ml_conv_w[l], ml_conv_b[l]))
        mq = qk[..., :ML_QK_WIDTH].reshape(B, S, ML_HEADS, ML_QK_DIM)
        mk = qk[..., ML_QK_WIDTH:].reshape(B, S, ML_HEADS, ML_QK_DIM)
        mv = mv.astype(jnp.float32).reshape(B, S, ML_HEADS, ML_V_DIM)
        ig = mi.astype(jnp.float32) + ml_i_b[l].astype(jnp.float32)
        fg = mf.astype(jnp.float32) + ml_f_b[l].astype(jnp.float32)
        hm = mlstm_chunkwise(mq, mk, mv, ig, fg)
        hm = rms_norm(hm, ml_out_norm_g[l].reshape(ML_HEADS, ML_V_DIM))
        hm = hm * jax.nn.sigmoid(mo.astype(jnp.float32)).reshape(B, S, ML_HEADS, ML_V_DIM)
        mix = jnp.concatenate([att, hm.reshape(B, S, ML_V_WIDTH)], axis=-1).astype(x.dtype)
        x = x + mix @ w_out[l]
        h2 = rms_norm(x, ffn_norm_g[l]).astype(x.dtype)
        y = moe_ffn(h2.reshape(B * S, D), router_w[l], router_b[l], w_up[l], b_up[l], w_down[l], b_down[l])
        x = x + y.reshape(B, S, D).astype(x.dtype)
    return x
```

```cpp
#include <hip/hip_runtime.h>
#include <cstdio>
#include <cstdint>

#ifndef N_LAUNCHES
#define N_LAUNCHES 1
#endif
#ifndef PH_STOP
#define PH_STOP 12
#endif

#define DI __device__ __forceinline__
#define GAS __attribute__((address_space(1)))
#define LAS __attribute__((address_space(3)))
typedef unsigned short bf16;
typedef short bf16x8 __attribute__((ext_vector_type(8)));
typedef short s16x4 __attribute__((ext_vector_type(4)));
typedef float f32x4 __attribute__((ext_vector_type(4)));
typedef float f32x2 __attribute__((ext_vector_type(2)));
typedef float f32x16 __attribute__((ext_vector_type(16)));
typedef unsigned u32x4 __attribute__((ext_vector_type(4)));
typedef unsigned u32x2 __attribute__((ext_vector_type(2)));
typedef __bf16 bf16x2_t __attribute__((ext_vector_type(2)));
typedef GAS unsigned gu32;

constexpr int SEQ = 16384, NBATCH = 2, NTOK = NBATCH * SEQ, DM = 2048, NPROJ = 6144, INW = 6152;
constexpr int COL_AQ = 0, COL_AK = 1024, COL_AV = 2048, COL_MQ = 3072, COL_MK = 3584, COL_MV = 4096, COL_MO = 5120;
constexpr int NE = 32, FF = 2048, UPW = 4096;
constexpr int MAXRT = 544, MAXSLOT = MAXRT * 256;
constexpr int NCH = 128;
constexpr float EPS = 1e-6f;
constexpr float QSCALE = 0.08838834764831845f;

constexpr size_t MiB = 1u << 20;
constexpr size_t WS_CTL = 0, CTL_ZERO_BYTES = 1 * MiB;
constexpr size_t WS_WIN = 2 * MiB;
constexpr size_t WS_WOUT = 26 * MiB;
constexpr size_t WS_RWT = 34 * MiB;
constexpr size_t WS_GATES = 35 * MiB;
constexpr size_t WS_SMALL = 36 * MiB;
constexpr size_t WS_WUP = 64 * MiB;
constexpr size_t WS_WDN = 576 * MiB;
constexpr size_t WS_XN = 832 * MiB;
constexpr size_t WS_PROJ = 960 * MiB;
constexpr size_t WS_QC = 1344 * MiB;
constexpr size_t WS_KC = 1376 * MiB;
constexpr size_t WS_CLOC = 1408 * MiB;
constexpr size_t WS_CPREV = 1536 * MiB;
constexpr size_t WS_OST = 1600 * MiB;
constexpr size_t WS_ML = 1728 * MiB;
constexpr size_t WS_MIX = 1732 * MiB;
constexpr size_t WS_ACT = 1860 * MiB;
constexpr size_t WS_YB = 2404 * MiB;
constexpr size_t WS_HM = WS_YB + 272 * MiB;
constexpr size_t HM_PLANE = (size_t)NTOK * 1024;
constexpr size_t WS_END = 2948 * MiB;
constexpr size_t SM_NLOC = 0;
constexpr size_t SM_NPREV = 512 * 1024;
constexpr size_t SM_G = 1024 * 1024;
constexpr size_t SM_MLOC = SM_G + 4096;
constexpr size_t SM_MPREV = SM_MLOC + 4096;
constexpr size_t SM_TOPI = SM_MPREV + 4096;
constexpr size_t SM_TOPW = SM_TOPI + 512 * 1024;
constexpr size_t SM_HIST = SM_TOPW + 512 * 1024;
constexpr size_t SM_POS = SM_HIST + 128 * 1024;
constexpr size_t SM_ROWTOK = SM_POS + 512 * 1024;
constexpr size_t SM_ROWW = SM_ROWTOK + 544 * 1024;
constexpr size_t SM_TILEE = SM_ROWW + 544 * 1024;
constexpr size_t SM_RSTD = SM_TILEE + 4096;
constexpr size_t SM_ROWS = SM_RSTD + 128 * 1024;
constexpr size_t SM_ROPE = SM_ROWS + 544 * 1024;
static_assert(SM_ROPE + 2 * MiB <= 16 * MiB, "small tables (WS_SMALL .. WS_WUP is 28 MiB)");
constexpr size_t CTL_HIST = 256 * 1024;
constexpr int CW_BAR = 4096, CW_SUB = 8192;

constexpr int RING_BYTES = 131072, MISC_OFF = RING_BYTES, ESTASH_OFF = MISC_OFF + 16384, LDS_BYTES = ESTASH_OFF + 8 * 768 + 64;
constexpr int NWAVES = 8, NTHR = 512;

DI unsigned cvtpk(float lo, float hi) { f32x2 v = {lo, hi}; bf16x2_t b = __builtin_convertvector(v, bf16x2_t); return __builtin_bit_cast(unsigned, b); }
DI unsigned pk4_fp8(float a, float b, float c, float d) {
    a = fminf(fmaxf(a, -448.f), 448.f); b = fminf(fmaxf(b, -448.f), 448.f); c = fminf(fmaxf(c, -448.f), 448.f); d = fminf(fmaxf(d, -448.f), 448.f);
    int v = __builtin_amdgcn_cvt_pk_fp8_f32(a, b, 0, false); v = __builtin_amdgcn_cvt_pk_fp8_f32(c, d, v, true); return (unsigned)v; }
DI unsigned pk4_fp8m(float a, float b, float c, float d) {
    a = __builtin_amdgcn_fmed3f(a, -448.f, 448.f); b = __builtin_amdgcn_fmed3f(b, -448.f, 448.f); c = __builtin_amdgcn_fmed3f(c, -448.f, 448.f); d = __builtin_amdgcn_fmed3f(d, -448.f, 448.f);
    int v = __builtin_amdgcn_cvt_pk_fp8_f32(a, b, 0, false); v = __builtin_amdgcn_cvt_pk_fp8_f32(c, d, v, true); return (unsigned)v; }
DI void swap32(u32x2& a, u32x2& b) {
    const auto r0 = __builtin_amdgcn_permlane32_swap(a.x, b.x, false, false); const auto r1 = __builtin_amdgcn_permlane32_swap(a.y, b.y, false, false);
    a.x = r0[0]; b.x = r0[1]; a.y = r1[0]; b.y = r1[1]; }
DI float bf2f(unsigned short b) { return __uint_as_float(((unsigned)b) << 16); }
DI float wave_sum(float v) {
#pragma unroll
    for (int o = 1; o < 64; o <<= 1) v += __shfl_xor(v, o);
    return v;
}
DI float wave_max(float v) {
#pragma unroll
    for (int o = 1; o < 64; o <<= 1) v = fmaxf(v, __shfl_xor(v, o));
    return v;
}
DI f32x16 mfma32(bf16x8 a, bf16x8 b, f32x16 c) { return __builtin_amdgcn_mfma_f32_32x32x16_bf16(a, b, c, 0, 0, 0); }
DI int crow(int reg, int h) { return (reg & 3) + 8 * (reg >> 2) + 4 * h; }
DI int img_off(int row, int ch) { return 256 * row + 16 * (ch ^ (((row & 3) << 2) | ((row >> 2) & 3))); }
typedef short v4i16_t __attribute__((ext_vector_type(4)));
DI s16x4 tr16(const LAS unsigned char* p) { return __builtin_bit_cast(s16x4, __builtin_amdgcn_ds_read_tr16_b64_v4i16((LAS v4i16_t*)p)); }
DI bf16x8 tr_frag(const LAS unsigned char* img, int r0a, int r0b, int cch, int q, int p) {
    const s16x4 lo = tr16(img + img_off(r0a + q, cch + (p >> 1)) + 8 * (p & 1));
    const s16x4 hi = tr16(img + img_off(r0b + q, cch + (p >> 1)) + 8 * (p & 1));
    return __builtin_shufflevector(lo, hi, 0, 1, 2, 3, 4, 5, 6, 7);
}
DI int tr_base(int rlane, int cch, int q, int p) { return img_off(rlane + q, cch + (p >> 1)) + 8 * (p & 1); }
DI bf16x8 tr_frag2(const LAS unsigned char* img, int ba, int bb, int off) { const s16x4 lo = tr16(img + ba + off), hi = tr16(img + bb + off); return __builtin_shufflevector(lo, hi, 0, 1, 2, 3, 4, 5, 6, 7); }
DI bf16x8 row_frag(const LAS unsigned char* img, int row, int ch) { return *(const LAS bf16x8*)(img + img_off(row, ch)); }
#define LDS_WAIT() asm volatile("s_waitcnt lgkmcnt(0)" ::: "memory")
#define VM_WAIT() asm volatile("s_waitcnt vmcnt(0)" ::: "memory")

#define XB_TMO      128
#define XB_XCNT(j)  (256  + 64 * (j))
#define XB_XSUB(j)  (1280 + 64 * (j))
#define XB_XGEN(j)  (2304 + 64 * (j))
#define XB_TOP      3328
#define XB_TOPGEN   3392
#define XCD_BAR_WORDS 3456
#define XB_SPIN_CAP (1u << 18)
DI unsigned xb_ld(unsigned* p)              { return __hip_atomic_load(p, __ATOMIC_RELAXED, __HIP_MEMORY_SCOPE_AGENT); }
DI unsigned xb_add(unsigned* p, unsigned v) { return __hip_atomic_fetch_add(p, v, __ATOMIC_RELAXED, __HIP_MEMORY_SCOPE_AGENT); }
DI unsigned xb_xcc_id() { return (unsigned)__builtin_amdgcn_s_getreg((3 << 11) | 20) & 0xFu; }
#define XB_SPIN(cond, bar) do { unsigned _sp = 0; while (cond) { __builtin_amdgcn_s_sleep(1); \
    if ((++_sp & 255u) == 0u) { if (xb_ld(&(bar)[XB_TMO])) break; if (_sp > XB_SPIN_CAP) { atomicAdd(&(bar)[XB_TMO], 1u); break; } } } } while (0)
struct XcdBarrier { unsigned* bar; unsigned x; volatile LAS unsigned* st; };
DI XcdBarrier xcd_barrier_post(unsigned* bar, volatile LAS unsigned* st) {
    XcdBarrier b; b.bar = bar; b.x = xb_xcc_id(); b.st = st;
    if (threadIdx.x == 0) (void)xb_add(&bar[XB_XCNT(b.x)], 1u);
    return b;
}
DI void xcd_barrier_complete(unsigned* bar, unsigned x, unsigned& nloc, unsigned& nx) {
    const unsigned G = gridDim.x * gridDim.y * gridDim.z;
    unsigned sum, cnt, mine, sp = 0u;
    for (;;) {
        sum = 0u; cnt = 0u; mine = 0u;
#pragma unroll
        for (unsigned j = 0; j < 16; ++j) { const unsigned c = xb_ld(&bar[XB_XCNT(j)]); sum += c; cnt += (c > 0u) ? 1u : 0u; mine = (j == x) ? c : mine; }
        if (sum == G) break;
        __builtin_amdgcn_s_sleep(1);
        if ((++sp & 255u) == 0u) { if (xb_ld(&bar[XB_TMO])) break; if (sp > XB_SPIN_CAP) { atomicAdd(&bar[XB_TMO], 1u); break; } }
    }
    nloc = mine > 0u ? mine : 1u; nx = cnt > 0u ? cnt : 1u;
}
DI void xcd_barrier(const XcdBarrier& b) {
    asm volatile("s_waitcnt vmcnt(0)" ::: "memory");
    __syncthreads();
    if (threadIdx.x == 0) {
        unsigned* bar = b.bar;
        __builtin_amdgcn_s_waitcnt(0);
        unsigned nloc = b.st[0], nx = b.st[1];
        if (nloc == 0u) { xcd_barrier_complete(bar, b.x, nloc, nx); b.st[0] = nloc; b.st[1] = nx; }
        const unsigned old = xb_add(&bar[XB_XSUB(b.x)], 1u);
        const unsigned gen = old / nloc;
        if (old + 1u == (gen + 1u) * nloc) {
            __builtin_amdgcn_fence(__ATOMIC_RELEASE, "agent");
            asm volatile("s_waitcnt vmcnt(0)" ::: "memory");
            const unsigned og = xb_add(&bar[XB_TOP], 1u);
            const unsigned tg = og / nx;
            if (og + 1u == (tg + 1u) * nx) xb_add(&bar[XB_TOPGEN], 1u);
            else XB_SPIN(xb_ld(&bar[XB_TOPGEN]) == tg, bar);
            __builtin_amdgcn_fence(__ATOMIC_ACQUIRE, "agent");
            xb_add(&bar[XB_XGEN(b.x)], 1u);
            asm volatile("s_waitcnt vmcnt(0)" ::: "memory");
        } else {
            XB_SPIN(xb_ld(&bar[XB_XGEN(b.x)]) == gen, bar);
            __builtin_amdgcn_fence(__ATOMIC_ACQUIRE, "agent");
            asm volatile("s_waitcnt vmcnt(0)" ::: "memory");
        }
    }
    __syncthreads();
}

struct Args { const float* in[18]; float* out; unsigned char* ws; int ph_lo, ph_hi; };
struct Frame {
    LAS unsigned char* lds; int tid, lane, wave, vcu, G;
    const float *x, *attn_g, *w_in, *qg, *kg, *conv_w, *conv_b, *i_b, *f_b, *mlout_g, *w_out, *ffn_g, *router_w, *router_b, *w_up, *b_up, *w_down, *b_down;
    float* out; unsigned char* ws;
};

namespace pg8 {
typedef int v8i32 __attribute__((ext_vector_type(8)));
constexpr int BM = 256, BK = 64, HALF = 128, HTB = HALF * BK * 2, STAGE_BYTES = 8 * HTB, NXCD = 8, WGM = 8;
DI int lds_byte(int r, int c) { const int st = (r >> 4) * 2 + (c >> 5), rr = r & 15, cc = c & 31, ob = rr * 64 + cc * 2; return st * 1024 + (ob ^ (((ob >> 9) & 1) << 5)); }
DI void stage_rc(int b, int& R, int& C) { const int st = b / 1024, sb = b % 1024, swz = sb ^ (((sb >> 9) & 1) << 5); R = (st >> 1) * 16 + swz / 64; C = (st & 1) * 32 + (swz % 64) / 2; }
DI int perm32(int rho) { const int n = rho >> 4, i = rho & 15; return 8 * (i >> 2) + 4 * n + (i & 3); }
DI const char* sptr(const char* p) { const unsigned long long v = (unsigned long long)p; const unsigned lo = __builtin_amdgcn_readfirstlane((unsigned)v), hi = __builtin_amdgcn_readfirstlane((unsigned)(v >> 32)); return (const char*)(((unsigned long long)hi << 32) | lo); }
struct Unit { int pm, pn, e; };
struct Gemm { const bf16* A; const bf16* Bt; int K; size_t estride; const int* rowtok; const LAS int* tile_e; LAS unsigned char* stash; LAS unsigned char* estash; };
struct StaticOrder {
    int nM, nN, nwg, G, c;
    DI void init(int nM_, int nN_, int G_, int c_) { nM = nM_; nN = nN_; nwg = nM * nN; G = G_; c = c_; }
    DI bool next(int i, Unit& u) const {
        const long L = (long)i * G + c; if (L >= nwg) return false;
        int wgid = (int)L; { const int q = nwg / NXCD, r = nwg % NXCD, xcd = wgid % NXCD, off = wgid / NXCD; wgid = (xcd < r ? xcd * (q + 1) : r * (q + 1) + (xcd - r) * q) + off; }
        const int nig = WGM * nN, gid = wgid / nig, fm = gid * WGM, gsz = (nM - fm) < WGM ? (nM - fm) : WGM;
        u.pm = fm + ((wgid % nig) % gsz); u.pn = (wgid % nig) / gsz; u.e = 0; return true;
    }
};
template <class Epi, bool GATHER, bool EXPERT, bool FP8>
DI void gemm_phase(LAS unsigned char* lds, const Gemm g, const StaticOrder& S, const Epi& E) {
    const int tid = threadIdx.x, wid = __builtin_amdgcn_readfirstlane(tid >> 6), lane = tid & 63, wr = wid >> 2, wc = wid & 3, fr = lane & 15, fq = lane >> 4;
    const int K = g.K, nt = K / BK;
    unsigned voffB[2], coffA[2][2];
    const size_t kstep = (size_t)(BK * 2), hstep = (size_t)HALF * K * 2, tstep = 2 * hstep;
#pragma unroll
    for (int i = 0; i < 2; ++i) { int R, C; stage_rc(tid * 16 + i * 8192, R, C); const int Rb = Epi::PERM ? ((R & ~31) + perm32(R & 31)) : R;
        voffB[i] = (unsigned)(Rb * K + C) * 2u; }
    const unsigned ldsw = (unsigned)wid * 1024u;
    const int aoff = lds_byte(wr * 64 + fr, fq * 8), boff = lds_byte(wc * 32 + fr, fq * 8);
#define PG8_SA(b, h) (((b) * 2 + (h)) * HTB)
#define PG8_SB(b, h) ((4 + (b) * 2 + (h)) * HTB)
#define PG8_GLDS(gp, lp) __builtin_amdgcn_global_load_lds((const unsigned*)(gp), (LAS unsigned*)(lp), 16, 0, 0)
#define PG8_OPQ(x) ({ unsigned o_ = (x); asm volatile("" : "+v"(o_)); o_; })
#define PG8_STAGE_B(bufoff, gbase) do { const char* sb_ = (const char*)(gbase); PG8_GLDS(sb_ + PG8_OPQ(voffB[0]), lds + (bufoff) + ldsw); PG8_GLDS(sb_ + PG8_OPQ(voffB[1]), lds + (bufoff) + ldsw + 8192); } while (0)
#define PG8_STAGE_A(bufoff, gbase, o0, o1) do { const char* sb_ = (const char*)(gbase); PG8_GLDS(sb_ + PG8_OPQ(o0), lds + (bufoff) + ldsw); PG8_GLDS(sb_ + PG8_OPQ(o1), lds + (bufoff) + ldsw + 8192); } while (0)
#define PG8_LDA(dst, b, h) do { _Pragma("unroll") for (int m = 0; m < 4; ++m) _Pragma("unroll") for (int k = 0; k < 2; ++k) dst[m][k] = *(const LAS bf16x8*)(lds + PG8_SA(b, h) + aoff + m * 2048 + k * 1024); } while (0)
#define PG8_LDB(dst, b, h) do { _Pragma("unroll") for (int n = 0; n < 2; ++n) _Pragma("unroll") for (int k = 0; k < 2; ++k) dst[n][k] = *(const LAS bf16x8*)(lds + PG8_SB(b, h) + boff + n * 2048 + k * 1024); } while (0)
#define PG8_CAT(x) __builtin_bit_cast(v8i32, __builtin_shufflevector(x[0], x[1], 0, 1, 2, 3, 4, 5, 6, 7, 8, 9, 10, 11, 12, 13, 14, 15))
#define PG8_MMA(ai, bj, At, Bt) do { __builtin_amdgcn_s_setprio(1); _Pragma("unroll") for (int m = 0; m < 4; ++m) _Pragma("unroll") for (int n = 0; n < 2; ++n) { \
        if (FP8) acc[ai][bj][m][n] = __builtin_amdgcn_mfma_scale_f32_16x16x128_f8f6f4(PG8_CAT(Bt[n]), PG8_CAT(At[m]), acc[ai][bj][m][n], 0, 0, 0, 0x7F7F7F7F, 0, 0x7F7F7F7F); \
        else { _Pragma("unroll") for (int k = 0; k < 2; ++k) acc[ai][bj][m][n] = __builtin_amdgcn_mfma_f32_16x16x32_bf16(Bt[n][k], At[m][k], acc[ai][bj][m][n], 0, 0, 0); } } \
        __builtin_amdgcn_s_setprio(0); \
        asm volatile("" : "+v"(acc[ai][bj][0][0]), "+v"(acc[ai][bj][0][1]), "+v"(acc[ai][bj][1][0]), "+v"(acc[ai][bj][1][1]), "+v"(acc[ai][bj][2][0]), "+v"(acc[ai][bj][2][1]), "+v"(acc[ai][bj][3][0]), "+v"(acc[ai][bj][3][1])); } while (0)
#define PG8_WAIT_V(n) asm volatile("s_waitcnt vmcnt(" #n ")" ::: "memory")
#define PG8_WAIT_L(n) asm volatile("s_waitcnt lgkmcnt(" #n ")" ::: "memory")
#define PG8_BAR __builtin_amdgcn_s_barrier()
#define PG8_SCHED __builtin_amdgcn_sched_barrier(0)
#define PG8_OFFS(dst, pm_) do { int t2_ = threadIdx.x; asm volatile("" : "+v"(t2_)); _Pragma("unroll") for (int i_ = 0; i_ < 2; ++i_) { int R_, C_; stage_rc(t2_ * 16 + i_ * 8192, R_, C_); \
        _Pragma("unroll") for (int h_ = 0; h_ < 2; ++h_) { \
        if (GATHER) dst[h_][i_] = (unsigned)g.rowtok[(pm_) * 256 + h_ * 128 + R_] * (unsigned)(K * 2) + (unsigned)(C_ * 2); \
        else dst[h_][i_] = (unsigned)((h_ * 128 + R_) * K + C_) * 2u; } } } while (0)
    Unit cur, nxt; int ui = 0;
    if (!S.next(0, cur)) return;
    if (EXPERT) cur.e = __builtin_amdgcn_readfirstlane(g.tile_e[cur.pm]);
    f32x4 acc[2][2][4][2];
#pragma unroll
    for (int a = 0; a < 2; ++a)
#pragma unroll
        for (int b = 0; b < 2; ++b)
#pragma unroll
            for (int m = 0; m < 4; ++m)
#pragma unroll
                for (int n = 0; n < 2; ++n) acc[a][b][m][n] = (f32x4){0.f, 0.f, 0.f, 0.f};
    bf16x8 At[4][2], B0[2][2], B1[2][2];
    PG8_OFFS(coffA, cur.pm);
    const char* cA = sptr((const char*)g.A + (GATHER ? (size_t)0 : (size_t)cur.pm * tstep));
    const char* cB = sptr((const char*)g.Bt + (size_t)cur.e * g.estride + (size_t)cur.pn * tstep);
    LAS unsigned char* est = g.estash + wid * 768;
    if (Epi::STASH) E.prefetch(cur, wr, wc, lane, est);
    LAS unsigned char* stash = g.stash + wid * 256;
    PG8_STAGE_B(PG8_SB(0, 0), cB); PG8_STAGE_B(PG8_SB(0, 1), cB + hstep); PG8_STAGE_A(PG8_SA(0, 0), cA, coffA[0][0], coffA[0][1]); PG8_STAGE_A(PG8_SA(0, 1), cA, coffA[1][0], coffA[1][1]);
    if (wr == 1) PG8_BAR;
    PG8_WAIT_V(2); PG8_BAR;
    PG8_STAGE_B(PG8_SB(1, 0), cB + kstep); PG8_STAGE_A(PG8_SA(1, 0), cA + kstep, coffA[0][0], coffA[0][1]); PG8_STAGE_B(PG8_SB(1, 1), cB + hstep + kstep);
    PG8_WAIT_V(6); PG8_BAR;
#define PG8_TRIP(a1, a2, b2, a3, b3, o00, o01, o10, o11) do { \
            PG8_LDB(B0, 0, 0); PG8_LDB(B1, 0, 1); PG8_SCHED; PG8_LDA(At, 0, 0); PG8_STAGE_A(PG8_SA(1, 1), a1, coffA[1][0], coffA[1][1]); \
            PG8_WAIT_V(8); PG8_WAIT_L(0); PG8_BAR; PG8_MMA(0, 0, At, B0); PG8_MMA(0, 1, At, B1); PG8_BAR; PG8_SCHED; \
            PG8_LDA(At, 0, 1); PG8_STAGE_B(PG8_SB(0, 0), b2); PG8_STAGE_B(PG8_SB(0, 1), (b2) + hstep); PG8_STAGE_A(PG8_SA(0, 0), a2, o00, o01); \
            PG8_WAIT_V(8); PG8_WAIT_L(0); PG8_BAR; PG8_MMA(1, 0, At, B0); PG8_MMA(1, 1, At, B1); PG8_BAR; PG8_SCHED; \
            PG8_LDB(B0, 1, 0); PG8_LDB(B1, 1, 1); PG8_SCHED; PG8_LDA(At, 1, 0); PG8_STAGE_A(PG8_SA(0, 1), a2, o10, o11); \
            PG8_WAIT_V(8); PG8_WAIT_L(0); PG8_BAR; PG8_MMA(0, 0, At, B0); PG8_MMA(0, 1, At, B1); PG8_BAR; PG8_SCHED; \
            PG8_LDA(At, 1, 1); PG8_STAGE_B(PG8_SB(1, 0), b3); PG8_STAGE_B(PG8_SB(1, 1), (b3) + hstep); PG8_STAGE_A(PG8_SA(1, 0), a3, o00, o01); \
            PG8_WAIT_V(8); PG8_WAIT_L(0); PG8_BAR; PG8_MMA(1, 0, At, B0); PG8_MMA(1, 1, At, B1); PG8_BAR; PG8_SCHED; } while (0)
    for (;;) {
        const bool has_next = S.next(ui + 1, nxt);
        if (EXPERT) nxt.e = has_next ? __builtin_amdgcn_readfirstlane(g.tile_e[nxt.pm]) : 0;
        const char* nA = sptr(has_next ? (const char*)g.A + (GATHER ? (size_t)0 : (size_t)nxt.pm * tstep) : cA);
        const char* nB = sptr(has_next ? (const char*)g.Bt + (size_t)nxt.e * g.estride + (size_t)nxt.pn * tstep : cB);
        if (GATHER && has_next) {
            int t2_ = threadIdx.x; asm volatile("" : "+v"(t2_));
#pragma unroll
            for (int i_ = 0; i_ < 2; ++i_) { int R_, C_; stage_rc(t2_ * 16 + i_ * 8192, R_, C_);
#pragma unroll
                for (int h_ = 0; h_ < 2; ++h_) __builtin_amdgcn_global_load_lds((const unsigned*)(g.rowtok + nxt.pm * 256 + h_ * 128 + R_), (LAS unsigned*)(stash + (h_ * 2 + i_) * 2048), 4, 0, 0); }
        }
        int C0x2 = 0, C1x2 = 0; const LAS unsigned* sp = nullptr;
        if (GATHER) { int t2_ = threadIdx.x; asm volatile("" : "+v"(t2_)); int R0_, C0_, R1_, C1_; stage_rc(t2_ * 16, R0_, C0_); stage_rc(t2_ * 16 + 8192, R1_, C1_); C0x2 = C0_ * 2; C1x2 = C1_ * 2;
            sp = (const LAS unsigned*)(stash + (t2_ & 63) * 4); }
#pragma unroll 1
        for (int t = 0; t < nt; t += 2) {
            const bool last = (t == nt - 2);
            const char* a1 = cA + (size_t)(t + 1) * kstep;
            const char* a2 = last ? nA : cA + (size_t)(t + 2) * kstep; const char* b2 = last ? nB : cB + (size_t)(t + 2) * kstep;
            const char* a3 = a2 + kstep; const char* b3 = b2 + kstep;
            unsigned o00 = coffA[0][0], o01 = coffA[0][1], o10 = coffA[1][0], o11 = coffA[1][1];
            if (GATHER && last && has_next) {
                o00 = sp[0] * (unsigned)(K * 2) + (unsigned)C0x2; o01 = sp[512] * (unsigned)(K * 2) + (unsigned)C1x2;
                o10 = sp[1024] * (unsigned)(K * 2) + (unsigned)C0x2; o11 = sp[1536] * (unsigned)(K * 2) + (unsigned)C1x2; }
            PG8_TRIP(a1, a2, b2, a3, b3, o00, o01, o10, o11);
            if (last) { coffA[0][0] = o00; coffA[0][1] = o01; coffA[1][0] = o10; coffA[1][1] = o11; }
        }
        if (wr == 0) PG8_BAR;
        { int l2 = threadIdx.x & 63; asm volatile("" : "+v"(l2)); E(acc, cur, wr, wc, l2 & 15, l2 >> 4, est); }
        if (!has_next) break;
#pragma unroll
        for (int a = 0; a < 2; ++a)
#pragma unroll
            for (int b = 0; b < 2; ++b)
#pragma unroll
                for (int m = 0; m < 4; ++m)
#pragma unroll
                    for (int n = 0; n < 2; ++n) acc[a][b][m][n] = (f32x4){0.f, 0.f, 0.f, 0.f};
        cur = nxt; cA = nA; cB = nB; ++ui;
        if (Epi::STASH) { int l2 = threadIdx.x & 63; asm volatile("" : "+v"(l2)); E.prefetch(cur, wr, wc, l2, est); }
        if (wr == 1) PG8_BAR;
    }
    PG8_WAIT_V(0);
    PG8_BAR;
#undef PG8_TRIP
#undef PG8_SA
#undef PG8_SB
#undef PG8_GLDS
#undef PG8_STAGE_A
#undef PG8_OPQ
#undef PG8_STAGE_B
#undef PG8_LDA
#undef PG8_LDB
#undef PG8_MMA
#undef PG8_CAT
#undef PG8_WAIT_V
#undef PG8_WAIT_L
#undef PG8_BAR
#undef PG8_SCHED
#undef PG8_OFFS
}

struct EpiProj {
    static constexpr bool PERM = true; static constexpr bool STASH = false;
    DI void prefetch(const Unit&, int, int, int, LAS unsigned char*) const {}
    bf16* O; int ldc; const float* qg; const float* kg; const float* rope; LAS float* P; bf16* HM;
    DI void operator()(const f32x4 (&acc)[2][2][4][2], const Unit& u, int wr, int wc, int fr, int fq, const LAS unsigned char* st) const {
        const int row0 = u.pm * BM + wr * 64 + fr, col0 = u.pn * BM + wc * 32 + 8 * fq;
        if (u.pn >= 8) {
#pragma unroll
            for (int ai = 0; ai < 2; ++ai)
#pragma unroll
                for (int m = 0; m < 4; ++m) { const int row = row0 + ai * HALF + m * 16; bf16* rowp = O + (size_t)row * ldc + col0;
                    if (u.pn < 12) rowp = HM + 2 * HM_PLANE + ((size_t)((row >> 14) * 8 + ((2 * u.pn) & 7)) * SEQ + (row & (SEQ - 1))) * 128 + wc * 32 + 8 * fq;
#pragma unroll
                    for (int bj = 0; bj < 2; ++bj) { const f32x4 v0 = acc[ai][bj][m][0], v1 = acc[ai][bj][m][1];
                        u32x4 w; w.x = cvtpk(v0[0], v0[1]); w.y = cvtpk(v0[2], v0[3]); w.z = cvtpk(v1[0], v1[1]); w.w = cvtpk(v1[2], v1[3]);
                        *(u32x4*)(rowp + (u.pn < 12 ? (size_t)bj * SEQ * 128 : (size_t)bj * HALF)) = w; } }
            return;
        }
#pragma unroll
        for (int ai = 0; ai < 2; ++ai)
#pragma unroll
            for (int m = 0; m < 4; ++m)
#pragma unroll
                for (int bj = 0; bj < 2; ++bj) { const f32x4 v0 = acc[ai][bj][m][0], v1 = acc[ai][bj][m][1];
                    float ss = (v0[0] * v0[0] + v0[1] * v0[1]) + (v0[2] * v0[2] + v0[3] * v0[3]) + (v1[0] * v1[0] + v1[1] * v1[1]) + (v1[2] * v1[2] + v1[3] * v1[3]);
                    ss += __shfl_xor(ss, 16); ss += __shfl_xor(ss, 32);
                    if (fq == 0) P[((ai * HALF + wr * 64 + m * 16 + fr) * 2 + bj) * 4 + wc] = ss; }
        asm volatile("s_waitcnt lgkmcnt(0)" ::: "memory"); __builtin_amdgcn_s_barrier(); asm volatile("" ::: "memory");
        const bool isk = u.pn >= 4; const float* gp = (isk ? kg : qg) + wc * 32 + 8 * fq; const float sc = isk ? 1.0f : QSCALE * 1.4426950408889634f;
        const f32x4 gA = *(const f32x4*)gp, gB = *(const f32x4*)(gp + 4);
#pragma unroll
        for (int ai = 0; ai < 2; ++ai)
#pragma unroll
            for (int m = 0; m < 4; ++m) { const int rl = ai * HALF + wr * 64 + m * 16 + fr; const int row = u.pm * BM + rl;
                bf16* rowp = HM + (isk ? HM_PLANE : (size_t)0) + ((size_t)((row >> 14) * 8 + ((2 * u.pn) & 7)) * SEQ + (row & (SEQ - 1))) * 128 + wc * 32 + 8 * fq;
                f32x4 cA = {1.f, 1.f, 1.f, 1.f}, cB = cA, sA = {0.f, 0.f, 0.f, 0.f}, sB = sA;
                if (wc == 0) { const float* tp = rope + (size_t)((u.pm * BM + rl) & (SEQ - 1)) * 32 + 8 * (fq & 1);
                    cA = *(const f32x4*)tp; cB = *(const f32x4*)(tp + 4); sA = *(const f32x4*)(tp + 16); sB = *(const f32x4*)(tp + 20); if (fq < 2) { sA = -sA; sB = -sB; } }
#pragma unroll
                for (int bj = 0; bj < 2; ++bj) { const f32x4 pp = *(const LAS f32x4*)(P + (rl * 2 + bj) * 4);
                    const float rstd = 1.0f / sqrtf(((pp[0] + pp[1]) + (pp[2] + pp[3])) * (1.f / 128.f) + EPS);
                    f32x4 y0 = acc[ai][bj][m][0] * rstd * gA, y1 = acc[ai][bj][m][1] * rstd * gB;
                    if (wc == 0) { f32x4 o0, o1;
#pragma unroll
                        for (int j = 0; j < 4; ++j) { o0[j] = __shfl_xor(y0[j], 32); o1[j] = __shfl_xor(y1[j], 32); }
                        y0 = y0 * cA + o0 * sA; y1 = y1 * cB + o1 * sB; }
                    y0 = y0 * sc; y1 = y1 * sc;
                    u32x4 w; w.x = cvtpk(y0[0], y0[1]); w.y = cvtpk(y0[2], y0[3]); w.z = cvtpk(y1[0], y1[1]); w.w = cvtpk(y1[2], y1[3]);
                    *(u32x4*)(rowp + (size_t)bj * SEQ * 128) = w; } }
    }
};
struct EpiResid {
    static constexpr bool PERM = false; static constexpr bool STASH = false;
    const float* base; float* C; int ldc;
    DI void prefetch(const Unit&, int, int, int, LAS unsigned char*) const {}
    DI void operator()(const f32x4 (&acc)[2][2][4][2], const Unit& u, int wr, int wc, int fr, int fq, const LAS unsigned char* st) const {
        const int row0 = u.pm * BM + wr * 64 + fr, col0 = u.pn * BM + wc * 32 + 4 * fq;
#pragma unroll
        for (int ai = 0; ai < 2; ++ai)
#pragma unroll
            for (int m = 0; m < 4; ++m) { const size_t off = (size_t)(row0 + ai * HALF + m * 16) * ldc + col0;
#pragma unroll
                for (int bj = 0; bj < 2; ++bj)
#pragma unroll
                    for (int n = 0; n < 2; ++n) { const f32x4 bs = *(const f32x4*)(base + off + bj * HALF + n * 16); *(f32x4*)(C + off + bj * HALF + n * 16) = bs + acc[ai][bj][m][n]; } }
    }
};
DI float swiglu4(float hg, float hl) {
    const float glu = fminf(hg, 7.0f), lin = __builtin_amdgcn_fmed3f(hl, -7.0f, 7.0f);
    const float sg = __builtin_amdgcn_rcpf(1.0f + __builtin_amdgcn_exp2f(glu * (-1.702f * 1.4426950408889634f)));
    return (glu * sg) * __builtin_fmaf(lin, 4.0f, 4.0f);
}
DI unsigned pk4_fp8n(float a, float b, float c, float d) { int v = __builtin_amdgcn_cvt_pk_fp8_f32(a, b, 0, false); v = __builtin_amdgcn_cvt_pk_fp8_f32(c, d, v, true); return (unsigned)v; }
DI u32x4 pair16(u32x2 a, u32x2 b) {
    const auto r0 = __builtin_amdgcn_permlane16_swap(a.x, b.x, false, false); const auto r1 = __builtin_amdgcn_permlane16_swap(a.y, b.y, false, false);
    u32x4 w; w.x = r0[0]; w.y = r1[0]; w.z = r0[1]; w.w = r1[1]; return w; }
#define PG8_DMA4(gp, lp) __builtin_amdgcn_global_load_lds((const unsigned*)(gp), (LAS unsigned*)(lp), 4, 0, 0)
struct EpiUp {
    static constexpr bool PERM = true; static constexpr bool STASH = true;
    unsigned char* ACT; const float* b_up; const float* rows;
    DI void prefetch(const Unit& u, int wr, int wc, int lane, LAS unsigned char* st) const {
        const float* rp = rows + u.pm * BM + wr * 64 + lane;
        PG8_DMA4(rp, st); PG8_DMA4(rp + HALF, st + 256);
        PG8_DMA4(b_up + (size_t)u.e * UPW + 2 * (u.pn * HALF + wc * 32) + lane, st + 512);
    }
    DI void operator()(const f32x4 (&acc)[2][2][4][2], const Unit& u, int wr, int wc, int fr, int fq, const LAS unsigned char* st) const {
        const int row0 = u.pm * BM + wr * 64 + fr, f0 = u.pn * HALF + wc * 32 + 8 * fq;
        f32x4 bb[4];
#pragma unroll
        for (int j = 0; j < 4; ++j) bb[j] = *(const LAS f32x4*)(st + 512 + fq * 64 + 16 * j);
#pragma unroll
        for (int ai = 0; ai < 2; ++ai)
#pragma unroll
            for (int mp = 0; mp < 2; ++mp) {
                u32x2 w2[2];
#pragma unroll
                for (int mm = 0; mm < 2; ++mm) { const int m = 2 * mp + mm; const float ws = *(const LAS float*)(st + ai * 256 + (m * 16 + fr) * 4) * (1.0f / 32.0f);
                    const f32x4 g0 = acc[ai][0][m][0], g1 = acc[ai][0][m][1], l0 = acc[ai][1][m][0], l1 = acc[ai][1][m][1];
#define UPV(gv, lv, bq, i) swiglu4(__builtin_fmaf(gv[i], ws, bb[bq][2 * ((i) & 1)]), __builtin_fmaf(lv[i], ws, bb[bq][2 * ((i) & 1) + 1]))
                    const float a0 = UPV(g0, l0, 0, 0), a1 = UPV(g0, l0, 0, 1), a2 = UPV(g0, l0, 1, 2), a3 = UPV(g0, l0, 1, 3);
                    const float a4 = UPV(g1, l1, 2, 0), a5 = UPV(g1, l1, 2, 1), a6 = UPV(g1, l1, 3, 2), a7 = UPV(g1, l1, 3, 3);
#undef UPV
                    w2[mm].x = pk4_fp8n(a0, a1, a2, a3); w2[mm].y = pk4_fp8n(a4, a5, a6, a7); }
                const u32x4 w = pair16(w2[0], w2[1]);
                *(u32x4*)(ACT + (size_t)(row0 + ai * HALF + (2 * mp + (fq & 1)) * 16) * FF + (f0 - 8 * (fq & 1))) = w; }
    }
};
struct EpiDown {
    static constexpr bool PERM = true; static constexpr bool STASH = true;
    unsigned char* YB; const float* b_down; const float* roww;
    DI void prefetch(const Unit& u, int wr, int wc, int lane, LAS unsigned char* st) const {
        const float* rp = roww + u.pm * BM + wr * 64 + lane;
        PG8_DMA4(rp, st); PG8_DMA4(rp + HALF, st + 256);
        PG8_DMA4(b_down + (size_t)u.e * DM + u.pn * BM + (lane >> 5) * HALF + wc * 32 + (lane & 31), st + 512);
    }
    DI void operator()(const f32x4 (&acc)[2][2][4][2], const Unit& u, int wr, int wc, int fr, int fq, const LAS unsigned char* st) const {
        const int row0 = u.pm * BM + wr * 64 + fr, col0 = u.pn * BM + wc * 32 + 8 * fq;
        f32x4 bv[2][2];
#pragma unroll
        for (int bj = 0; bj < 2; ++bj)
#pragma unroll
            for (int n = 0; n < 2; ++n) bv[bj][n] = *(const LAS f32x4*)(st + 512 + bj * 128 + fq * 32 + 16 * n);
#pragma unroll
        for (int ai = 0; ai < 2; ++ai)
#pragma unroll
            for (int mp = 0; mp < 2; ++mp) {
                const float wA = *(const LAS float*)(st + ai * 256 + ((2 * mp) * 16 + fr) * 4) * 16.0f, wB = *(const LAS float*)(st + ai * 256 + ((2 * mp + 1) * 16 + fr) * 4) * 16.0f;
                unsigned char* rowp = YB + (size_t)(row0 + ai * HALF + (2 * mp + (fq & 1)) * 16) * DM + (col0 - 8 * (fq & 1));
#pragma unroll
                for (int bj = 0; bj < 2; ++bj) { u32x2 w2[2];
#pragma unroll
                    for (int mm = 0; mm < 2; ++mm) { const int m = 2 * mp + mm; const float w8 = mm ? wB : wA;
                        const f32x4 v0 = (acc[ai][bj][m][0] * (1.0f / 128.0f) + bv[bj][0]) * w8, v1 = (acc[ai][bj][m][1] * (1.0f / 128.0f) + bv[bj][1]) * w8;
                        w2[mm].x = pk4_fp8m(v0[0], v0[1], v0[2], v0[3]); w2[mm].y = pk4_fp8m(v1[0], v1[1], v1[2], v1[3]); }
                    *(u32x4*)(rowp + bj * HALF) = pair16(w2[0], w2[1]); } }
    }
};
#undef PG8_DMA4
}

template <int MODE  >
DI void p0_tr_item(const float* W, int ld, bf16* WT, int K, int k0, int n0, LAS unsigned char* img, int lane) {
    const float* wp = W + (size_t)(k0 + (lane >> 5)) * ld + n0 + 4 * (lane & 31);
    const int ioff = img_off(lane >> 5, (lane & 31) >> 1) + (lane & 1) * 8;
#pragma unroll 1
    for (int bt = 0; bt < 4; ++bt) {
        f32x4 v[8];
#pragma unroll
        for (int i = 0; i < 8; ++i) v[i] = *(const f32x4*)(wp + (size_t)(2 * (8 * bt + i)) * ld);
#pragma unroll
        for (int i = 0; i < 8; ++i) { const int kk = 2 * (8 * bt + i) + (lane >> 5), n = 4 * (lane & 31);
            u32x2 pk; pk.x = cvtpk(v[i][0], v[i][1]); pk.y = cvtpk(v[i][2], v[i][3]);
            *(LAS u32x2*)(img + img_off(kk, n >> 3) + (n & 7) * 2) = pk; }
    }
    (void)ioff;
    LDS_WAIT();
    const int g = lane >> 4, i16 = lane & 15, q = i16 >> 2, p = i16 & 3;
#pragma unroll 4
    for (int step = 0; step < 16; ++step) { const int kc = 4 * (step & 1) + g, nb = step >> 1;
        const bf16x8 f = tr_frag(img, 8 * kc, 8 * kc + 4, 2 * nb, q, p);
        const int n = n0 + 16 * nb + i16; int row = n;
        if (MODE == 1) { const int ff = n >> 1; row = 256 * (ff >> 7) + 128 * (n & 1) + (ff & 127); }
        *(bf16x8*)(WT + (size_t)row * K + k0 + 8 * kc) = f; }
    LDS_WAIT();
}
DI float log_sigmoid(float x) { return fminf(x, 0.f) - log1pf(__expf(-fabsf(x))); }
DI void p0_prologue(Frame& F) {
    const int gw = F.vcu * NWAVES + F.wave, NGW = F.G * NWAVES;
    LAS float* lg = (LAS float*)F.lds;
    for (int idx = F.tid; idx < 8 * DM; idx += NTHR) { const int k = idx >> 3, c = idx & 7; lg[c * DM + k] = F.w_in[(size_t)k * INW + NPROJ + c]; }
    __syncthreads();
    bf16* XN = (bf16*)(F.ws + WS_XN); float* GATES = (float*)(F.ws + WS_GATES);
    for (int row = gw; row < NTOK; row += NGW) {
        const f32x4* xr = (const f32x4*)(F.x + (size_t)row * DM) + F.lane;
        f32x4 v[8]; float ss = 0.f;
#pragma unroll
        for (int j = 0; j < 8; ++j) { v[j] = xr[64 * j]; ss += (v[j][0] * v[j][0] + v[j][1] * v[j][1]) + (v[j][2] * v[j][2] + v[j][3] * v[j][3]); }
        const float rstd = 1.0f / sqrtf(wave_sum(ss) * (1.f / DM) + EPS);
        float ga[8];
#pragma unroll
        for (int c = 0; c < 8; ++c) ga[c] = 0.f;
        u32x2* o8 = (u32x2*)(XN + (size_t)row * DM) + F.lane;
#pragma unroll
        for (int j = 0; j < 8; ++j) { const f32x4 gn = ((const f32x4*)F.attn_g)[F.lane + 64 * j]; const f32x4 hh = v[j] * rstd * gn;
            u32x2 pk; pk.x = cvtpk(hh[0], hh[1]); pk.y = cvtpk(hh[2], hh[3]); o8[64 * j] = pk;
#pragma unroll
            for (int c = 0; c < 8; ++c) { const f32x4 w = *(const LAS f32x4*)(lg + c * DM + 4 * F.lane + 256 * j); ga[c] += (hh[0] * w[0] + hh[1] * w[1]) + (hh[2] * w[2] + hh[3] * w[3]); }
            __builtin_amdgcn_sched_barrier(0); }
#pragma unroll
        for (int c = 0; c < 8; ++c) ga[c] = wave_sum(ga[c]);
        if (F.lane < 8) { float gv = ga[0];
#pragma unroll
            for (int c = 1; c < 8; ++c) gv = (F.lane == c) ? ga[c] : gv;
            gv += (F.lane < 4) ? F.i_b[F.lane] : F.f_b[F.lane - 4];
            GATES[(size_t)row * 8 + F.lane] = gv; }
    }
    __syncthreads();
    { bf16* RH = (bf16*)(F.ws + WS_RWT); bf16* RL = RH + NE * DM;
      for (int idx = F.vcu * NTHR + F.tid; idx < NE * DM; idx += F.G * NTHR) { const int e = idx & 31, k = idx >> 5; const float w = F.router_w[idx] * F.ffn_g[k];
          const unsigned hi = cvtpk(w, 0.f) & 0xffffu; const float rem = w - __uint_as_float(hi << 16);
          const int off = (((((k >> 6) * 2 + ((k >> 5) & 1)) * 2 + (e >> 4)) * 64) + 16 * ((k >> 3) & 3) + (e & 15)) * 8 + (k & 7);
          RH[off] = (bf16)hi; RL[off] = (bf16)(cvtpk(rem, 0.f) & 0xffffu); } }
    { float* TAB = (float*)(F.ws + WS_SMALL + SM_ROPE);
      for (int idx = F.vcu * NTHR + F.tid; idx < SEQ * 16; idx += F.G * NTHR) { const int pos = idx >> 4, i = idx & 15;
          const float inv = exp2f(-(float)i * (2.0f / 32.0f) * 18.931568569324174f); const float ang = (float)pos * inv; const float nrev = rintf(ang * 0.15915494309189535f);
          const float rr = (float)__builtin_fma(-(double)nrev, 6.283185307179586476925, (double)ang);
          TAB[pos * 32 + i] = cosf(rr); TAB[pos * 32 + 16 + i] = sinf(rr); } }
    LAS unsigned char* img = F.lds + F.wave * 16384;
    constexpr int I_IN = 32 * 48, I_OUT = 32 * 16, NITEMS = I_IN + I_OUT;
    for (int it = gw; it < NITEMS; it += NGW) {
        int r = it;
        if (r < I_IN) { const int kb = r / 48, nb = r % 48; p0_tr_item<0>(F.w_in, INW, (bf16*)(F.ws + WS_WIN), DM, 64 * kb, 128 * nb, img, F.lane); continue; } r -= I_IN;
        { const int kb = r / 16, nb = r % 16; p0_tr_item<0>(F.w_out, DM, (bf16*)(F.ws + WS_WOUT), DM, 64 * kb, 128 * nb, img, F.lane); }
    }
}
template <int MODE>
DI void p0_strip_fp8(const float* W, int ld, unsigned char* WT, int K, int n0, LAS unsigned char* img, int lane) {
    const float* wp = W + (size_t)(lane >> 5) * ld + n0 + 4 * (lane & 31);
    const int g = lane >> 4, i16 = lane & 15, q = i16 >> 2, p = i16 & 3;
    int wb[8];
#pragma unroll
    for (int i = 0; i < 8; ++i) { const int kk = 2 * i + (lane >> 5), n = 4 * (lane & 31); wb[i] = img_off(kk, n >> 3) + (n & 7) * 2; }
    int rb[4], cx[4];
#pragma unroll
    for (int t = 0; t < 4; ++t) { const int M = (q << 2) | t; rb[t] = 256 * (16 * g + 4 * t + q) + 16 * ((p >> 1) ^ (M & 1)) + 8 * (p & 1); cx[t] = M >> 1; }
    int orow[8];
#pragma unroll
    for (int nb = 0; nb < 8; ++nb) { const int n = n0 + 16 * nb + i16; int row = n; if (MODE == 1) { const int ff = n >> 1; row = 256 * (ff >> 7) + 128 * (n & 1) + (ff & 127); } orow[nb] = row * K + 16 * g; }
    f32x4 va[16], vb[16];
#define P0S_LOAD(dst, krow0) do { _Pragma("unroll") for (int i = 0; i < 16; ++i) dst[i] = *(const f32x4*)(wp + (size_t)((krow0) + 2 * i) * ld); } while (0)
#define P0S_PUT(src, r0) do { _Pragma("unroll") for (int i = 0; i < 16; ++i) { \
        u32x2 pk; pk.x = cvtpk(src[i][0], src[i][1]) + 0x02800280u; pk.y = cvtpk(src[i][2], src[i][3]) + 0x02800280u;        \
        *(LAS u32x2*)(img + wb[i & 7] + ((r0) / 16 + (i >> 3)) * 4096) = pk; } } while (0)
#define P0S_F8(lo, hi) pk4_fp8m(__uint_as_float((lo) << 16), __uint_as_float((lo) & 0xffff0000u), __uint_as_float((hi) << 16), __uint_as_float((hi) & 0xffff0000u))
    P0S_LOAD(va, 0);
#pragma unroll 1
    for (int kb = 0; kb < 32; ++kb) {
        P0S_LOAD(vb, 64 * kb + 32);
        P0S_PUT(va, 0);
        if (kb < 31) P0S_LOAD(va, 64 * kb + 64);
        P0S_PUT(vb, 32);
        LDS_WAIT();
#pragma unroll 2
        for (int nb = 0; nb < 8; ++nb) {
            const s16x4 t0 = tr16(img + rb[0] + 32 * (nb ^ cx[0])), t1 = tr16(img + rb[1] + 32 * (nb ^ cx[1])), t2 = tr16(img + rb[2] + 32 * (nb ^ cx[2])), t3 = tr16(img + rb[3] + 32 * (nb ^ cx[3]));
            const u32x2 f0 = __builtin_bit_cast(u32x2, t0), f1 = __builtin_bit_cast(u32x2, t1), f2 = __builtin_bit_cast(u32x2, t2), f3 = __builtin_bit_cast(u32x2, t3);
            u32x4 o; o.x = P0S_F8(f0.x, f0.y); o.y = P0S_F8(f1.x, f1.y); o.z = P0S_F8(f2.x, f2.y); o.w = P0S_F8(f3.x, f3.y);
            *(u32x4*)(WT + (size_t)(unsigned)orow[nb] + 64 * kb) = o; }
        LDS_WAIT();
    }
#undef P0S_LOAD
#undef P0S_PUT
#undef P0S_F8
}
DI void p0_expert_weights(Frame& F, int wk, int nwk) {
    LAS unsigned char* img = F.lds + F.wave * 16384;
    constexpr int C_UP = NE * 32, C_DN = NE * 16, NCH = C_UP + C_DN;
    for (int cx = wk * NWAVES + F.wave; cx < NCH; cx += nwk * NWAVES) {
        if (cx < C_UP) { const int e = cx >> 5, nb = cx & 31; p0_strip_fp8<1>(F.w_up + (size_t)e * DM * UPW, UPW, F.ws + WS_WUP + (size_t)e * UPW * DM, DM, 128 * nb, img, F.lane); }
        else { const int r = cx - C_UP, e = r >> 4, nb = r & 15; p0_strip_fp8<0>(F.w_down + (size_t)e * FF * DM, DM, F.ws + WS_WDN + (size_t)e * DM * FF, FF, 128 * nb, img, F.lane); }
    }
}

DI void p2_conv(Frame& F, int wk, int nwk) {
    bf16* PROJ = (bf16*)(F.ws + WS_PROJ);
    bf16* QC = (bf16*)(F.ws + WS_QC); bf16* KC = (bf16*)(F.ws + WS_KC);
    for (int idx = wk * NTHR + F.tid; idx < NTOK * 128; idx += nwk * NTHR) {
        const int tok = idx >> 7, c8 = (idx & 127) * 8, t = tok & (SEQ - 1);
        float a[8];
#pragma unroll
        for (int e = 0; e < 8; ++e) a[e] = F.conv_b[c8 + e];
#pragma unroll
        for (int j = 0; j < 4; ++j) { const int tt = t - 3 + j; if (tt < 0) continue;
            const u32x4 raw = *(const u32x4*)(PROJ + (size_t)(tok - 3 + j) * NPROJ + COL_MQ + c8);
            const float* wp = F.conv_w + j * 1024 + c8;
#pragma unroll
            for (int e = 0; e < 4; ++e) { a[2 * e] += __uint_as_float(raw[e] << 16) * wp[2 * e]; a[2 * e + 1] += __uint_as_float(raw[e] & 0xffff0000u) * wp[2 * e + 1]; } }
        const float sc = (c8 < 512) ? 1.0f : QSCALE;
#pragma unroll
        for (int e = 0; e < 8; ++e) a[e] = a[e] * __builtin_amdgcn_rcpf(1.0f + __expf(-a[e])) * sc;
        u32x4 w; w.x = cvtpk(a[0], a[1]); w.y = cvtpk(a[2], a[3]); w.z = cvtpk(a[4], a[5]); w.w = cvtpk(a[6], a[7]);
        if (c8 < 512) *(u32x4*)(QC + (size_t)tok * 512 + c8) = w; else *(u32x4*)(KC + (size_t)tok * 512 + (c8 - 512)) = w;
    }
}

template <int DIL, bool FIRST, bool LAST>
DI void attn_phase(Frame& F) {
    constexpr int UPR = 64 / DIL, PRE = 6;
    bf16* OST = (bf16*)(F.ws + WS_OST); float* ML = (float*)(F.ws + WS_ML); bf16* MIX = (bf16*)(F.ws + WS_MIX);
    const bf16* HMq = (const bf16*)(F.ws + WS_HM);
    const int lane = F.lane, r = lane & 31, h = lane >> 5, g = lane >> 4, i16 = lane & 15, q4 = i16 >> 2, p4 = i16 & 3;
    const int prow = 4 * F.wave + g, pch = i16 ^ ((g << 2) | (F.wave & 3));
    const unsigned pdst = (unsigned)F.wave * 1024u;
    int vB0[4], vB1[4];
#pragma unroll
    for (int db = 0; db < 4; ++db) { vB0[db] = tr_base(4 * h, 4 * db + 2 * (g & 1), q4, p4); vB1[db] = tr_base(8 + 4 * h, 4 * db + 2 * (g & 1), q4, p4); }
    const int kmask = ((r & 3) << 2) | ((r >> 2) & 3);
    __syncthreads();
    const int nun = (F.vcu < 1024) ? (1023 - F.vcu) / F.G + 1 : 0;
    if (nun > 0) {
#define ATT_DECODE(k_, b_, hd_, res_, ib_) do { const int u_ = F.vcu + (k_) * F.G; const int bh_ = u_ >> 6, uu_ = u_ & 63; b_ = bh_ >> 3; hd_ = bh_ & 7; res_ = uu_ / UPR; ib_ = (uu_ % UPR) * 256; } while (0)
        int iu = 0, ij = 0, is = 0, ib_i; const bf16* kv_i;
        { int b_, hd_, res_; ATT_DECODE(0, b_, hd_, res_, ib_i); kv_i = HMq + HM_PLANE + ((size_t)(b_ * 8 + hd_) * SEQ + res_) * 128; }
#define ATT_DMA16(gp, la) asm volatile("s_mov_b32 m0, %1\n\tglobal_load_lds_dwordx4 %0, off" :: "v"(gp), "s"(la) : "memory", "m0")
#define ATT_ISSUE1() do { int ki_ = ib_i - 128 + 32 * ij + prow; ki_ = ki_ < 0 ? 0 : ki_; const bf16* src_ = kv_i + (size_t)ki_ * (DIL * 128) + 8 * pch; \
            const unsigned slot_ = __builtin_amdgcn_readfirstlane((unsigned)(unsigned long long)(F.lds + (is & 7) * 16384 + pdst)); ++is; \
            ATT_DMA16(src_, slot_); ATT_DMA16(src_ + HM_PLANE, slot_ + 8192u); \
            if (++ij == 12) { if (iu + 1 < nun) { ++iu; ij = 0; int b_, hd_, res_; ATT_DECODE(iu, b_, hd_, res_, ib_i); kv_i = HMq + HM_PLANE + ((size_t)(b_ * 8 + hd_) * SEQ + res_) * 128; } else ij = 11; } } while (0)
        u32x4 qfr[8], on[8]; u32x2 mlx; mlx.x = 0u; mlx.y = 0u;
#define ATT_GLD16(dst, ptr, off) asm volatile("global_load_dwordx4 %0, %1, off offset:%2" : "=v"(dst) : "v"(ptr), "i"(off) : "memory")
#define ATT_PREFETCH(k_) do { int b_, hd_, res_, ib_; ATT_DECODE(k_, b_, hd_, res_, ib_); const size_t hr_ = (size_t)(b_ * 8 + hd_) * SEQ + (size_t)(ib_ + 32 * F.wave + r) * DIL + res_; \
            const bf16* qp_ = HMq + hr_ * 128 + 8 * h; _Pragma("unroll") for (int kk = 0; kk < 8; ++kk) ATT_GLD16(qfr[kk], qp_, 32 * kk); \
            if (!FIRST) { const bf16* op_ = OST + hr_ * 128 + 8 * h; _Pragma("unroll") for (int db = 0; db < 4; ++db) _Pragma("unroll") for (int j2 = 0; j2 < 2; ++j2) ATT_GLD16(on[2 * db + j2], op_, 64 * db + 32 * j2); \
                const float* mlq_ = ML + hr_ * 2; asm volatile("global_load_dwordx2 %0, %1, off" : "=v"(mlx) : "v"(mlq_) : "memory"); } } while (0)
        ATT_PREFETCH(0);
#pragma unroll
        for (int jt = 0; jt < PRE; ++jt) ATT_ISSUE1();
        int cs = 0;
        f32x16 o[4]; float m = -1e30f, l = 0.f;
#pragma unroll 1
        for (int k = 0; k < nun; ++k) {
            int b, hd, res, ibase; ATT_DECODE(k, b, hd, res, ibase);
            const int i0 = ibase + F.wave * 32;
#pragma unroll 1
            for (int j = 0; j < 12; ++j) {
                ATT_ISSUE1();
                asm volatile("s_waitcnt vmcnt(12)" ::: "memory");
                __builtin_amdgcn_s_barrier(); asm volatile("" ::: "memory");
                const int kt = j - F.wave;
                if (kt >= 0 && kt <= 4) {
                    if (kt == 0) {
                        if (FIRST) {
#pragma unroll
                            for (int db = 0; db < 4; ++db)
#pragma unroll
                                for (int e = 0; e < 16; ++e) o[db][e] = 0.f;
                            m = -1e30f; l = 0.f;
                        } else {
#pragma unroll
                            for (int db = 0; db < 4; ++db)
#pragma unroll
                                for (int j2 = 0; j2 < 2; ++j2) { const u32x4 vv = on[2 * db + j2]; u32x2 va2[2]; va2[0].x = vv.x; va2[0].y = vv.y; va2[1].x = vv.z; va2[1].y = vv.w; swap32(va2[0], va2[1]);
#pragma unroll
                                    for (int q2 = 0; q2 < 2; ++q2) { const int g4 = 2 * j2 + q2; const u32x2 v = va2[q2];
                                        o[db][4 * g4] = __uint_as_float(v.x << 16); o[db][4 * g4 + 1] = __uint_as_float(v.x & 0xffff0000u); o[db][4 * g4 + 2] = __uint_as_float(v.y << 16); o[db][4 * g4 + 3] = __uint_as_float(v.y & 0xffff0000u); } }
                            m = __uint_as_float(mlx.x); l = __uint_as_float(mlx.y);
                        }
                    }
                    const LAS unsigned char* kimg = F.lds + (cs & 7) * 16384; const LAS unsigned char* vi = kimg + 8192;
                    f32x16 s;
#pragma unroll
                    for (int e = 0; e < 16; ++e) s[e] = 0.f;
                    const LAS unsigned char* krow = kimg + 256 * r;
                    bf16x8 ka[8];
#pragma unroll
                    for (int kk = 0; kk < 8; ++kk) ka[kk] = *(const LAS bf16x8*)(krow + 16 * ((2 * kk + h) ^ kmask));
                    __builtin_amdgcn_sched_barrier(0);
#pragma unroll
                    for (int kk = 0; kk < 8; ++kk) s = mfma32(ka[kk], __builtin_bit_cast(bf16x8, qfr[kk]), s);
                    bf16x8 va[2][4];
#pragma unroll
                    for (int s2 = 0; s2 < 2; ++s2)
#pragma unroll
                        for (int db = 0; db < 4; ++db) va[s2][db] = tr_frag2(vi, vB0[db], vB1[db], s2 * 4096);
                    __builtin_amdgcn_sched_barrier(0);
                    { const int kb = i0 - 128 + 32 * kt;
                      if (kt == 0 || kt == 4 || kb < 0) {
#pragma unroll
                        for (int e = 0; e < 16; ++e) { const int ce = crow(e, h); const bool bad = ((kb + ce) < 0) || (kt == 0 && ce < r) || (kt == 4 && ce > r); if (bad) s[e] = -1e30f; } } }
                    float mx = fmaxf(fmaxf(s[0], s[1]), s[2]);
#pragma unroll
                    for (int e = 3; e < 15; e += 2) mx = fmaxf(fmaxf(mx, s[e]), s[e + 1]);
                    mx = fmaxf(mx, s[15]);
                    mx = fmaxf(mx, __shfl_xor(mx, 32));
                    if (__any(mx > m + 8.0f)) { const float mn = fmaxf(m, mx), alpha = __builtin_amdgcn_exp2f(m - mn); l *= alpha; m = mn;
#pragma unroll
                        for (int db = 0; db < 4; ++db)
#pragma unroll
                            for (int e = 0; e < 16; ++e) o[db][e] *= alpha; }
                    float rs = 0.f;
#pragma unroll
                    for (int e = 0; e < 16; ++e) { s[e] = __builtin_amdgcn_exp2f(s[e] - m); rs += s[e]; }
                    rs += __shfl_xor(rs, 32); l += rs;
                    bf16x8 pb[2];
#pragma unroll
                    for (int s2 = 0; s2 < 2; ++s2) { u32x4 w; w.x = cvtpk(s[8 * s2], s[8 * s2 + 1]); w.y = cvtpk(s[8 * s2 + 2], s[8 * s2 + 3]); w.z = cvtpk(s[8 * s2 + 4], s[8 * s2 + 5]); w.w = cvtpk(s[8 * s2 + 6], s[8 * s2 + 7]);
                        pb[s2] = __builtin_bit_cast(bf16x8, w); }
#pragma unroll
                    for (int s2 = 0; s2 < 2; ++s2) {
#pragma unroll
                        for (int db = 0; db < 4; ++db) o[db] = mfma32(va[s2][db], pb[s2], o[db]);
                    }
                    if (kt == 4) {
                        const size_t hrow = (size_t)(b * 8 + hd) * SEQ + (size_t)(i0 + r) * DIL + res;
                        if (LAST) {
                            const size_t rowq = (size_t)b * SEQ + (size_t)(i0 + r) * DIL + res;
                            const float il = 1.0f / l;
                            bf16* mp = MIX + rowq * DM + hd * 128 + 8 * h;
#pragma unroll
                            for (int db = 0; db < 4; ++db)
#pragma unroll
                                for (int j2 = 0; j2 < 2; ++j2) { u32x2 w2[2];
#pragma unroll
                                    for (int q2 = 0; q2 < 2; ++q2) { const int g4 = 2 * j2 + q2; w2[q2].x = cvtpk(o[db][4 * g4] * il, o[db][4 * g4 + 1] * il); w2[q2].y = cvtpk(o[db][4 * g4 + 2] * il, o[db][4 * g4 + 3] * il); }
                                    swap32(w2[0], w2[1]); u32x4 w; w.x = w2[0].x; w.y = w2[0].y; w.z = w2[1].x; w.w = w2[1].y;
                                    *(u32x4*)(mp + 32 * db + 16 * j2) = w; }
                        } else {
                            bf16* ostp = OST + hrow * 128 + 8 * h; float* mlp = ML + hrow * 2;
#pragma unroll
                            for (int db = 0; db < 4; ++db)
#pragma unroll
                                for (int j2 = 0; j2 < 2; ++j2) { u32x2 w2[2];
#pragma unroll
                                    for (int q2 = 0; q2 < 2; ++q2) { const int g4 = 2 * j2 + q2; w2[q2].x = cvtpk(o[db][4 * g4], o[db][4 * g4 + 1]); w2[q2].y = cvtpk(o[db][4 * g4 + 2], o[db][4 * g4 + 3]); }
                                    swap32(w2[0], w2[1]); u32x4 w; w.x = w2[0].x; w.y = w2[0].y; w.z = w2[1].x; w.w = w2[1].y;
                                    *(u32x4*)(ostp + 32 * db + 16 * j2) = w; }
                            if (h == 0) { f32x2 mlv; mlv[0] = m; mlv[1] = l; *(f32x2*)mlp = mlv; }
                        }
                        if (k + 1 < nun) ATT_PREFETCH(k + 1);
                    }
                }
                ++cs;
                __builtin_amdgcn_sched_barrier(0);
            }
        }
#undef ATT_ISSUE1
#undef ATT_DMA16
#undef ATT_PREFETCH
#undef ATT_GLD16
#undef ATT_DECODE
        asm volatile("s_waitcnt vmcnt(0)" ::: "memory");
    }
    __syncthreads();
}

DI float scan_incl_sum(float v, int lane) {
#pragma unroll
    for (int o = 1; o < 64; o <<= 1) { const float t = __shfl_up(v, o); if (lane >= o) v += t; }
    return v;
}
DI float scan_incl_max(float v, int lane) {
#pragma unroll
    for (int o = 1; o < 64; o <<= 1) { const float t = __shfl_up(v, o); if (lane >= o) v = fmaxf(v, t); }
    return v;
}
template <bool SCALE>
DI void load_img128(LAS unsigned char* img, const bf16* src, size_t ldg, const LAS float* rs, int tid) {
#pragma unroll
    for (int it = 0; it < 4; ++it) { const int idx = tid + NTHR * it, row = idx >> 4, ch = idx & 15;
        u32x4 v = *(const u32x4*)(src + (size_t)row * ldg + 8 * ch);
        if (SCALE) { const float w = rs[row];
#pragma unroll
            for (int e = 0; e < 4; ++e) { const float lo = __uint_as_float(v[e] << 16) * w, hi = __uint_as_float(v[e] & 0xffff0000u) * w; v[e] = cvtpk(lo, hi); } }
        *(LAS u32x4*)(img + img_off(row, ch)) = v; }
}
DI void dma_img128(LAS unsigned char* img, const bf16* src, size_t ldg, int wave, int lane) {
    const int g = lane >> 4, i16 = lane & 15;
#pragma unroll
    for (int i = 0; i < 4; ++i) { const int row = (wave * 4 + i) * 4 + g; const int ch = i16 ^ ((g << 2) | i);
        __builtin_amdgcn_global_load_lds((const unsigned*)(src + (size_t)row * ldg + 8 * ch), (LAS unsigned*)(img + (wave * 4 + i) * 1024), 16, 0, 0); }
}
DI void mlstm_m1_unit(Frame& F, int u) {
    const int bh = u >> 7, c = u & 127, b = bh >> 2, hd = bh & 3;
    const int tok0 = b * SEQ + c * 128;
    const float* GATES = (const float*)(F.ws + WS_GATES);
    LAS float* mf = (LAS float*)(F.lds + MISC_OFF);
    LAS unsigned char* imgK = F.lds, *imgV0 = F.lds + 32768, *imgV1 = F.lds + 65536;
    const int lane = F.lane;
    const bf16* KC = (const bf16*)(F.ws + WS_KC); const bf16* PROJ = (const bf16*)(F.ws + WS_PROJ);
    dma_img128(imgV0, PROJ + (size_t)tok0 * NPROJ + COL_MV + hd * 256, NPROJ, F.wave, lane);
    dma_img128(imgV1, PROJ + (size_t)tok0 * NPROJ + COL_MV + hd * 256 + 128, NPROJ, F.wave, lane);
    asm volatile("" ::: "memory");
    u32x4 kreg[4];
#pragma unroll
    for (int it = 0; it < 4; ++it) { const int idx = F.tid + NTHR * it, row = idx >> 4, ch = idx & 15; kreg[it] = *(const u32x4*)(KC + (size_t)(tok0 + row) * 512 + hd * 128 + 8 * ch); }
    if (F.wave == 0) {
        const int s0 = 2 * lane;
        const float ig0 = GATES[(size_t)(tok0 + s0) * 8 + hd], fg0 = GATES[(size_t)(tok0 + s0) * 8 + 4 + hd];
        const float ig1 = GATES[(size_t)(tok0 + s0 + 1) * 8 + hd], fg1 = GATES[(size_t)(tok0 + s0 + 1) * 8 + 4 + hd];
        const float lf0 = log_sigmoid(fg0), lf1 = log_sigmoid(fg1);
        const float b1 = scan_incl_sum(lf0 + lf1, lane), b0 = b1 - lf1;
        const float gt = __shfl(b1, 63);
        const float a0 = gt - b0 + ig0, a1 = gt - b1 + ig1;
        const float ml = wave_max(fmaxf(a0, a1));
        mf[s0] = __expf(a0 - ml); mf[s0 + 1] = __expf(a1 - ml);
        if (lane == 0) { ((float*)(F.ws + WS_SMALL + SM_G))[u] = gt; ((float*)(F.ws + WS_SMALL + SM_MLOC))[u] = ml; }
    }
    asm volatile("s_waitcnt vmcnt(4)" ::: "memory");
    __syncthreads();
#pragma unroll
    for (int it = 0; it < 4; ++it) { const int idx = F.tid + NTHR * it, row = idx >> 4, ch = idx & 15; const float w = mf[row]; u32x4 v = kreg[it];
#pragma unroll
        for (int e = 0; e < 4; ++e) { const float lo = __uint_as_float(v[e] << 16) * w, hi = __uint_as_float(v[e] & 0xffff0000u) * w; v[e] = cvtpk(lo, hi); }
        *(LAS u32x4*)(imgK + img_off(row, ch)) = v; }
    __syncthreads();
    if (F.tid < 128) { const int dk = F.tid; float a = 0.f;
        for (int s = 0; s < 128; ++s) a += bf2f(*(const LAS unsigned short*)(imgK + img_off(s, dk >> 3) + (dk & 7) * 2));
        ((float*)(F.ws + WS_SMALL + SM_NLOC))[(size_t)u * 128 + dk] = a; }
    const int mb = F.wave >> 1, nh = F.wave & 1, r = lane & 31, h = lane >> 5, g = lane >> 4, i16 = lane & 15, q4 = i16 >> 2, p4 = i16 & 3;
    LAS unsigned char* imgV = nh ? imgV1 : imgV0;
    f32x16 acc[4];
#pragma unroll
    for (int nb = 0; nb < 4; ++nb)
#pragma unroll
        for (int e = 0; e < 16; ++e) acc[nb][e] = 0.f;
    const int aA0 = tr_base(8 * h, 4 * mb + 2 * (g & 1), q4, p4), aA1 = tr_base(8 * h + 4, 4 * mb + 2 * (g & 1), q4, p4);
    int bB0[4], bB1[4];
#pragma unroll
    for (int nb = 0; nb < 4; ++nb) { bB0[nb] = tr_base(8 * h, 4 * nb + 2 * (g & 1), q4, p4); bB1[nb] = tr_base(8 * h + 4, 4 * nb + 2 * (g & 1), q4, p4); }
#pragma unroll
    for (int ks = 0; ks < 8; ++ks) {
        const bf16x8 a = tr_frag2(imgK, aA0, aA1, ks * 4096);
#pragma unroll
        for (int nb = 0; nb < 4; ++nb) { const bf16x8 bfr = tr_frag2(imgV, bB0[nb], bB1[nb], ks * 4096);
            acc[nb] = mfma32(a, bfr, acc[nb]); }
        __builtin_amdgcn_sched_barrier(0);
    }
    bf16* CL = (bf16*)(F.ws + WS_CLOC) + (size_t)u * 128 * 256;
    __syncthreads();
    { LAS unsigned char* stg = F.lds + (size_t)(32 * mb) * 528 + (128 * nh + r) * 2;
#pragma unroll
      for (int nb = 0; nb < 4; ++nb)
#pragma unroll
          for (int e = 0; e < 16; ++e) *(LAS unsigned short*)(stg + crow(e, h) * 528 + 64 * nb) = (unsigned short)(cvtpk(acc[nb][e], 0.f) & 0xffffu); }
    __syncthreads();
#pragma unroll
    for (int i = 0; i < 8; ++i) { const int p = F.tid + NTHR * i, row = p >> 5, ch = p & 31; *(u32x4*)(CL + (size_t)row * 256 + 8 * ch) = *(const LAS u32x4*)(F.lds + row * 528 + 16 * ch); }
    __syncthreads();
}
DI void mlstm_scan(Frame& F) {
    const float* Gv = (const float*)(F.ws + WS_SMALL + SM_G); const float* MLv = (const float*)(F.ws + WS_SMALL + SM_MLOC);
    float* MP = (float*)(F.ws + WS_SMALL + SM_MPREV); const float* NL = (const float*)(F.ws + WS_SMALL + SM_NLOC); float* NP = (float*)(F.ws + WS_SMALL + SM_NPREV);
    const bf16* CL = (const bf16*)(F.ws + WS_CLOC); bf16* CP = (bf16*)(F.ws + WS_CPREV);
    const int lane = F.lane;
    for (int t = F.vcu + F.G * F.wave; t < 512; t += F.G * NWAVES) {
        const int bh = t >> 6, dk = (t & 63) * 2 + (lane >> 5), dv = (lane & 31) * 8;
        const float g0 = Gv[bh * 128 + lane], g1 = Gv[bh * 128 + 64 + lane], l0 = MLv[bh * 128 + lane], l1 = MLv[bh * 128 + 64 + lane];
        const size_t e0 = (size_t)bh * 128 * 32768 + (size_t)dk * 256 + dv;
        float st[8];
#pragma unroll
        for (int e = 0; e < 8; ++e) st[e] = 0.f;
        float m = 0.f, ns = 0.f;
#pragma unroll 1
        for (int cb = 0; cb < NCH; cb += 16) {
            u32x4 cl[16];
#pragma unroll
            for (int i = 0; i < 16; ++i) cl[i] = *(const u32x4*)(CL + e0 + (size_t)(cb + i) * 32768);
#pragma unroll
            for (int i = 0; i < 16; ++i) { const int c = cb + i;
                const float gc = __uint_as_float(__builtin_amdgcn_readlane(__float_as_uint(cb < 64 ? g0 : g1), c & 63)), ml = __uint_as_float(__builtin_amdgcn_readlane(__float_as_uint(cb < 64 ? l0 : l1), c & 63));
                const float mn = fmaxf(gc + m, ml), dold = __expf(gc + m - mn), dnew = __expf(ml - mn);
                u32x4 w; w.x = cvtpk(st[0], st[1]); w.y = cvtpk(st[2], st[3]); w.z = cvtpk(st[4], st[5]); w.w = cvtpk(st[6], st[7]);
                *(u32x4*)(CP + e0 + (size_t)c * 32768) = w;
#pragma unroll
                for (int e = 0; e < 4; ++e) { st[2 * e] = dold * st[2 * e] + dnew * __uint_as_float(cl[i][e] << 16); st[2 * e + 1] = dold * st[2 * e + 1] + dnew * __uint_as_float(cl[i][e] & 0xffff0000u); }
                if ((lane & 31) == 0) { const float nl = NL[(size_t)(bh * 128 + c) * 128 + dk]; NP[(size_t)(bh * 128 + c) * 128 + dk] = ns; ns = dold * ns + dnew * nl; }
                if ((t & 63) == 0 && lane == 0) MP[bh * 128 + c] = m;
                m = mn; }
        }
    }
}
DI void mlstm_m3_unit(Frame& F, int u) {
    const int bh = u >> 7, c = u & 127, b = bh >> 2, hd = bh & 3;
    const int tok0 = b * SEQ + c * 128;
    const float* GATES = (const float*)(F.ws + WS_GATES);
    LAS float* mf = (LAS float*)(F.lds + MISC_OFF);
    LAS unsigned char* imgV0 = F.lds, *imgV1 = F.lds + 32768, *imgC0 = F.lds + 65536, *imgC1 = F.lds + 98304, *imgK = F.lds + 65536;
    int lane_ = F.lane; asm volatile("" : "+v"(lane_));
    const int lane = lane_, tid_ = F.wave * 64 + lane, r = lane & 31, h = lane >> 5, g = lane >> 4, i16 = lane & 15, q4 = i16 >> 2, p4 = i16 & 3;
    const bf16* QC = (const bf16*)(F.ws + WS_QC); const bf16* KC = (const bf16*)(F.ws + WS_KC); const bf16* PROJ = (const bf16*)(F.ws + WS_PROJ);
    const bf16* CP = (const bf16*)(F.ws + WS_CPREV) + (size_t)u * 32768;
    dma_img128(imgV0, PROJ + (size_t)tok0 * NPROJ + COL_MV + hd * 256, NPROJ, F.wave, lane);
    dma_img128(imgV1, PROJ + (size_t)tok0 * NPROJ + COL_MV + hd * 256 + 128, NPROJ, F.wave, lane);
    dma_img128(imgC0, CP, 256, F.wave, lane);
    dma_img128(imgC1, CP + 128, 256, F.wave, lane);
    asm volatile("" ::: "memory");
    const int tb = F.wave & 3, dh = F.wave >> 2;
    const int tl = 32 * tb + r;
    bf16x8 qf[8];
    { const bf16* qp = QC + (size_t)(tok0 + tl) * 512 + hd * 128 + 8 * h;
#pragma unroll
      for (int kk = 0; kk < 8; ++kk) qf[kk] = *(const bf16x8*)(qp + 16 * kk); }
    u32x4 kreg[4];
#pragma unroll
    for (int it = 0; it < 4; ++it) { const int idx = tid_ + NTHR * it, row = idx >> 4, ch = idx & 15; kreg[it] = *(const u32x4*)(KC + (size_t)(tok0 + row) * 512 + hd * 128 + 8 * ch); }
    asm volatile("" ::: "memory");
    const float m_prev = ((const float*)(F.ws + WS_SMALL + SM_MPREV))[u];
    if (F.wave == 0) {
        const int s0 = 2 * lane;
        const float ig0 = GATES[(size_t)(tok0 + s0) * 8 + hd], fg0 = GATES[(size_t)(tok0 + s0) * 8 + 4 + hd];
        const float ig1 = GATES[(size_t)(tok0 + s0 + 1) * 8 + hd], fg1 = GATES[(size_t)(tok0 + s0 + 1) * 8 + 4 + hd];
        const float lf0 = log_sigmoid(fg0), lf1 = log_sigmoid(fg1);
        const float b1 = scan_incl_sum(lf0 + lf1, lane), b0 = b1 - lf1;
        const float u0 = ig0 - b0, u1 = ig1 - b1;
        const float im = scan_incl_max(fmaxf(u0, u1), lane);
        float ex = __shfl_up(im, 1); if (lane == 0) ex = -1e30f;
        const float cm0 = fmaxf(ex, u0), cm1 = im;
        const float M0 = fmaxf(m_prev, cm0), M1 = fmaxf(m_prev, cm1);
        mf[s0] = u0; mf[s0 + 1] = u1; mf[128 + s0] = M0; mf[128 + s0 + 1] = M1;
        mf[256 + s0] = __expf(m_prev - M0); mf[256 + s0 + 1] = __expf(m_prev - M1);
        mf[384 + s0] = __expf(-(b0 + M0)); mf[384 + s0 + 1] = __expf(-(b1 + M1));
    }
    if (F.wave == 1) { const float* NP = (const float*)(F.ws + WS_SMALL + SM_NPREV) + (size_t)u * 128; mf[512 + lane] = NP[lane]; mf[512 + 64 + lane] = NP[64 + lane]; }
    asm volatile("s_waitcnt vmcnt(4)" ::: "memory");
    __syncthreads();
    LAS unsigned char* imgC = dh ? imgC1 : imgC0; LAS unsigned char* imgV = dh ? imgV1 : imgV0;
    f32x16 acc[4];
#pragma unroll
    for (int nb = 0; nb < 4; ++nb)
#pragma unroll
        for (int e = 0; e < 16; ++e) acc[nb][e] = 0.f;
    int cB0[4], cB1[4];
#pragma unroll
    for (int nb = 0; nb < 4; ++nb) { cB0[nb] = tr_base(8 * h, 4 * nb + 2 * (g & 1), q4, p4); cB1[nb] = tr_base(8 * h + 4, 4 * nb + 2 * (g & 1), q4, p4); }
#pragma unroll
    for (int kk = 0; kk < 8; ++kk) {
#pragma unroll
        for (int nb = 0; nb < 4; ++nb) { const bf16x8 a = tr_frag2(imgC, cB0[nb], cB1[nb], kk * 4096);
            acc[nb] = mfma32(a, qf[kk], acc[nb]); }
        __builtin_amdgcn_sched_barrier(0);
    }
    const float wi = mf[256 + tl], Mt = mf[128 + tl], en = mf[384 + tl];
#pragma unroll
    for (int nb = 0; nb < 4; ++nb)
#pragma unroll
        for (int e = 0; e < 16; ++e) acc[nb][e] *= wi;
    float qn = 0.f;
#pragma unroll
    for (int kk = 0; kk < 8; ++kk) { const f32x4 n0 = *(const LAS f32x4*)(mf + 512 + 16 * kk + 8 * h), n1 = *(const LAS f32x4*)(mf + 512 + 16 * kk + 8 * h + 4);
        const u32x4 qq = __builtin_bit_cast(u32x4, qf[kk]);
        qn += __uint_as_float(qq[0] << 16) * n0[0] + __uint_as_float(qq[0] & 0xffff0000u) * n0[1] + __uint_as_float(qq[1] << 16) * n0[2] + __uint_as_float(qq[1] & 0xffff0000u) * n0[3];
        qn += __uint_as_float(qq[2] << 16) * n1[0] + __uint_as_float(qq[2] & 0xffff0000u) * n1[1] + __uint_as_float(qq[3] << 16) * n1[2] + __uint_as_float(qq[3] & 0xffff0000u) * n1[3]; }
    qn += __shfl_xor(qn, 32);
    __syncthreads();
#pragma unroll
    for (int it = 0; it < 4; ++it) { const int idx = tid_ + NTHR * it, row = idx >> 4, ch = idx & 15; *(LAS u32x4*)(imgK + img_off(row, ch)) = kreg[it]; }
    __syncthreads();
    u32x4 moreg[8];
    { const bf16* mop = PROJ + (size_t)(tok0 + tl) * NPROJ + COL_MO + hd * 256 + 128 * dh + 8 * h;
#pragma unroll
      for (int nb = 0; nb < 4; ++nb)
#pragma unroll
          for (int j2 = 0; j2 < 2; ++j2) moreg[2 * nb + j2] = *(const u32x4*)(mop + 32 * nb + 16 * j2); }
    float den = 0.f;
    int vB0[4], vB1[4];
#pragma unroll
    for (int nb = 0; nb < 4; ++nb) { vB0[nb] = tr_base(4 * h, 4 * nb + 2 * (g & 1), q4, p4); vB1[nb] = tr_base(8 + 4 * h, 4 * nb + 2 * (g & 1), q4, p4); }
    const int kmask = ((r & 3) << 2) | ((r >> 2) & 3);
#pragma unroll 1
    for (int sb = 0; sb <= tb; ++sb) {
        f32x16 s;
#pragma unroll
        for (int e = 0; e < 16; ++e) s[e] = 0.f;
        const LAS unsigned char* krow = imgK + 256 * (32 * sb + r);
#pragma unroll
        for (int kk = 0; kk < 8; ++kk) { const bf16x8 a = *(const LAS bf16x8*)(krow + 16 * ((2 * kk + h) ^ kmask)); s = mfma32(a, qf[kk], s); }
        __builtin_amdgcn_sched_barrier(0);
#pragma unroll
        for (int g4 = 0; g4 < 4; ++g4) { const f32x4 uu = *(const LAS f32x4*)(mf + 32 * sb + 8 * g4 + 4 * h);
#pragma unroll
            for (int j = 0; j < 4; ++j) { const int e = 4 * g4 + j; const int sl = 32 * sb + 8 * g4 + 4 * h + j;
                const float w = (sl <= tl) ? __expf(uu[j] - Mt) : 0.f; s[e] *= w; den += s[e]; } }
        bf16x8 pb[2];
#pragma unroll
        for (int s2 = 0; s2 < 2; ++s2) { u32x4 w; w.x = cvtpk(s[8 * s2], s[8 * s2 + 1]); w.y = cvtpk(s[8 * s2 + 2], s[8 * s2 + 3]); w.z = cvtpk(s[8 * s2 + 4], s[8 * s2 + 5]); w.w = cvtpk(s[8 * s2 + 6], s[8 * s2 + 7]);
            pb[s2] = __builtin_bit_cast(bf16x8, w); }
        const LAS unsigned char* vsb = imgV + 8192 * sb;
#pragma unroll
        for (int s2 = 0; s2 < 2; ++s2) {
#pragma unroll
            for (int nb = 0; nb < 4; ++nb) { const bf16x8 va = tr_frag2(vsb, vB0[nb], vB1[nb], s2 * 4096);
                acc[nb] = mfma32(va, pb[s2], acc[nb]); }
        }
        __builtin_amdgcn_sched_barrier(0);
    }
    den += __shfl_xor(den, 32);
    const float dt = wi * qn + den;
    const float inv = 1.0f / fmaxf(fabsf(dt), en);
    float ss = 0.f;
#pragma unroll
    for (int nb = 0; nb < 4; ++nb)
#pragma unroll
        for (int e = 0; e < 16; ++e) { acc[nb][e] *= inv; ss += acc[nb][e] * acc[nb][e]; }
    ss += __shfl_xor(ss, 32);
    if (h == 0) mf[640 + dh * 128 + tl] = ss;
    __syncthreads();
    const float rstd = 1.0f / sqrtf((mf[640 + tl] + mf[640 + 128 + tl]) * (1.f / 256.f) + EPS);
    const size_t tokr = (size_t)(tok0 + tl);
    const float* gp = F.mlout_g + hd * 256 + 128 * dh + 4 * h;
    bf16* outp = (bf16*)(F.ws + WS_MIX) + tokr * DM + 1024 + hd * 256 + 128 * dh + 8 * h;
#pragma unroll
    for (int nb = 0; nb < 4; ++nb)
#pragma unroll
        for (int j2 = 0; j2 < 2; ++j2) { const u32x4 mv = moreg[2 * nb + j2]; u32x2 mo2[2], w2[2]; mo2[0].x = mv.x; mo2[0].y = mv.y; mo2[1].x = mv.z; mo2[1].y = mv.w; swap32(mo2[0], mo2[1]);
#pragma unroll
            for (int q2 = 0; q2 < 2; ++q2) { const int g4 = 2 * j2 + q2; const u32x2 mo = mo2[q2]; const f32x4 gg = *(const f32x4*)(gp + 32 * nb + 8 * g4);
                const float z0 = __uint_as_float(mo.x << 16), z1 = __uint_as_float(mo.x & 0xffff0000u), z2 = __uint_as_float(mo.y << 16), z3 = __uint_as_float(mo.y & 0xffff0000u);
                const float y0 = acc[nb][4 * g4] * rstd * gg[0] * __builtin_amdgcn_rcpf(1.0f + __expf(-z0)), y1 = acc[nb][4 * g4 + 1] * rstd * gg[1] * __builtin_amdgcn_rcpf(1.0f + __expf(-z1));
                const float y2 = acc[nb][4 * g4 + 2] * rstd * gg[2] * __builtin_amdgcn_rcpf(1.0f + __expf(-z2)), y3 = acc[nb][4 * g4 + 3] * rstd * gg[3] * __builtin_amdgcn_rcpf(1.0f + __expf(-z3));
                w2[q2].x = cvtpk(y0, y1); w2[q2].y = cvtpk(y2, y3); }
            swap32(w2[0], w2[1]); u32x4 w; w.x = w2[0].x; w.y = w2[0].y; w.z = w2[1].x; w.w = w2[1].y;
            *(u32x4*)(outp + 32 * nb + 16 * j2) = w; }
    __syncthreads();
}

DI void p7_router(Frame& F) {
    const float* X1 = F.out; unsigned char* H2 = F.ws + WS_XN;
    const bf16* RH = (const bf16*)(F.ws + WS_RWT); const bf16* RL = RH + NE * DM;
    int* TOPI = (int*)(F.ws + WS_SMALL + SM_TOPI); float* TOPW = (float*)(F.ws + WS_SMALL + SM_TOPW); int* HIST = (int*)(F.ws + WS_CTL + CTL_HIST); float* RSTD = (float*)(F.ws + WS_SMALL + SM_RSTD);
    const int lane = F.lane, g4 = lane >> 4, c = lane & 15;
    LAS unsigned char* himg = F.lds + F.wave * 6144; LAS unsigned char* limg = himg + 2304;
    LAS float* lr = (LAS float*)(himg + 4608);
    LAS unsigned char* fimg = himg + 5120;
    LAS float* gl = (LAS float*)(F.lds + 49152);
    LAS unsigned char* wbuf = F.lds + 57344;
    __syncthreads();
    *(LAS f32x4*)(gl + 4 * F.tid) = *(const f32x4*)(F.ffn_g + 4 * F.tid);
    const char* rhb = (const char*)RH + F.tid * 16; const char* rlb = (const char*)RL + F.tid * 16;
#define P7_G16(gp, la) asm volatile("s_mov_b32 m0, %1\n\tglobal_load_lds_dwordx4 %0, off" :: "v"(gp), "s"(la) : "memory", "m0")
#define P7_DMA(s_) do { const unsigned d_ = __builtin_amdgcn_readfirstlane((unsigned)(unsigned long long)(wbuf + ((s_) & 1) * 32768 + F.wave * 1024)); const size_t so_ = (size_t)(s_) * 16384; \
        P7_G16(rhb + so_, d_); P7_G16(rhb + so_ + 8192, d_ + 8192u); P7_G16(rlb + so_, d_ + 16384u); P7_G16(rlb + so_ + 8192, d_ + 24576u); } while (0)
#define P7_LOADX(slot, ch_) do { xv[slot][0] = *(const f32x4*)(xp + 64 * (ch_)); xv[slot][1] = *(const f32x4*)(xp + 64 * (ch_) + 4 * DM); xv[slot][2] = *(const f32x4*)(xp + 64 * (ch_) + 8 * DM); xv[slot][3] = *(const f32x4*)(xp + 64 * (ch_) + 12 * DM); } while (0)
    for (int t0 = F.vcu * NWAVES; t0 < NTOK / 16; t0 += F.G * NWAVES) {
        const int tile = t0 + F.wave;
        const int tok0 = 16 * tile;
        f32x4 acc0 = {0.f, 0.f, 0.f, 0.f}, acc1 = {0.f, 0.f, 0.f, 0.f};
        float ss0 = 0.f, ss1 = 0.f, ss2 = 0.f, ss3 = 0.f;
        const float* xp = X1 + (size_t)(tok0 + g4) * DM + 4 * c;
        unsigned char* hp = H2 + (size_t)(tok0 + (lane >> 2)) * DM + 16 * (lane & 3);
        f32x4 xv[4][4];
        P7_DMA(0);
        P7_LOADX(0, 0); P7_LOADX(1, 1); P7_LOADX(2, 2);
#pragma unroll 1
        for (int sl = 0; sl < 8; ++sl) {
            asm volatile("s_waitcnt vmcnt(12) lgkmcnt(0)" ::: "memory");
            __builtin_amdgcn_s_barrier(); asm volatile("" ::: "memory");
            if (sl + 1 < 8) P7_DMA(sl + 1);
            const LAS unsigned char* wsl = wbuf + (sl & 1) * 32768 + lane * 16;
#pragma unroll
            for (int u = 0; u < 4; ++u) {
                const int ch = 4 * sl + u;
                { const int cn = (ch + 3 < 32) ? ch + 3 : 31; P7_LOADX((u + 3) & 3, cn); }
                __builtin_amdgcn_sched_barrier(0);
                const f32x4 gv = *(const LAS f32x4*)(gl + 64 * ch + 4 * c);
#define P7_ROW(v, i, ssacc) do { ssacc += (v[0] * v[0] + v[1] * v[1]) + (v[2] * v[2] + v[3] * v[3]); const f32x4 y = v * gv; \
                *(LAS unsigned*)(fimg + (4 * (i) + g4) * 64 + 4 * c) = pk4_fp8(y[0], y[1], y[2], y[3]); \
                u32x2 hi, lo; hi.x = cvtpk(v[0], v[1]); hi.y = cvtpk(v[2], v[3]); \
                lo.x = cvtpk(v[0] - __uint_as_float(hi.x << 16), v[1] - __uint_as_float(hi.x & 0xffff0000u)); lo.y = cvtpk(v[2] - __uint_as_float(hi.y << 16), v[3] - __uint_as_float(hi.y & 0xffff0000u)); \
                *(LAS u32x2*)(himg + (4 * (i) + g4) * 144 + 8 * c) = hi; *(LAS u32x2*)(limg + (4 * (i) + g4) * 144 + 8 * c) = lo; } while (0)
                P7_ROW(xv[u][0], 0, ss0); P7_ROW(xv[u][1], 1, ss1); P7_ROW(xv[u][2], 2, ss2); P7_ROW(xv[u][3], 3, ss3);
#undef P7_ROW
                *(u32x4*)(hp + 64 * ch) = *(const LAS u32x4*)(fimg + 16 * lane);
#pragma unroll
                for (int kk = 0; kk < 2; ++kk) {
                    const bf16x8 bh_ = *(const LAS bf16x8*)(himg + c * 144 + (32 * kk + 8 * g4) * 2), bl_ = *(const LAS bf16x8*)(limg + c * 144 + (32 * kk + 8 * g4) * 2);
                    const bf16x8 ah0 = *(const LAS bf16x8*)(wsl + u * 4096 + (kk * 2) * 1024), ah1 = *(const LAS bf16x8*)(wsl + u * 4096 + (kk * 2 + 1) * 1024);
                    const bf16x8 al0 = *(const LAS bf16x8*)(wsl + 16384 + u * 4096 + (kk * 2) * 1024), al1 = *(const LAS bf16x8*)(wsl + 16384 + u * 4096 + (kk * 2 + 1) * 1024);
                    acc0 = __builtin_amdgcn_mfma_f32_16x16x32_bf16(ah0, bh_, acc0, 0, 0, 0); acc0 = __builtin_amdgcn_mfma_f32_16x16x32_bf16(ah0, bl_, acc0, 0, 0, 0); acc0 = __builtin_amdgcn_mfma_f32_16x16x32_bf16(al0, bh_, acc0, 0, 0, 0);
                    acc1 = __builtin_amdgcn_mfma_f32_16x16x32_bf16(ah1, bh_, acc1, 0, 0, 0); acc1 = __builtin_amdgcn_mfma_f32_16x16x32_bf16(ah1, bl_, acc1, 0, 0, 0); acc1 = __builtin_amdgcn_mfma_f32_16x16x32_bf16(al1, bh_, acc1, 0, 0, 0);
                }
                __builtin_amdgcn_sched_barrier(0);
            }
        }
#undef P7_LOADX
#undef P7_DMA
#undef P7_G16
#define P7_RED(x) do { x += __shfl_xor(x, 1); x += __shfl_xor(x, 2); x += __shfl_xor(x, 4); x += __shfl_xor(x, 8); x = 1.0f / sqrtf(x * (1.f / DM) + EPS); } while (0)
        P7_RED(ss0); P7_RED(ss1); P7_RED(ss2); P7_RED(ss3);
#undef P7_RED
        if (c == 0) { lr[g4] = ss0; lr[4 + g4] = ss1; lr[8 + g4] = ss2; lr[12 + g4] = ss3;
            RSTD[tok0 + g4] = ss0; RSTD[tok0 + 4 + g4] = ss1; RSTD[tok0 + 8 + g4] = ss2; RSTD[tok0 + 12 + g4] = ss3; }
        const float rs = lr[c];
        float v[8];
#pragma unroll
        for (int j = 0; j < 4; ++j) { v[j] = acc0[j] * rs + F.router_b[4 * g4 + j]; v[4 + j] = acc1[j] * rs + F.router_b[16 + 4 * g4 + j]; }
        float sv[4]; int si[4];
#pragma unroll
        for (int k = 0; k < 4; ++k) {
            float bv = v[0]; int bi = 4 * g4;
#pragma unroll
            for (int j = 1; j < 8; ++j) { const int ce = (j < 4) ? (4 * g4 + j) : (16 + 4 * g4 + j - 4); if (v[j] > bv) { bv = v[j]; bi = ce; } }
            { const float ov = __shfl_xor(bv, 16); const int oi = __shfl_xor(bi, 16); if (ov > bv || (ov == bv && oi < bi)) { bv = ov; bi = oi; } }
            { const float ov = __shfl_xor(bv, 32); const int oi = __shfl_xor(bi, 32); if (ov > bv || (ov == bv && oi < bi)) { bv = ov; bi = oi; } }
            sv[k] = bv; si[k] = bi;
#pragma unroll
            for (int j = 0; j < 8; ++j) { const int ce = (j < 4) ? (4 * g4 + j) : (16 + 4 * g4 + j - 4); if (ce == bi) v[j] = -3.0e38f; }
        }
        const float e1 = __expf(sv[1] - sv[0]), e2 = __expf(sv[2] - sv[0]), e3 = __expf(sv[3] - sv[0]);
        const float isum = 1.0f / (1.0f + e1 + e2 + e3);
        const int tok = tok0 + c;
        if (g4 == 0) { *(int4*)(TOPI + (size_t)tok * 4) = make_int4(si[0], si[1], si[2], si[3]); *(f32x4*)(TOPW + (size_t)tok * 4) = (f32x4){isum, e1 * isum, e2 * isum, e3 * isum}; }
        int cnt = 0;
#pragma unroll 4
        for (int e = 0; e < 32; ++e) { const bool has = (g4 == 0) && (si[0] == e || si[1] == e || si[2] == e || si[3] == e);
            const unsigned long long bm = __ballot(has); if (lane == e) cnt = __popcll(bm); }
        if (lane < 32 && cnt > 0) atomicAdd(HIST + (tile >> 1) * 32 + lane, cnt);
    }
}

DI void p8_dispatch(Frame& F) {
    const int* TOPI = (const int*)(F.ws + WS_SMALL + SM_TOPI); const float* TOPW = (const float*)(F.ws + WS_SMALL + SM_TOPW); const int* HIST = (const int*)(F.ws + WS_CTL + CTL_HIST); const float* RSTD = (const float*)(F.ws + WS_SMALL + SM_RSTD); float* ROWS = (float*)(F.ws + WS_SMALL + SM_ROWS);
    int* POS = (int*)(F.ws + WS_SMALL + SM_POS); int* ROWTOK = (int*)(F.ws + WS_SMALL + SM_ROWTOK); float* ROWW = (float*)(F.ws + WS_SMALL + SM_ROWW); int* TILEE = (int*)(F.ws + WS_SMALL + SM_TILEE);
    LAS int* pre = (LAS int*)F.lds;
    LAS int* seg = (LAS int*)(F.lds + MISC_OFF);
    for (int i = F.tid; i < 1024 * 32; i += NTHR) pre[i] = HIST[i];
    __syncthreads();
    { const int e = F.tid & 31, sg = F.tid >> 5; int run = 0;
      for (int i = 0; i < 64; ++i) { const int idx = (sg * 64 + i) * 32 + e; const int v = pre[idx]; pre[idx] = run; run += v; }
      seg[sg * 32 + e] = run; }
    __syncthreads();
    { const int e = F.tid & 31, sg = F.tid >> 5; int base = 0;
      for (int j = 0; j < sg; ++j) base += seg[j * 32 + e];
      for (int i = 0; i < 64; ++i) pre[(sg * 64 + i) * 32 + e] += base;
      if (sg == 15) seg[512 + e] = base + seg[15 * 32 + e]; }
    __syncthreads();
    if (F.tid == 0) { int ps = 0; for (int e = 0; e < 32; ++e) { const int c = seg[512 + e], pc = (c + 255) & ~255; seg[544 + e] = ps; seg[576 + e] = pc; ps += pc; } seg[608] = ps >> 8; }
    __syncthreads();
    const int NT = seg[608];
    const int gw = F.vcu * NWAVES + F.wave, NGW = F.G * NWAVES, lane = F.lane;
    for (int tile = gw; tile < 1024; tile += NGW) {
        const int tok = 32 * tile + (lane & 31);
        const int4 ti = *(const int4*)(TOPI + (size_t)tok * 4); const f32x4 tw = *(const f32x4*)(TOPW + (size_t)tok * 4);
        const int ek = (lane < 32) ? ti.x : ti.y, ek2 = (lane < 32) ? ti.z : ti.w;
        int rk = 0, rk2 = 0;
        for (int e = 0; e < 32; ++e) { const bool has = (lane < 32) && (ti.x == e || ti.y == e || ti.z == e || ti.w == e);
            const unsigned long long bm = __ballot(has); const int below = __popcll(bm & ((1ull << (lane & 31)) - 1ull));
            if (ek == e) rk = below; if (ek2 == e) rk2 = below; }
        const int d1 = seg[544 + ek] + pre[tile * 32 + ek] + rk, d2 = seg[544 + ek2] + pre[tile * 32 + ek2] + rk2;
        const int k1 = (lane < 32) ? 0 : 1, k2 = k1 + 2;
        const float rsd = RSTD[tok];
        ROWTOK[d1] = tok; ROWW[d1] = (lane < 32) ? tw[0] : tw[1]; ROWS[d1] = rsd; POS[(size_t)tok * 4 + k1] = d1;
        ROWTOK[d2] = tok; ROWW[d2] = (lane < 32) ? tw[2] : tw[3]; ROWS[d2] = rsd; POS[(size_t)tok * 4 + k2] = d2;
    }
    if (F.vcu < 32) { const int e = F.vcu, c = seg[512 + e], ps = seg[544 + e], pc = seg[576 + e];
        for (int i = c + F.tid; i < pc; i += NTHR) { ROWTOK[ps + i] = 0; ROWW[ps + i] = 0.f; ROWS[ps + i] = 0.f; } }
    if (F.vcu == 32 % F.G) { for (int rt = F.tid; rt < MAXRT; rt += NTHR) { int e = 31; for (int j = 31; j >= 0; --j) if (rt * 256 < seg[544 + j] + seg[576 + j] && seg[576 + j] > 0 && rt * 256 >= seg[544 + j]) e = j; TILEE[rt] = e; }
        if (F.tid == 0) TILEE[MAXRT] = NT; }
    __syncthreads();
}

DI void p11_combine(Frame& F) {
    const int* POS = (const int*)(F.ws + WS_SMALL + SM_POS); const unsigned char* YB = F.ws + WS_YB;
    const int gw = F.vcu * NWAVES + F.wave, NGW = F.G * NWAVES;
    for (int tok = gw; tok < NTOK; tok += NGW) {
        const int4 ps = *(const int4*)(POS + (size_t)tok * 4);
        f32x4* orow = (f32x4*)(F.out + (size_t)tok * DM) + F.lane;
        const unsigned* y0 = (const unsigned*)(YB + (size_t)ps.x * DM) + F.lane; const unsigned* y1 = (const unsigned*)(YB + (size_t)ps.y * DM) + F.lane;
        const unsigned* y2 = (const unsigned*)(YB + (size_t)ps.z * DM) + F.lane; const unsigned* y3 = (const unsigned*)(YB + (size_t)ps.w * DM) + F.lane;
#pragma unroll
        for (int j = 0; j < 8; ++j) { f32x4 v = orow[64 * j]; const unsigned a = y0[64 * j], bq = y1[64 * j], cq = y2[64 * j], dq = y3[64 * j];
            const f32x2 a0 = __builtin_amdgcn_cvt_pk_f32_fp8((int)a, false), a1 = __builtin_amdgcn_cvt_pk_f32_fp8((int)a, true), b0 = __builtin_amdgcn_cvt_pk_f32_fp8((int)bq, false), b1 = __builtin_amdgcn_cvt_pk_f32_fp8((int)bq, true);
            const f32x2 c0 = __builtin_amdgcn_cvt_pk_f32_fp8((int)cq, false), c1 = __builtin_amdgcn_cvt_pk_f32_fp8((int)cq, true), d0 = __builtin_amdgcn_cvt_pk_f32_fp8((int)dq, false), d1 = __builtin_amdgcn_cvt_pk_f32_fp8((int)dq, true);
            v[0] += (((a0[0] + b0[0]) + c0[0]) + d0[0]) * 0.0625f; v[1] += (((a0[1] + b0[1]) + c0[1]) + d0[1]) * 0.0625f;
            v[2] += (((a1[0] + b1[0]) + c1[0]) + d1[0]) * 0.0625f; v[3] += (((a1[1] + b1[1]) + c1[1]) + d1[1]) * 0.0625f; orow[64 * j] = v; }
    }
}

constexpr int NPHASE = 12;
__global__ void __launch_bounds__(NTHR, 2) mk_fwd(Args args) {
    extern __shared__ __attribute__((aligned(16))) unsigned char lds_raw[];
    Frame F;
    F.lds = (LAS unsigned char*)lds_raw;
    F.tid = threadIdx.x; F.lane = F.tid & 63; F.wave = __builtin_amdgcn_readfirstlane(F.tid >> 6);
    F.G = gridDim.x; { const int bx = blockIdx.x; F.vcu = (F.G % 8 == 0) ? (bx % 8) * (F.G / 8) + bx / 8 : bx; }
    F.x = args.in[0]; F.attn_g = args.in[1]; F.w_in = args.in[2]; F.qg = args.in[3]; F.kg = args.in[4]; F.conv_w = args.in[5]; F.conv_b = args.in[6]; F.i_b = args.in[7]; F.f_b = args.in[8];
    F.mlout_g = args.in[9]; F.w_out = args.in[10]; F.ffn_g = args.in[11]; F.router_w = args.in[12]; F.router_b = args.in[13]; F.w_up = args.in[14]; F.b_up = args.in[15]; F.w_down = args.in[16]; F.b_down = args.in[17];
    F.out = args.out; F.ws = args.ws;
    volatile LAS unsigned* MISCW = (volatile LAS unsigned*)(F.lds + LDS_BYTES - 64);
    if (F.tid < 16) MISCW[F.tid] = 0u;
    __syncthreads();
    XcdBarrier bar; bar.bar = (unsigned*)(F.ws + WS_CTL) + CW_BAR; bar.x = 0; bar.st = nullptr;
    if (N_LAUNCHES == 1) bar = xcd_barrier_post((unsigned*)(F.ws + WS_CTL) + CW_BAR, MISCW);
    const int lo = args.ph_lo, hi = args.ph_hi;
#ifndef PHASE_MASK
#define PHASE_MASK 0xfff
#endif
#define IN(k) ((((PHASE_MASK) >> (k)) & 1) && lo <= (k) && (k) < hi)
#define SEAM(k) do { if (IN(k) && IN((k) + 1)) xcd_barrier(bar); } while (0)

    if (IN(0)) { p0_prologue(F); } SEAM(0);
    if (IN(1)) {
        const int NGEMM = (F.G == 256) ? 192 : F.G;
        if ((int)blockIdx.x < NGEMM) { pg8::Gemm g{(const bf16*)(F.ws + WS_XN), (const bf16*)(F.ws + WS_WIN), DM, 0, nullptr, nullptr, nullptr, nullptr}; pg8::StaticOrder S; S.init(NTOK / 256, NPROJ / 256, NGEMM, (int)blockIdx.x);
            pg8::EpiProj E{(bf16*)(F.ws + WS_PROJ), NPROJ, F.qg, F.kg, (const float*)(F.ws + WS_SMALL + SM_ROPE), (LAS float*)(F.lds + MISC_OFF), (bf16*)(F.ws + WS_HM)}; pg8::gemm_phase<pg8::EpiProj, false, false, false>(F.lds, g, S, E);
            { VM_WAIT(); __syncthreads();
              if (F.tid == 0) { unsigned* ctr = (unsigned*)(F.ws + WS_CTL) + CW_SUB; __builtin_amdgcn_fence(__ATOMIC_RELEASE, "agent"); VM_WAIT(); xb_add(ctr, 1u);
                  unsigned sp = 0; while (xb_ld(ctr) < (unsigned)NGEMM) { __builtin_amdgcn_s_sleep(2); if (++sp > (1u << 22)) break; }
                  __builtin_amdgcn_fence(__ATOMIC_ACQUIRE, "agent"); VM_WAIT(); }
              __syncthreads(); }
            p2_conv(F, (int)blockIdx.x, NGEMM); }
        if (F.G == 256) { if ((int)blockIdx.x >= NGEMM) p0_expert_weights(F, (int)blockIdx.x - NGEMM, F.G - NGEMM); }
        else p0_expert_weights(F, F.vcu, F.G);
    } SEAM(1);
    if (IN(3)) {
#ifndef SKIP_ML
        for (int u = F.vcu; u < 1024; u += F.G) mlstm_m1_unit(F, u);
#endif
#ifndef SKIP_ATTN
        attn_phase<1, true, false>(F);
#endif
    } SEAM(3);
    if (IN(4)) {
#ifndef SKIP_ML
        mlstm_scan(F);
#endif
#ifndef SKIP_ATTN
        attn_phase<4, false, false>(F);
#endif
    } SEAM(4);
    if (IN(5)) {
#ifndef SKIP_ML
        for (int u = F.vcu; u < 1024; u += F.G) mlstm_m3_unit(F, u);
#endif
#ifndef SKIP_ATTN
        attn_phase<16, false, true>(F);
#endif
    } SEAM(5);
    if (IN(6)) { pg8::Gemm g{(const bf16*)(F.ws + WS_MIX), (const bf16*)(F.ws + WS_WOUT), DM, 0, nullptr, nullptr, nullptr, nullptr}; pg8::StaticOrder S; S.init(NTOK / 256, DM / 256, F.G, (int)blockIdx.x);
        pg8::EpiResid E{F.x, F.out, DM}; pg8::gemm_phase<pg8::EpiResid, false, false, false>(F.lds, g, S, E); } SEAM(6);
    if (IN(7)) { p7_router(F); } SEAM(7);
    if (IN(8)) { p8_dispatch(F); } SEAM(8);
    if (IN(9) || IN(10)) {
        LAS int* te = (LAS int*)(F.lds + MISC_OFF);
        const int* TILEE = (const int*)(F.ws + WS_SMALL + SM_TILEE);
        __syncthreads();
        for (int i = F.tid; i <= MAXRT; i += NTHR) te[i] = (int)__hip_atomic_load(TILEE + i, __ATOMIC_RELAXED, __HIP_MEMORY_SCOPE_AGENT);
        __syncthreads();
        const int NT = te[MAXRT];
        if (IN(9)) { pg8::Gemm g{(const bf16*)(F.ws + WS_XN), (const bf16*)(F.ws + WS_WUP), DM / 2, (size_t)UPW * DM, (const int*)(F.ws + WS_SMALL + SM_ROWTOK), te, F.lds + MISC_OFF + 4096, F.lds + ESTASH_OFF};   pg8::StaticOrder S; S.init(NT, UPW / 256, F.G, (int)blockIdx.x);
            pg8::EpiUp E{F.ws + WS_ACT, F.b_up, (const float*)(F.ws + WS_SMALL + SM_ROWS)}; pg8::gemm_phase<pg8::EpiUp, true, true, true>(F.lds, g, S, E); }
        SEAM(9);
        if (IN(10)) { pg8::Gemm g{(const bf16*)(F.ws + WS_ACT), (const bf16*)(F.ws + WS_WDN), FF / 2, (size_t)DM * FF, nullptr, te, nullptr, F.lds + ESTASH_OFF}; pg8::StaticOrder S; S.init(NT, DM / 256, F.G, (int)blockIdx.x);
            pg8::EpiDown E{F.ws + WS_YB, F.b_down, (const float*)(F.ws + WS_SMALL + SM_ROWW)}; pg8::gemm_phase<pg8::EpiDown, false, true, true>(F.lds, g, S, E); }
    }
    SEAM(10);
    if (IN(11)) { p11_combine(F); }
#undef IN
#undef SEAM
}

extern "C" void kernel_launch(void* const* d_in, const int* in_sizes, int n_in, void* d_out, int out_size, void* d_ws, size_t ws_size, hipStream_t stream) {
    static int grid = 0;
    if (grid == 0) {
        if (n_in != 18 || out_size != NTOK * DM || ws_size < WS_END) { fprintf(stderr, "kernel_launch: unexpected shapes (n_in %d, out %d, ws %zu)\n", n_in, out_size, ws_size); grid = -1; return; }
        int dev = 0, cus = 0, per_cu = 0;
        if (hipGetDevice(&dev) != hipSuccess || hipDeviceGetAttribute(&cus, hipDeviceAttributeMultiprocessorCount, dev) != hipSuccess) { grid = -1; return; }
        if (hipFuncSetAttribute((const void*)mk_fwd, hipFuncAttributeMaxDynamicSharedMemorySize, LDS_BYTES) != hipSuccess) { fprintf(stderr, "kernel_launch: hipFuncSetAttribute failed\n"); grid = -1; return; }
        if (hipOccupancyMaxActiveBlocksPerMultiprocessor(&per_cu, (const void*)mk_fwd, NTHR, LDS_BYTES) != hipSuccess || per_cu < 1) fprintf(stderr, "kernel_launch: occupancy query says %d\n", per_cu);
        (void)hipGetLastError();
        grid = cus;
    }
    if (grid < 0) return;
    (void)hipMemsetAsync((char*)d_ws + WS_CTL, 0, CTL_ZERO_BYTES, stream);
    Args a{};
    for (int i = 0; i < 18; ++i) a.in[i] = (const float*)d_in[i];
    a.out = (float*)d_out; a.ws = (unsigned char*)d_ws;
    if (N_LAUNCHES == 1) { a.ph_lo = 0; a.ph_hi = PH_STOP; hipLaunchKernelGGL(mk_fwd, dim3(grid), dim3(NTHR), LDS_BYTES, stream, a); }
    else { for (int ph = 0; ph < PH_STOP; ++ph) { a.ph_lo = ph; a.ph_hi = ph + 1; hipLaunchKernelGGL(mk_fwd, dim3(grid), dim3(NTHR), LDS_BYTES, stream, a); } }
}
```

```cpp
#include <hip/hip_runtime.h>
#include <cstdio>
#include <cstdint>

#ifndef N_LAUNCHES
#define N_LAUNCHES 1
#endif
#ifndef PH_STOP
#define PH_STOP 12
#endif

#define DI __device__ __forceinline__
#define GAS __attribute__((address_space(1)))
#define LAS __attribute__((address_space(3)))
typedef unsigned short bf16;
typedef short bf16x8 __attribute__((ext_vector_type(8)));
typedef short s16x4 __attribute__((ext_vector_type(4)));
typedef float f32x4 __attribute__((ext_vector_type(4)));
typedef float f32x2 __attribute__((ext_vector_type(2)));
typedef float f32x16 __attribute__((ext_vector_type(16)));
typedef unsigned u32x4 __attribute__((ext_vector_type(4)));
typedef unsigned u32x2 __attribute__((ext_vector_type(2)));
typedef __bf16 bf16x2_t __attribute__((ext_vector_type(2)));
typedef GAS unsigned gu32;

constexpr int SEQ = 16384, NBATCH = 2, NTOK = NBATCH * SEQ, DM = 2048, NPROJ = 6144, INW = 6152;
constexpr int COL_AQ = 0, COL_AK = 1024, COL_AV = 2048, COL_MQ = 3072, COL_MK = 3584, COL_MV = 4096, COL_MO = 5120;
constexpr int NE = 32, FF = 2048, UPW = 4096;
constexpr int MAXRT = 544, MAXSLOT = MAXRT * 256;
constexpr int NCH = 128;
constexpr float EPS = 1e-6f;
constexpr float QSCALE = 0.08838834764831845f;

constexpr size_t MiB = 1u << 20;
constexpr size_t WS_CTL = 0, CTL_ZERO_BYTES = 1 * MiB;
constexpr size_t WS_WIN = 2 * MiB;
constexpr size_t WS_WOUT = 26 * MiB;
constexpr size_t WS_RWT = 34 * MiB;
constexpr size_t WS_GATES = 35 * MiB;
constexpr size_t WS_SMALL = 36 * MiB;
constexpr size_t WS_WUP = 64 * MiB;
constexpr size_t WS_WDN = 576 * MiB;
constexpr size_t WS_XN = 832 * MiB;
constexpr size_t WS_PROJ = 960 * MiB;
constexpr size_t WS_QC = 1344 * MiB;
constexpr size_t WS_KC = 1376 * MiB;
constexpr size_t WS_CLOC = 1408 * MiB;
constexpr size_t WS_CPREV = 1536 * MiB;
constexpr size_t WS_OST = 1600 * MiB;
constexpr size_t WS_ML = 1728 * MiB;
constexpr size_t WS_MIX = 1732 * MiB;
constexpr size_t WS_ACT = 1860 * MiB;
constexpr size_t WS_YB = 2404 * MiB;
constexpr size_t WS_HM = WS_YB + 272 * MiB;
constexpr size_t HM_PLANE = (size_t)NTOK * 1024;
constexpr size_t WS_END = 2948 * MiB;
constexpr size_t SM_NLOC = 0;
constexpr size_t SM_NPREV = 512 * 1024;
constexpr size_t SM_G = 1024 * 1024;
constexpr size_t SM_MLOC = SM_G + 4096;
constexpr size_t SM_MPREV = SM_MLOC + 4096;
constexpr size_t SM_TOPI = SM_MPREV + 4096;
constexpr size_t SM_TOPW = SM_TOPI + 512 * 1024;
constexpr size_t SM_HIST = SM_TOPW + 512 * 1024;
constexpr size_t SM_POS = SM_HIST + 128 * 1024;
constexpr size_t SM_ROWTOK = SM_POS + 512 * 1024;
constexpr size_t SM_ROWW = SM_ROWTOK + 544 * 1024;
constexpr size_t SM_TILEE = SM_ROWW + 544 * 1024;
constexpr size_t SM_RSTD = SM_TILEE + 4096;
constexpr size_t SM_ROWS = SM_RSTD + 128 * 1024;
constexpr size_t SM_ROPE = SM_ROWS + 544 * 1024;
static_assert(SM_ROPE + 2 * MiB <= 16 * MiB, "small tables (WS_SMALL .. WS_WUP is 28 MiB)");
constexpr size_t CTL_HIST = 256 * 1024;
constexpr int CW_BAR = 4096, CW_SUB = 8192;

constexpr int RING_BYTES = 131072, MISC_OFF = RING_BYTES, ESTASH_OFF = MISC_OFF + 16384, LDS_BYTES = ESTASH_OFF + 8 * 768 + 64;
constexpr int NWAVES = 8, NTHR = 512;

DI unsigned cvtpk(float lo, float hi) { f32x2 v = {lo, hi}; bf16x2_t b = __builtin_convertvector(v, bf16x2_t); return __builtin_bit_cast(unsigned, b); }
DI unsigned pk4_fp8(float a, float b, float c, float d) {
    a = fminf(fmaxf(a, -448.f), 448.f); b = fminf(fmaxf(b, -448.f), 448.f); c = fminf(fmaxf(c, -448.f), 448.f); d = fminf(fmaxf(d, -448.f), 448.f);
    int v = __builtin_amdgcn_cvt_pk_fp8_f32(a, b, 0, false); v = __builtin_amdgcn_cvt_pk_fp8_f32(c, d, v, true); return (unsigned)v; }
DI unsigned pk4_fp8m(float a, float b, float c, float d) {
    a = __builtin_amdgcn_fmed3f(a, -448.f, 448.f); b = __builtin_amdgcn_fmed3f(b, -448.f, 448.f); c = __builtin_amdgcn_fmed3f(c, -448.f, 448.f); d = __builtin_amdgcn_fmed3f(d, -448.f, 448.f);
    int v = __builtin_amdgcn_cvt_pk_fp8_f32(a, b, 0, false); v = __builtin_amdgcn_cvt_pk_fp8_f32(c, d, v, true); return (unsigned)v; }
DI void swap32(u32x2& a, u32x2& b) {
    const auto r0 = __builtin_amdgcn_permlane32_swap(a.x, b.x, false, false); const auto r1 = __builtin_amdgcn_permlane32_swap(a.y, b.y, false, false);
    a.x = r0[0]; b.x = r0[1]; a.y = r1[0]; b.y = r1[1]; }
DI float bf2f(unsigned short b) { return __uint_as_float(((unsigned)b) << 16); }
DI float wave_sum(float v) {
#pragma unroll
    for (int o = 1; o < 64; o <<= 1) v += __shfl_xor(v, o);
    return v;
}
DI float wave_max(float v) {
#pragma unroll
    for (int o = 1; o < 64; o <<= 1) v = fmaxf(v, __shfl_xor(v, o));
    return v;
}
DI f32x16 mfma32(bf16x8 a, bf16x8 b, f32x16 c) { return __builtin_amdgcn_mfma_f32_32x32x16_bf16(a, b, c, 0, 0, 0); }
DI int crow(int reg, int h) { return (reg & 3) + 8 * (reg >> 2) + 4 * h; }
DI int img_off(int row, int ch) { return 256 * row + 16 * (ch ^ (((row & 3) << 2) | ((row >> 2) & 3))); }
typedef short v4i16_t __attribute__((ext_vector_type(4)));
DI s16x4 tr16(const LAS unsigned char* p) { return __builtin_bit_cast(s16x4, __builtin_amdgcn_ds_read_tr16_b64_v4i16((LAS v4i16_t*)p)); }
DI bf16x8 tr_frag(const LAS unsigned char* img, int r0a, int r0b, int cch, int q, int p) {
    const s16x4 lo = tr16(img + img_off(r0a + q, cch + (p >> 1)) + 8 * (p & 1));
    const s16x4 hi = tr16(img + img_off(r0b + q, cch + (p >> 1)) + 8 * (p & 1));
    return __builtin_shufflevector(lo, hi, 0, 1, 2, 3, 4, 5, 6, 7);
}
DI int tr_base(int rlane, int cch, int q, int p) { return img_off(rlane + q, cch + (p >> 1)) + 8 * (p & 1); }
DI bf16x8 tr_frag2(const LAS unsigned char* img, int ba, int bb, int off) { const s16x4 lo = tr16(img + ba + off), hi = tr16(img + bb + off); return __builtin_shufflevector(lo, hi, 0, 1, 2, 3, 4, 5, 6, 7); }
DI bf16x8 row_frag(const LAS unsigned char* img, int row, int ch) { return *(const LAS bf16x8*)(img + img_off(row, ch)); }
#define LDS_WAIT() asm volatile("s_waitcnt lgkmcnt(0)" ::: "memory")
#define VM_WAIT() asm volatile("s_waitcnt vmcnt(0)" ::: "memory")

#define XB_TMO      128
#define XB_XCNT(j)  (256  + 64 * (j))
#define XB_XSUB(j)  (1280 + 64 * (j))
#define XB_XGEN(j)  (2304 + 64 * (j))
#define XB_TOP      3328
#define XB_TOPGEN   3392
#define XCD_BAR_WORDS 3456
#define XB_SPIN_CAP (1u << 18)
DI unsigned xb_ld(unsigned* p)              { return __hip_atomic_load(p, __ATOMIC_RELAXED, __HIP_MEMORY_SCOPE_AGENT); }
DI unsigned xb_add(unsigned* p, unsigned v) { return __hip_atomic_fetch_add(p, v, __ATOMIC_RELAXED, __HIP_MEMORY_SCOPE_AGENT); }
DI unsigned xb_xcc_id() { return (unsigned)__builtin_amdgcn_s_getreg((3 << 11) | 20) & 0xFu; }
#define XB_SPIN(cond, bar) do { unsigned _sp = 0; while (cond) { __builtin_amdgcn_s_sleep(1); \
    if ((++_sp & 255u) == 0u) { if (xb_ld(&(bar)[XB_TMO])) break; if (_sp > XB_SPIN_CAP) { atomicAdd(&(bar)[XB_TMO], 1u); break; } } } } while (0)
struct XcdBarrier { unsigned* bar; unsigned x; volatile LAS unsigned* st; };
DI XcdBarrier xcd_barrier_post(unsigned* bar, volatile LAS unsigned* st) {
    XcdBarrier b; b.bar = bar; b.x = xb_xcc_id(); b.st = st;
    if (threadIdx.x == 0) (void)xb_add(&bar[XB_XCNT(b.x)], 1u);
    return b;
}
DI void xcd_barrier_complete(unsigned* bar, unsigned x, unsigned& nloc, unsigned& nx) {
    const unsigned G = gridDim.x * gridDim.y * gridDim.z;
    unsigned sum, cnt, mine, sp = 0u;
    for (;;) {
        sum = 0u; cnt = 0u; mine = 0u;
#pragma unroll
        for (unsigned j = 0; j < 16; ++j) { const unsigned c = xb_ld(&bar[XB_XCNT(j)]); sum += c; cnt += (c > 0u) ? 1u : 0u; mine = (j == x) ? c : mine; }
        if (sum == G) break;
        __builtin_amdgcn_s_sleep(1);
        if ((++sp & 255u) == 0u) { if (xb_ld(&bar[XB_TMO])) break; if (sp > XB_SPIN_CAP) { atomicAdd(&bar[XB_TMO], 1u); break; } }
    }
    nloc = mine > 0u ? mine : 1u; nx = cnt > 0u ? cnt : 1u;
}
DI void xcd_barrier(const XcdBarrier& b) {
    asm volatile("s_waitcnt vmcnt(0)" ::: "memory");
    __syncthreads();
    if (threadIdx.x == 0) {
        unsigned* bar = b.bar;
        __builtin_amdgcn_s_waitcnt(0);
        unsigned nloc = b.st[0], nx = b.st[1];
        if (nloc == 0u) { xcd_barrier_complete(bar, b.x, nloc, nx); b.st[0] = nloc; b.st[1] = nx; }
        const unsigned old = xb_add(&bar[XB_XSUB(b.x)], 1u);
        const unsigned gen = old / nloc;
        if (old + 1u == (gen + 1u) * nloc) {
            __builtin_amdgcn_fence(__ATOMIC_RELEASE, "agent");
            asm volatile("s_waitcnt vmcnt(0)" ::: "memory");
            const unsigned og = xb_add(&bar[XB_TOP], 1u);
            const unsigned tg = og / nx;
            if (og + 1u == (tg + 1u) * nx) xb_add(&bar[XB_TOPGEN], 1u);
            else XB_SPIN(xb_ld(&bar[XB_TOPGEN]) == tg, bar);
            __builtin_amdgcn_fence(__ATOMIC_ACQUIRE, "agent");
            xb_add(&bar[XB_XGEN(b.x)], 1u);
            asm volatile("s_waitcnt vmcnt(0)" ::: "memory");
        } else {
            XB_SPIN(xb_ld(&bar[XB_XGEN(b.x)]) == gen, bar);
            __builtin_amdgcn_fence(__ATOMIC_ACQUIRE, "agent");
            asm volatile("s_waitcnt vmcnt(0)" ::: "memory");
        }
    }
    __syncthreads();
}

struct Args { const float* in[18]; float* out; unsigned char* ws; int ph_lo, ph_hi; };
struct Frame {
    LAS unsigned char* lds; int tid, lane, wave, vcu, G;
    const float *x, *attn_g, *w_in, *qg, *kg, *conv_w, *conv_b, *i_b, *f_b, *mlout_g, *w_out, *ffn_g, *router_w, *router_b, *w_up, *b_up, *w_down, *b_down;
    float* out; unsigned char* ws;
};

namespace pg8 {
typedef int v8i32 __attribute__((ext_vector_type(8)));
constexpr int BM = 256, BK = 64, HALF = 128, HTB = HALF * BK * 2, STAGE_BYTES = 8 * HTB, NXCD = 8, WGM = 8;
DI int lds_byte(int r, int c) { const int st = (r >> 4) * 2 + (c >> 5), rr = r & 15, cc = c & 31, ob = rr * 64 + cc * 2; return st * 1024 + (ob ^ (((ob >> 9) & 1) << 5)); }
DI void stage_rc(int b, int& R, int& C) { const int st = b / 1024, sb = b % 1024, swz = sb ^ (((sb >> 9) & 1) << 5); R = (st >> 1) * 16 + swz / 64; C = (st & 1) * 32 + (swz % 64) / 2; }
DI int perm32(int rho) { const int n = rho >> 4, i = rho & 15; return 8 * (i >> 2) + 4 * n + (i & 3); }
DI const char* sptr(const char* p) { const unsigned long long v = (unsigned long long)p; const unsigned lo = __builtin_amdgcn_readfirstlane((unsigned)v), hi = __builtin_amdgcn_readfirstlane((unsigned)(v >> 32)); return (const char*)(((unsigned long long)hi << 32) | lo); }
struct Unit { int pm, pn, e; };
struct Gemm { const bf16* A; const bf16* Bt; int K; size_t estride; const int* rowtok; const LAS int* tile_e; LAS unsigned char* stash; LAS unsigned char* estash; };
struct StaticOrder {
    int nM, nN, nwg, G, c;
    DI void init(int nM_, int nN_, int G_, int c_) { nM = nM_; nN = nN_; nwg = nM * nN; G = G_; c = c_; }
    DI bool next(int i, Unit& u) const {
        const long L = (long)i * G + c; if (L >= nwg) return false;
        int wgid = (int)L; { const int q = nwg / NXCD, r = nwg % NXCD, xcd = wgid % NXCD, off = wgid / NXCD; wgid = (xcd < r ? xcd * (q + 1) : r * (q + 1) + (xcd - r) * q) + off; }
        const int nig = WGM * nN, gid = wgid / nig, fm = gid * WGM, gsz = (nM - fm) < WGM ? (nM - fm) : WGM;
        u.pm = fm + ((wgid % nig) % gsz); u.pn = (wgid % nig) / gsz; u.e = 0; return true;
    }
};
template <class Epi, bool GATHER, bool EXPERT, bool FP8>
DI void gemm_phase(LAS unsigned char* lds, const Gemm g, const StaticOrder& S, const Epi& E) {
    const int tid = threadIdx.x, wid = __builtin_amdgcn_readfirstlane(tid >> 6), lane = tid & 63, wr = wid >> 2, wc = wid & 3, fr = lane & 15, fq = lane >> 4;
    const int K = g.K, nt = K / BK;
    unsigned voffB[2], coffA[2][2];
    const size_t kstep = (size_t)(BK * 2), hstep = (size_t)HALF * K * 2, tstep = 2 * hstep;
#pragma unroll
    for (int i = 0; i < 2; ++i) { int R, C; stage_rc(tid * 16 + i * 8192, R, C); const int Rb = Epi::PERM ? ((R & ~31) + perm32(R & 31)) : R;
        voffB[i] = (unsigned)(Rb * K + C) * 2u; }
    const unsigned ldsw = (unsigned)wid * 1024u;
    const int aoff = lds_byte(wr * 64 + fr, fq * 8), boff = lds_byte(wc * 32 + fr, fq * 8);
#define PG8_SA(b, h) (((b) * 2 + (h)) * HTB)
#define PG8_SB(b, h) ((4 + (b) * 2 + (h)) * HTB)
#define PG8_GLDS(gp, lp) __builtin_amdgcn_global_load_lds((const unsigned*)(gp), (LAS unsigned*)(lp), 16, 0, 0)
#define PG8_OPQ(x) ({ unsigned o_ = (x); asm volatile("" : "+v"(o_)); o_; })
#define PG8_STAGE_B(bufoff, gbase) do { const char* sb_ = (const char*)(gbase); PG8_GLDS(sb_ + PG8_OPQ(voffB[0]), lds + (bufoff) + ldsw); PG8_GLDS(sb_ + PG8_OPQ(voffB[1]), lds + (bufoff) + ldsw + 8192); } while (0)
#define PG8_STAGE_A(bufoff, gbase, o0, o1) do { const char* sb_ = (const char*)(gbase); PG8_GLDS(sb_ + PG8_OPQ(o0), lds + (bufoff) + ldsw); PG8_GLDS(sb_ + PG8_OPQ(o1), lds + (bufoff) + ldsw + 8192); } while (0)
#define PG8_LDA(dst, b, h) do { _Pragma("unroll") for (int m = 0; m < 4; ++m) _Pragma("unroll") for (int k = 0; k < 2; ++k) dst[m][k] = *(const LAS bf16x8*)(lds + PG8_SA(b, h) + aoff + m * 2048 + k * 1024); } while (0)
#define PG8_LDB(dst, b, h) do { _Pragma("unroll") for (int n = 0; n < 2; ++n) _Pragma("unroll") for (int k = 0; k < 2; ++k) dst[n][k] = *(const LAS bf16x8*)(lds + PG8_SB(b, h) + boff + n * 2048 + k * 1024); } while (0)
#define PG8_CAT(x) __builtin_bit_cast(v8i32, __builtin_shufflevector(x[0], x[1], 0, 1, 2, 3, 4, 5, 6, 7, 8, 9, 10, 11, 12, 13, 14, 15))
#define PG8_MMA(ai, bj, At, Bt) do { __builtin_amdgcn_s_setprio(1); _Pragma("unroll") for (int m = 0; m < 4; ++m) _Pragma("unroll") for (int n = 0; n < 2; ++n) { \
        if (FP8) acc[ai][bj][m][n] = __builtin_amdgcn_mfma_scale_f32_16x16x128_f8f6f4(PG8_CAT(Bt[n]), PG8_CAT(At[m]), acc[ai][bj][m][n], 0, 0, 0, 0x7F7F7F7F, 0, 0x7F7F7F7F); \
        else { _Pragma("unroll") for (int k = 0; k < 2; ++k) acc[ai][bj][m][n] = __builtin_amdgcn_mfma_f32_16x16x32_bf16(Bt[n][k], At[m][k], acc[ai][bj][m][n], 0, 0, 0); } } \
        __builtin_amdgcn_s_setprio(0); \
        asm volatile("" : "+v"(acc[ai][bj][0][0]), "+v"(acc[ai][bj][0][1]), "+v"(acc[ai][bj][1][0]), "+v"(acc[ai][bj][1][1]), "+v"(acc[ai][bj][2][0]), "+v"(acc[ai][bj][2][1]), "+v"(acc[ai][bj][3][0]), "+v"(acc[ai][bj][3][1])); } while (0)
#define PG8_WAIT_V(n) asm volatile("s_waitcnt vmcnt(" #n ")" ::: "memory")
#define PG8_WAIT_L(n) asm volatile("s_waitcnt lgkmcnt(" #n ")" ::: "memory")
#define PG8_BAR __builtin_amdgcn_s_barrier()
#define PG8_SCHED __builtin_amdgcn_sched_barrier(0)
#define PG8_OFFS(dst, pm_) do { int t2_ = threadIdx.x; asm volatile("" : "+v"(t2_)); _Pragma("unroll") for (int i_ = 0; i_ < 2; ++i_) { int R_, C_; stage_rc(t2_ * 16 + i_ * 8192, R_, C_); \
        _Pragma("unroll") for (int h_ = 0; h_ < 2; ++h_) { \
        if (GATHER) dst[h_][i_] = (unsigned)g.rowtok[(pm_) * 256 + h_ * 128 + R_] * (unsigned)(K * 2) + (unsigned)(C_ * 2); \
        else dst[h_][i_] = (unsigned)((h_ * 128 + R_) * K + C_) * 2u; } } } while (0)
    Unit cur, nxt; int ui = 0;
    if (!S.next(0, cur)) return;
    if (EXPERT) cur.e = __builtin_amdgcn_readfirstlane(g.tile_e[cur.pm]);
    f32x4 acc[2][2][4][2];
#pragma unroll
    for (int a = 0; a < 2; ++a)
#pragma unroll
        for (int b = 0; b < 2; ++b)
#pragma unroll
            for (int m = 0; m < 4; ++m)
#pragma unroll
                for (int n = 0; n < 2; ++n) acc[a][b][m][n] = (f32x4){0.f, 0.f, 0.f, 0.f};
    bf16x8 At[4][2], B0[2][2], B1[2][2];
    PG8_OFFS(coffA, cur.pm);
    const char* cA = sptr((const char*)g.A + (GATHER ? (size_t)0 : (size_t)cur.pm * tstep));
    const char* cB = sptr((const char*)g.Bt + (size_t)cur.e * g.estride + (size_t)cur.pn * tstep);
    LAS unsigned char* est = g.estash + wid * 768;
    if (Epi::STASH) E.prefetch(cur, wr, wc, lane, est);
    LAS unsigned char* stash = g.stash + wid * 256;
    PG8_STAGE_B(PG8_SB(0, 0), cB); PG8_STAGE_B(PG8_SB(0, 1), cB + hstep); PG8_STAGE_A(PG8_SA(0, 0), cA, coffA[0][0], coffA[0][1]); PG8_STAGE_A(PG8_SA(0, 1), cA, coffA[1][0], coffA[1][1]);
    if (wr == 1) PG8_BAR;
    PG8_WAIT_V(2); PG8_BAR;
    PG8_STAGE_B(PG8_SB(1, 0), cB + kstep); PG8_STAGE_A(PG8_SA(1, 0), cA + kstep, coffA[0][0], coffA[0][1]); PG8_STAGE_B(PG8_SB(1, 1), cB + hstep + kstep);
    PG8_WAIT_V(6); PG8_BAR;
#define PG8_TRIP(a1, a2, b2, a3, b3, o00, o01, o10, o11) do { \
            PG8_LDB(B0, 0, 0); PG8_LDB(B1, 0, 1); PG8_SCHED; PG8_LDA(At, 0, 0); PG8_STAGE_A(PG8_SA(1, 1), a1, coffA[1][0], coffA[1][1]); \
            PG8_WAIT_V(8); PG8_WAIT_L(0); PG8_BAR; PG8_MMA(0, 0, At, B0); PG8_MMA(0, 1, At, B1); PG8_BAR; PG8_SCHED; \
            PG8_LDA(At, 0, 1); PG8_STAGE_B(PG8_SB(0, 0), b2); PG8_STAGE_B(PG8_SB(0, 1), (b2) + hstep); PG8_STAGE_A(PG8_SA(0, 0), a2, o00, o01); \
            PG8_WAIT_V(8); PG8_WAIT_L(0); PG8_BAR; PG8_MMA(1, 0, At, B0); PG8_MMA(1, 1, At, B1); PG8_BAR; PG8_SCHED; \
            PG8_LDB(B0, 1, 0); PG8_LDB(B1, 1, 1); PG8_SCHED; PG8_LDA(At, 1, 0); PG8_STAGE_A(PG8_SA(0, 1), a2, o10, o11); \
            PG8_WAIT_V(8); PG8_WAIT_L(0); PG8_BAR; PG8_MMA(0, 0, At, B0); PG8_MMA(0, 1, At, B1); PG8_BAR; PG8_SCHED; \
            PG8_LDA(At, 1, 1); PG8_STAGE_B(PG8_SB(1, 0), b3); PG8_STAGE_B(PG8_SB(1, 1), (b3) + hstep); PG8_STAGE_A(PG8_SA(1, 0), a3, o00, o01); \
            PG8_WAIT_V(8); PG8_WAIT_L(0); PG8_BAR; PG8_MMA(1, 0, At, B0); PG8_MMA(1, 1, At, B1); PG8_BAR; PG8_SCHED; } while (0)
    for (;;) {
        const bool has_next = S.next(ui + 1, nxt);
        if (EXPERT) nxt.e = has_next ? __builtin_amdgcn_readfirstlane(g.tile_e[nxt.pm]) : 0;
        const char* nA = sptr(has_next ? (const char*)g.A + (GATHER ? (size_t)0 : (size_t)nxt.pm * tstep) : cA);
        const char* nB = sptr(has_next ? (const char*)g.Bt + (size_t)nxt.e * g.estride + (size_t)nxt.pn * tstep : cB);
        if (GATHER && has_next) {
            int t2_ = threadIdx.x; asm volatile("" : "+v"(t2_));
#pragma unroll
            for (int i_ = 0; i_ < 2; ++i_) { int R_, C_; stage_rc(t2_ * 16 + i_ * 8192, R_, C_);
#pragma unroll
                for (int h_ = 0; h_ < 2; ++h_) __builtin_amdgcn_global_load_lds((const unsigned*)(g.rowtok + nxt.pm * 256 + h_ * 128 + R_), (LAS unsigned*)(stash + (h_ * 2 + i_) * 2048), 4, 0, 0); }
        }
        int C0x2 = 0, C1x2 = 0; const LAS unsigned* sp = nullptr;
        if (GATHER) { int t2_ = threadIdx.x; asm volatile("" : "+v"(t2_)); int R0_, C0_, R1_, C1_; stage_rc(t2_ * 16, R0_, C0_); stage_rc(t2_ * 16 + 8192, R1_, C1_); C0x2 = C0_ * 2; C1x2 = C1_ * 2;
            sp = (const LAS unsigned*)(stash + (t2_ & 63) * 4); }
        asm volatile(".p2align 8" ::: "memory");
#pragma unroll 1
        for (int t = 0; t < nt; t += 2) {
            const bool last = (t == nt - 2);
            const char* a1 = cA + (size_t)(t + 1) * kstep;
            const char* a2 = last ? nA : cA + (size_t)(t + 2) * kstep; const char* b2 = last ? nB : cB + (size_t)(t + 2) * kstep;
            const char* a3 = a2 + kstep; const char* b3 = b2 + kstep;
            unsigned o00 = coffA[0][0], o01 = coffA[0][1], o10 = coffA[1][0], o11 = coffA[1][1];
            if (GATHER && last && has_next) {
                o00 = sp[0] * (unsigned)(K * 2) + (unsigned)C0x2; o01 = sp[512] * (unsigned)(K * 2) + (unsigned)C1x2;
                o10 = sp[1024] * (unsigned)(K * 2) + (unsigned)C0x2; o11 = sp[1536] * (unsigned)(K * 2) + (unsigned)C1x2; }
            PG8_TRIP(a1, a2, b2, a3, b3, o00, o01, o10, o11);
            if (last) { coffA[0][0] = o00; coffA[0][1] = o01; coffA[1][0] = o10; coffA[1][1] = o11; }
        }
        if (wr == 0) PG8_BAR;
        { int l2 = threadIdx.x & 63; asm volatile("" : "+v"(l2)); E(acc, cur, wr, wc, l2 & 15, l2 >> 4, est); }
        if (!has_next) break;
#pragma unroll
        for (int a = 0; a < 2; ++a)
#pragma unroll
            for (int b = 0; b < 2; ++b)
#pragma unroll
                for (int m = 0; m < 4; ++m)
#pragma unroll
                    for (int n = 0; n < 2; ++n) acc[a][b][m][n] = (f32x4){0.f, 0.f, 0.f, 0.f};
        cur = nxt; cA = nA; cB = nB; ++ui;
        if (Epi::STASH) { int l2 = threadIdx.x & 63; asm volatile("" : "+v"(l2)); E.prefetch(cur, wr, wc, l2, est); }
        if (wr == 1) PG8_BAR;
    }
    PG8_WAIT_V(0);
    PG8_BAR;
#undef PG8_TRIP
#undef PG8_SA
#undef PG8_SB
#undef PG8_GLDS
#undef PG8_STAGE_A
#undef PG8_OPQ
#undef PG8_STAGE_B
#undef PG8_LDA
#undef PG8_LDB
#undef PG8_MMA
#undef PG8_CAT
#undef PG8_WAIT_V
#undef PG8_WAIT_L
#undef PG8_BAR
#undef PG8_SCHED
#undef PG8_OFFS
}

struct EpiProj {
    static constexpr bool PERM = true; static constexpr bool STASH = false;
    DI void prefetch(const Unit&, int, int, int, LAS unsigned char*) const {}
    bf16* O; int ldc; const float* qg; const float* kg; const float* rope; LAS float* P; bf16* HM;
    DI void operator()(const f32x4 (&acc)[2][2][4][2], const Unit& u, int wr, int wc, int fr, int fq, const LAS unsigned char* st) const {
        const int row0 = u.pm * BM + wr * 64 + fr, col0 = u.pn * BM + wc * 32 + 8 * fq;
        if (u.pn >= 8) {
#pragma unroll
            for (int ai = 0; ai < 2; ++ai)
#pragma unroll
                for (int m = 0; m < 4; ++m) { const int row = row0 + ai * HALF + m * 16; bf16* rowp = O + (size_t)row * ldc + col0;
                    if (u.pn < 12) rowp = HM + 2 * HM_PLANE + ((size_t)((row >> 14) * 8 + ((2 * u.pn) & 7)) * SEQ + (row & (SEQ - 1))) * 128 + wc * 32 + 8 * fq;
#pragma unroll
                    for (int bj = 0; bj < 2; ++bj) { const f32x4 v0 = acc[ai][bj][m][0], v1 = acc[ai][bj][m][1];
                        u32x4 w; w.x = cvtpk(v0[0], v0[1]); w.y = cvtpk(v0[2], v0[3]); w.z = cvtpk(v1[0], v1[1]); w.w = cvtpk(v1[2], v1[3]);
                        *(u32x4*)(rowp + (u.pn < 12 ? (size_t)bj * SEQ * 128 : (size_t)bj * HALF)) = w; } }
            return;
        }
        f32x4 rc[3][4];
#define EPR_LOAD(it_) do { const int rl_ = ((it_) >> 2) * HALF + wr * 64 + ((it_) & 3) * 16 + fr; const float* tp_ = rope + (size_t)((u.pm * BM + rl_) & (SEQ - 1)) * 32 + 8 * (fq & 1); \
            rc[(it_) % 3][0] = *(const f32x4*)tp_; rc[(it_) % 3][1] = *(const f32x4*)(tp_ + 4); rc[(it_) % 3][2] = *(const f32x4*)(tp_ + 16); rc[(it_) % 3][3] = *(const f32x4*)(tp_ + 20); } while (0)
        if (wc == 0) { EPR_LOAD(0); EPR_LOAD(1); }
#pragma unroll
        for (int ai = 0; ai < 2; ++ai)
#pragma unroll
            for (int m = 0; m < 4; ++m)
#pragma unroll
                for (int bj = 0; bj < 2; ++bj) { const f32x4 v0 = acc[ai][bj][m][0], v1 = acc[ai][bj][m][1];
                    float ss = (v0[0] * v0[0] + v0[1] * v0[1]) + (v0[2] * v0[2] + v0[3] * v0[3]) + (v1[0] * v1[0] + v1[1] * v1[1]) + (v1[2] * v1[2] + v1[3] * v1[3]);
                    ss += __shfl_xor(ss, 16); ss += __shfl_xor(ss, 32);
                    if (fq == 0) P[((ai * HALF + wr * 64 + m * 16 + fr) * 2 + bj) * 4 + wc] = ss; }
        asm volatile("s_waitcnt lgkmcnt(0)" ::: "memory"); __builtin_amdgcn_s_barrier(); asm volatile("" ::: "memory");
        const bool isk = u.pn >= 4; const float* gp = (isk ? kg : qg) + wc * 32 + 8 * fq; const float sc = isk ? 1.0f : QSCALE * 1.4426950408889634f;
        const f32x4 gA = *(const f32x4*)gp, gB = *(const f32x4*)(gp + 4);
#pragma unroll
        for (int ai = 0; ai < 2; ++ai)
#pragma unroll
            for (int m = 0; m < 4; ++m) { const int rl = ai * HALF + wr * 64 + m * 16 + fr; const int row = u.pm * BM + rl;
                bf16* rowp = HM + (isk ? HM_PLANE : (size_t)0) + ((size_t)((row >> 14) * 8 + ((2 * u.pn) & 7)) * SEQ + (row & (SEQ - 1))) * 128 + wc * 32 + 8 * fq;
                f32x4 cA = {1.f, 1.f, 1.f, 1.f}, cB = cA, sA = {0.f, 0.f, 0.f, 0.f}, sB = sA;
                if (wc == 0) { const int it = 4 * ai + m; if (it + 2 < 8) EPR_LOAD(it + 2);
                    cA = rc[it % 3][0]; cB = rc[it % 3][1]; sA = rc[it % 3][2]; sB = rc[it % 3][3]; if (fq < 2) { sA = -sA; sB = -sB; } }
#pragma unroll
                for (int bj = 0; bj < 2; ++bj) { const f32x4 pp = *(const LAS f32x4*)(P + (rl * 2 + bj) * 4);
                    const float rstd = 1.0f / sqrtf(((pp[0] + pp[1]) + (pp[2] + pp[3])) * (1.f / 128.f) + EPS);
                    f32x4 y0 = acc[ai][bj][m][0] * rstd * gA, y1 = acc[ai][bj][m][1] * rstd * gB;
                    if (wc == 0) { f32x4 o0, o1;
#pragma unroll
                        for (int j = 0; j < 4; ++j) { o0[j] = __shfl_xor(y0[j], 32); o1[j] = __shfl_xor(y1[j], 32); }
                        y0 = y0 * cA + o0 * sA; y1 = y1 * cB + o1 * sB; }
                    y0 = y0 * sc; y1 = y1 * sc;
                    u32x4 w; w.x = cvtpk(y0[0], y0[1]); w.y = cvtpk(y0[2], y0[3]); w.z = cvtpk(y1[0], y1[1]); w.w = cvtpk(y1[2], y1[3]);
                    *(u32x4*)(rowp + (size_t)bj * SEQ * 128) = w; } }
#undef EPR_LOAD
    }
};
struct EpiResid {
    static constexpr bool PERM = false; static constexpr bool STASH = false;
    const float* base; float* C; int ldc;
    DI void prefetch(const Unit&, int, int, int, LAS unsigned char*) const {}
    DI void operator()(const f32x4 (&acc)[2][2][4][2], const Unit& u, int wr, int wc, int fr, int fq, const LAS unsigned char* st) const {
        const int row0 = u.pm * BM + wr * 64 + fr, col0 = u.pn * BM + wc * 32 + 4 * fq;
        f32x4 rb[4][4];
#define EPS_LOAD(g_) do { const size_t off_ = (size_t)(row0 + ((g_) >> 2) * HALF + ((g_) & 3) * 16) * ldc + col0; \
            _Pragma("unroll") for (int bj = 0; bj < 2; ++bj) _Pragma("unroll") for (int n = 0; n < 2; ++n) rb[(g_) & 3][2 * bj + n] = *(const f32x4*)(base + off_ + bj * HALF + n * 16); } while (0)
        EPS_LOAD(0); EPS_LOAD(1); EPS_LOAD(2);
#pragma unroll
        for (int ai = 0; ai < 2; ++ai)
#pragma unroll
            for (int m = 0; m < 4; ++m) { const int g = 4 * ai + m; const size_t off = (size_t)(row0 + ai * HALF + m * 16) * ldc + col0;
                if (g + 3 < 8) EPS_LOAD(g + 3);
#pragma unroll
                for (int bj = 0; bj < 2; ++bj)
#pragma unroll
                    for (int n = 0; n < 2; ++n) *(f32x4*)(C + off + bj * HALF + n * 16) = rb[g & 3][2 * bj + n] + acc[ai][bj][m][n]; }
#undef EPS_LOAD
    }
};
DI float swiglu4(float hg, float hl) {
    const float glu = fminf(hg, 7.0f), lin = __builtin_amdgcn_fmed3f(hl, -7.0f, 7.0f);
    const float sg = __builtin_amdgcn_rcpf(1.0f + __builtin_amdgcn_exp2f(glu * (-1.702f * 1.4426950408889634f)));
    return (glu * sg) * __builtin_fmaf(lin, 4.0f, 4.0f);
}
DI f32x2 swiglu4_2(f32x2 hg, f32x2 hl) {
    f32x2 glu, lin, ex, sg;
    glu[0] = fminf(hg[0], 7.0f); glu[1] = fminf(hg[1], 7.0f); lin[0] = __builtin_amdgcn_fmed3f(hl[0], -7.0f, 7.0f); lin[1] = __builtin_amdgcn_fmed3f(hl[1], -7.0f, 7.0f);
    const f32x2 t = glu * (-1.702f * 1.4426950408889634f);
    ex[0] = __builtin_amdgcn_exp2f(t[0]); ex[1] = __builtin_amdgcn_exp2f(t[1]);
    const f32x2 den = ex + 1.0f;
    sg[0] = __builtin_amdgcn_rcpf(den[0]); sg[1] = __builtin_amdgcn_rcpf(den[1]);
    return (glu * sg) * (lin * 4.0f + 4.0f);
}
DI unsigned pk4_fp8n(float a, float b, float c, float d) { int v = __builtin_amdgcn_cvt_pk_fp8_f32(a, b, 0, false); v = __builtin_amdgcn_cvt_pk_fp8_f32(c, d, v, true); return (unsigned)v; }
DI u32x4 pair16(u32x2 a, u32x2 b) {
    const auto r0 = __builtin_amdgcn_permlane16_swap(a.x, b.x, false, false); const auto r1 = __builtin_amdgcn_permlane16_swap(a.y, b.y, false, false);
    u32x4 w; w.x = r0[0]; w.y = r1[0]; w.z = r0[1]; w.w = r1[1]; return w; }
#define PG8_DMA4(gp, lp) __builtin_amdgcn_global_load_lds((const unsigned*)(gp), (LAS unsigned*)(lp), 4, 0, 0)
struct EpiUp {
    static constexpr bool PERM = true; static constexpr bool STASH = true;
    unsigned char* ACT; const float* b_up; const float* rows;
    DI void prefetch(const Unit& u, int wr, int wc, int lane, LAS unsigned char* st) const {
        const float* rp = rows + u.pm * BM + wr * 64 + lane;
        PG8_DMA4(rp, st); PG8_DMA4(rp + HALF, st + 256);
        PG8_DMA4(b_up + (size_t)u.e * UPW + 2 * (u.pn * HALF + wc * 32) + lane, st + 512);
    }
    DI void operator()(const f32x4 (&acc)[2][2][4][2], const Unit& u, int wr, int wc, int fr, int fq, const LAS unsigned char* st) const {
        const int row0 = u.pm * BM + wr * 64 + fr, f0 = u.pn * HALF + wc * 32 + 8 * fq;
        f32x2 bg[4], bl[4];
        { const LAS float* sb = (const LAS float*)(st + 512 + fq * 64);
#pragma unroll
          for (int p = 0; p < 4; ++p) { bg[p][0] = sb[4 * p]; bg[p][1] = sb[4 * p + 2]; bl[p][0] = sb[4 * p + 1]; bl[p][1] = sb[4 * p + 3]; } }
#pragma unroll
        for (int ai = 0; ai < 2; ++ai)
#pragma unroll
            for (int mp = 0; mp < 2; ++mp) {
                u32x2 w2[2];
#pragma unroll
                for (int mm = 0; mm < 2; ++mm) { const int m = 2 * mp + mm; const float ws = *(const LAS float*)(st + ai * 256 + (m * 16 + fr) * 4) * (1.0f / 32.0f);
                    const f32x4 g0 = acc[ai][0][m][0], g1 = acc[ai][0][m][1], l0 = acc[ai][1][m][0], l1 = acc[ai][1][m][1];
                    f32x2 ws2; ws2[0] = ws; ws2[1] = ws;
                    const f32x2 a01 = swiglu4_2(__builtin_shufflevector(g0, g0, 0, 1) * ws2 + bg[0], __builtin_shufflevector(l0, l0, 0, 1) * ws2 + bl[0]);
                    const f32x2 a23 = swiglu4_2(__builtin_shufflevector(g0, g0, 2, 3) * ws2 + bg[1], __builtin_shufflevector(l0, l0, 2, 3) * ws2 + bl[1]);
                    const f32x2 a45 = swiglu4_2(__builtin_shufflevector(g1, g1, 0, 1) * ws2 + bg[2], __builtin_shufflevector(l1, l1, 0, 1) * ws2 + bl[2]);
                    const f32x2 a67 = swiglu4_2(__builtin_shufflevector(g1, g1, 2, 3) * ws2 + bg[3], __builtin_shufflevector(l1, l1, 2, 3) * ws2 + bl[3]);
                    w2[mm].x = pk4_fp8n(a01[0], a01[1], a23[0], a23[1]); w2[mm].y = pk4_fp8n(a45[0], a45[1], a67[0], a67[1]); }
                const u32x4 w = pair16(w2[0], w2[1]);
                *(u32x4*)(ACT + (size_t)(row0 + ai * HALF + (2 * mp + (fq & 1)) * 16) * FF + (f0 - 8 * (fq & 1))) = w; }
    }
};
struct EpiDown {
    static constexpr bool PERM = true; static constexpr bool STASH = true;
    unsigned char* YB; const float* b_down; const float* roww;
    DI void prefetch(const Unit& u, int wr, int wc, int lane, LAS unsigned char* st) const {
        const float* rp = roww + u.pm * BM + wr * 64 + lane;
        PG8_DMA4(rp, st); PG8_DMA4(rp + HALF, st + 256);
        PG8_DMA4(b_down + (size_t)u.e * DM + u.pn * BM + (lane >> 5) * HALF + wc * 32 + (lane & 31), st + 512);
    }
    DI void operator()(const f32x4 (&acc)[2][2][4][2], const Unit& u, int wr, int wc, int fr, int fq, const LAS unsigned char* st) const {
        const int row0 = u.pm * BM + wr * 64 + fr, col0 = u.pn * BM + wc * 32 + 8 * fq;
        f32x4 bv[2][2];
#pragma unroll
        for (int bj = 0; bj < 2; ++bj)
#pragma unroll
            for (int n = 0; n < 2; ++n) bv[bj][n] = *(const LAS f32x4*)(st + 512 + bj * 128 + fq * 32 + 16 * n);
#pragma unroll
        for (int ai = 0; ai < 2; ++ai)
#pragma unroll
            for (int mp = 0; mp < 2; ++mp) {
                const float wA = *(const LAS float*)(st + ai * 256 + ((2 * mp) * 16 + fr) * 4) * 16.0f, wB = *(const LAS float*)(st + ai * 256 + ((2 * mp + 1) * 16 + fr) * 4) * 16.0f;
                unsigned char* rowp = YB + (size_t)(row0 + ai * HALF + (2 * mp + (fq & 1)) * 16) * DM + (col0 - 8 * (fq & 1));
#pragma unroll
                for (int bj = 0; bj < 2; ++bj) { u32x2 w2[2];
#pragma unroll
                    for (int mm = 0; mm < 2; ++mm) { const int m = 2 * mp + mm; const float w8 = mm ? wB : wA;
                        const f32x4 v0 = (acc[ai][bj][m][0] * (1.0f / 128.0f) + bv[bj][0]) * w8, v1 = (acc[ai][bj][m][1] * (1.0f / 128.0f) + bv[bj][1]) * w8;
                        w2[mm].x = pk4_fp8m(v0[0], v0[1], v0[2], v0[3]); w2[mm].y = pk4_fp8m(v1[0], v1[1], v1[2], v1[3]); }
                    *(u32x4*)(rowp + bj * HALF) = pair16(w2[0], w2[1]); } }
    }
};
#undef PG8_DMA4
}

template <int MODE  >
DI void p0_tr_item(const float* W, int ld, bf16* WT, int K, int k0, int n0, LAS unsigned char* img, int lane) {
    const float* wp = W + (size_t)(k0 + (lane >> 5)) * ld + n0 + 4 * (lane & 31);
    const int ioff = img_off(lane >> 5, (lane & 31) >> 1) + (lane & 1) * 8;
#pragma unroll 1
    for (int bt = 0; bt < 4; ++bt) {
        f32x4 v[8];
#pragma unroll
        for (int i = 0; i < 8; ++i) v[i] = *(const f32x4*)(wp + (size_t)(2 * (8 * bt + i)) * ld);
#pragma unroll
        for (int i = 0; i < 8; ++i) { const int kk = 2 * (8 * bt + i) + (lane >> 5), n = 4 * (lane & 31);
            u32x2 pk; pk.x = cvtpk(v[i][0], v[i][1]); pk.y = cvtpk(v[i][2], v[i][3]);
            *(LAS u32x2*)(img + img_off(kk, n >> 3) + (n & 7) * 2) = pk; }
    }
    (void)ioff;
    LDS_WAIT();
    const int g = lane >> 4, i16 = lane & 15, q = i16 >> 2, p = i16 & 3;
#pragma unroll 4
    for (int step = 0; step < 16; ++step) { const int kc = 4 * (step & 1) + g, nb = step >> 1;
        const bf16x8 f = tr_frag(img, 8 * kc, 8 * kc + 4, 2 * nb, q, p);
        const int n = n0 + 16 * nb + i16; int row = n;
        if (MODE == 1) { const int ff = n >> 1; row = 256 * (ff >> 7) + 128 * (n & 1) + (ff & 127); }
        *(bf16x8*)(WT + (size_t)row * K + k0 + 8 * kc) = f; }
    LDS_WAIT();
}
DI float log_sigmoid(float x) { return fminf(x, 0.f) - log1pf(__expf(-fabsf(x))); }
DI void p0_prologue(Frame& F) {
    const int gw = F.vcu * NWAVES + F.wave, NGW = F.G * NWAVES;
    LAS float* lg = (LAS float*)F.lds;
    { float gvv[32];
#pragma unroll
      for (int i = 0; i < 32; ++i) { const int idx = F.tid + NTHR * i; gvv[i] = F.w_in[(size_t)(idx >> 3) * INW + NPROJ + (idx & 7)]; }
#pragma unroll
      for (int i = 0; i < 32; ++i) { const int idx = F.tid + NTHR * i; lg[(idx & 7) * DM + (idx >> 3)] = gvv[i]; } }
    __syncthreads();
    bf16* XN = (bf16*)(F.ws + WS_XN); float* GATES = (float*)(F.ws + WS_GATES);
#define P0_XLOAD(dst, row_) do { const f32x4* xr_ = (const f32x4*)(F.x + (size_t)(row_) * DM) + F.lane; _Pragma("unroll") for (int j = 0; j < 8; ++j) dst[j] = xr_[64 * j]; } while (0)
#define P0_XROW(v, row_) do { float ss = 0.f; \
        _Pragma("unroll") for (int j = 0; j < 8; ++j) ss += (v[j][0] * v[j][0] + v[j][1] * v[j][1]) + (v[j][2] * v[j][2] + v[j][3] * v[j][3]); \
        const float rstd = 1.0f / sqrtf(wave_sum(ss) * (1.f / DM) + EPS); \
        float ga[8]; _Pragma("unroll") for (int c = 0; c < 8; ++c) ga[c] = 0.f; \
        u32x2* o8 = (u32x2*)(XN + (size_t)(row_) * DM) + F.lane; \
        _Pragma("unroll") for (int j = 0; j < 8; ++j) { const f32x4 hh = v[j] * rstd * gnr[j]; \
            u32x2 pk; pk.x = cvtpk(hh[0], hh[1]); pk.y = cvtpk(hh[2], hh[3]); o8[64 * j] = pk; \
            _Pragma("unroll") for (int c = 0; c < 8; ++c) { const f32x4 w = *(const LAS f32x4*)(lg + c * DM + 4 * F.lane + 256 * j); ga[c] += (hh[0] * w[0] + hh[1] * w[1]) + (hh[2] * w[2] + hh[3] * w[3]); } \
            __builtin_amdgcn_sched_barrier(0); } \
        _Pragma("unroll") for (int c = 0; c < 8; ++c) ga[c] = wave_sum(ga[c]); \
        if (F.lane < 8) { float gv = ga[0]; \
            _Pragma("unroll") for (int c = 1; c < 8; ++c) gv = (F.lane == c) ? ga[c] : gv; \
            gv += gbias; \
            GATES[(size_t)(row_) * 8 + F.lane] = gv; } } while (0)
    { f32x4 va[8], vb[8], gnr[8];
#pragma unroll
      for (int j = 0; j < 8; ++j) gnr[j] = ((const f32x4*)F.attn_g)[F.lane + 64 * j];
      const float gbias = (F.lane < 4) ? F.i_b[F.lane & 3] : F.f_b[(F.lane - 4) & 3];
      int row = gw;
      if (row < NTOK) P0_XLOAD(va, row);
#pragma unroll 1
      for (; row < NTOK; row += 2 * NGW) {
          const int row1 = row + NGW, row2 = row + 2 * NGW;
          P0_XLOAD(vb, (row1 < NTOK ? row1 : NTOK - 1));
          __builtin_amdgcn_sched_barrier(0);
          P0_XROW(va, row);
          P0_XLOAD(va, (row2 < NTOK ? row2 : NTOK - 1));
          __builtin_amdgcn_sched_barrier(0);
          if (row1 < NTOK) P0_XROW(vb, row1);
      } }
#undef P0_XLOAD
#undef P0_XROW
    __syncthreads();
    { bf16* RH = (bf16*)(F.ws + WS_RWT); bf16* RL = RH + NE * DM;
      for (int idx = F.vcu * NTHR + F.tid; idx < NE * DM; idx += F.G * NTHR) { const int e = idx & 31, k = idx >> 5; const float w = F.router_w[idx] * F.ffn_g[k];
          const unsigned hi = cvtpk(w, 0.f) & 0xffffu; const float rem = w - __uint_as_float(hi << 16);
          const int off = (((((k >> 6) * 2 + ((k >> 5) & 1)) * 2 + (e >> 4)) * 64) + 16 * ((k >> 3) & 3) + (e & 15)) * 8 + (k & 7);
          RH[off] = (bf16)hi; RL[off] = (bf16)(cvtpk(rem, 0.f) & 0xffffu); } }
    { float* TAB = (float*)(F.ws + WS_SMALL + SM_ROPE);
      for (int idx = F.vcu * NTHR + F.tid; idx < SEQ * 16; idx += F.G * NTHR) { const int pos = idx >> 4, i = idx & 15;
          const float inv = exp2f(-(float)i * (2.0f / 32.0f) * 18.931568569324174f); const float ang = (float)pos * inv; const float nrev = rintf(ang * 0.15915494309189535f);
          const float rr = (float)__builtin_fma(-(double)nrev, 6.283185307179586476925, (double)ang);
          TAB[pos * 32 + i] = cosf(rr); TAB[pos * 32 + 16 + i] = sinf(rr); } }
    LAS unsigned char* img = F.lds + F.wave * 16384;
    constexpr int I_IN = 32 * 48, I_OUT = 32 * 16, NITEMS = I_IN + I_OUT;
    for (int it = gw; it < NITEMS; it += NGW) {
        int r = it;
        if (r < I_IN) { const int kb = r / 48, nb = r % 48; p0_tr_item<0>(F.w_in, INW, (bf16*)(F.ws + WS_WIN), DM, 64 * kb, 128 * nb, img, F.lane); continue; } r -= I_IN;
        { const int kb = r / 16, nb = r % 16; p0_tr_item<0>(F.w_out, DM, (bf16*)(F.ws + WS_WOUT), DM, 64 * kb, 128 * nb, img, F.lane); }
    }
}
template <int MODE>
DI void p0_strip_fp8(const float* W, int ld, unsigned char* WT, int K, int n0, LAS unsigned char* img, int lane) {
    const float* wp = W + (size_t)(lane >> 5) * ld + n0 + 4 * (lane & 31);
    const int g = lane >> 4, i16 = lane & 15, q = i16 >> 2, p = i16 & 3;
    int wb[8];
#pragma unroll
    for (int i = 0; i < 8; ++i) { const int kk = 2 * i + (lane >> 5), n = 4 * (lane & 31); wb[i] = img_off(kk, n >> 3) + (n & 7) * 2; }
    int rb[4], cx[4];
#pragma unroll
    for (int t = 0; t < 4; ++t) { const int M = (q << 2) | t; rb[t] = 256 * (16 * g + 4 * t + q) + 16 * ((p >> 1) ^ (M & 1)) + 8 * (p & 1); cx[t] = M >> 1; }
    int orow[8];
#pragma unroll
    for (int nb = 0; nb < 8; ++nb) { const int n = n0 + 16 * nb + i16; int row = n; if (MODE == 1) { const int ff = n >> 1; row = 256 * (ff >> 7) + 128 * (n & 1) + (ff & 127); } orow[nb] = row * K + 16 * g; }
    f32x4 va[16], vb[16];
#define P0S_LOAD(dst, krow0) do { _Pragma("unroll") for (int i = 0; i < 16; ++i) dst[i] = *(const f32x4*)(wp + (size_t)((krow0) + 2 * i) * ld); } while (0)
#define P0S_PUT(src, r0) do { _Pragma("unroll") for (int i = 0; i < 16; ++i) { \
        u32x2 pk; pk.x = cvtpk(src[i][0], src[i][1]) + 0x02800280u; pk.y = cvtpk(src[i][2], src[i][3]) + 0x02800280u;        \
        *(LAS u32x2*)(img + wb[i & 7] + ((r0) / 16 + (i >> 3)) * 4096) = pk; } } while (0)
#define P0S_F8(lo, hi) pk4_fp8m(__uint_as_float((lo) << 16), __uint_as_float((lo) & 0xffff0000u), __uint_as_float((hi) << 16), __uint_as_float((hi) & 0xffff0000u))
    P0S_LOAD(va, 0);
#pragma unroll 1
    for (int kb = 0; kb < 32; ++kb) {
        P0S_LOAD(vb, 64 * kb + 32);
        P0S_PUT(va, 0);
        if (kb < 31) P0S_LOAD(va, 64 * kb + 64);
        P0S_PUT(vb, 32);
        LDS_WAIT();
#pragma unroll 2
        for (int nb = 0; nb < 8; ++nb) {
            const s16x4 t0 = tr16(img + rb[0] + 32 * (nb ^ cx[0])), t1 = tr16(img + rb[1] + 32 * (nb ^ cx[1])), t2 = tr16(img + rb[2] + 32 * (nb ^ cx[2])), t3 = tr16(img + rb[3] + 32 * (nb ^ cx[3]));
            const u32x2 f0 = __builtin_bit_cast(u32x2, t0), f1 = __builtin_bit_cast(u32x2, t1), f2 = __builtin_bit_cast(u32x2, t2), f3 = __builtin_bit_cast(u32x2, t3);
            u32x4 o; o.x = P0S_F8(f0.x, f0.y); o.y = P0S_F8(f1.x, f1.y); o.z = P0S_F8(f2.x, f2.y); o.w = P0S_F8(f3.x, f3.y);
            *(u32x4*)(WT + (size_t)(unsigned)orow[nb] + 64 * kb) = o; }
        LDS_WAIT();
    }
#undef P0S_LOAD
#undef P0S_PUT
#undef P0S_F8
}
DI void p0_expert_weights(Frame& F, int wk, int nwk) {
    LAS unsigned char* img = F.lds + F.wave * 16384;
    constexpr int C_UP = NE * 32, C_DN = NE * 16, NCH = C_UP + C_DN;
    for (int cx = wk * NWAVES + F.wave; cx < NCH; cx += nwk * NWAVES) {
        if (cx < C_UP) { const int e = cx >> 5, nb = cx & 31; p0_strip_fp8<1>(F.w_up + (size_t)e * DM * UPW, UPW, F.ws + WS_WUP + (size_t)e * UPW * DM, DM, 128 * nb, img, F.lane); }
        else { const int r = cx - C_UP, e = r >> 4, nb = r & 15; p0_strip_fp8<0>(F.w_down + (size_t)e * FF * DM, DM, F.ws + WS_WDN + (size_t)e * DM * FF, FF, 128 * nb, img, F.lane); }
    }
}

DI void p2_conv(Frame& F, int wk, int nwk) {
    bf16* PROJ = (bf16*)(F.ws + WS_PROJ);
    bf16* QC = (bf16*)(F.ws + WS_QC); bf16* KC = (bf16*)(F.ws + WS_KC);
    const int c8 = (F.tid & 127) * 8, tok0 = (wk * NTHR + F.tid) >> 7, tstr = (nwk * NTHR) >> 7;
    float cb[8], cw[4][8];
#pragma unroll
    for (int e = 0; e < 8; ++e) cb[e] = F.conv_b[c8 + e];
#pragma unroll
    for (int j = 0; j < 4; ++j)
#pragma unroll
        for (int e = 0; e < 8; ++e) cw[j][e] = F.conv_w[j * 1024 + c8 + e];
    const float sc = (c8 < 512) ? 1.0f : QSCALE;
#pragma unroll 1
    for (int tokb = tok0; tokb < NTOK; tokb += 4 * tstr) {
        u32x4 raw[4][4];
#pragma unroll
        for (int u = 0; u < 4; ++u) { int tok = tokb + u * tstr; tok = tok < NTOK ? tok : NTOK - 1; const int t = tok & (SEQ - 1);
#pragma unroll
            for (int j = 0; j < 4; ++j) { const int back = (t - 3 + j < 0) ? t : 3 - j;
                raw[u][j] = *(const u32x4*)(PROJ + (size_t)(tok - back) * NPROJ + COL_MQ + c8); } }
#pragma unroll
        for (int u = 0; u < 4; ++u) { const int tok = tokb + u * tstr; const int tc = tok < NTOK ? tok : NTOK - 1; const int t = tc & (SEQ - 1);
            float a[8];
#pragma unroll
            for (int e = 0; e < 8; ++e) a[e] = cb[e];
#pragma unroll
            for (int j = 0; j < 4; ++j) { const float on_ = (t - 3 + j < 0) ? 0.0f : 1.0f;
#pragma unroll
                for (int e = 0; e < 4; ++e) { a[2 * e] += __uint_as_float(raw[u][j][e] << 16) * (cw[j][2 * e] * on_); a[2 * e + 1] += __uint_as_float(raw[u][j][e] & 0xffff0000u) * (cw[j][2 * e + 1] * on_); } }
#pragma unroll
            for (int e = 0; e < 8; ++e) a[e] = a[e] * __builtin_amdgcn_rcpf(1.0f + __expf(-a[e])) * sc;
            u32x4 w; w.x = cvtpk(a[0], a[1]); w.y = cvtpk(a[2], a[3]); w.z = cvtpk(a[4], a[5]); w.w = cvtpk(a[6], a[7]);
            if (tok < NTOK) { if (c8 < 512) *(u32x4*)(QC + (size_t)tok * 512 + c8) = w; else *(u32x4*)(KC + (size_t)tok * 512 + (c8 - 512)) = w; } }
    }
}

template <int DIL, bool FIRST, bool LAST>
DI void attn_phase(Frame& F) {
    constexpr int BPR = 16 / DIL, PRE = 6, NTILE = 36;
    bf16* OST = (bf16*)(F.ws + WS_OST); float* ML = (float*)(F.ws + WS_ML); bf16* MIX = (bf16*)(F.ws + WS_MIX);
    const bf16* HMq = (const bf16*)(F.ws + WS_HM);
    const int lane = F.lane, r = lane & 31, h = lane >> 5, g = lane >> 4, i16 = lane & 15, q4 = i16 >> 2, p4 = i16 & 3;
    const int prow = 4 * F.wave + g, pch = i16 ^ ((g << 2) | (F.wave & 3));
    const unsigned pdst = (unsigned)F.wave * 1024u;
    int vB0[4], vB1[4];
#pragma unroll
    for (int db = 0; db < 4; ++db) { vB0[db] = tr_base(4 * h, 4 * db + 2 * (g & 1), q4, p4); vB1[db] = tr_base(8 + 4 * h, 4 * db + 2 * (g & 1), q4, p4); }
    const int kmask = ((r & 3) << 2) | ((r >> 2) & 3);
    __syncthreads();
    const int nun = (F.vcu < 256) ? (255 - F.vcu) / F.G + 1 : 0;
    if (nun > 0) {
#define ATT_DECODE(k_, b_, hd_, res_, ib_) do { const int u_ = F.vcu + (k_) * F.G; const int bh_ = u_ >> 4, uu_ = u_ & 15; b_ = bh_ >> 3; hd_ = bh_ & 7; res_ = uu_ / BPR; ib_ = (uu_ % BPR) * 1024; } while (0)
        int iu = 0, ij = 0, is = 0, ib_i; const bf16* kv_i;
        { int b_, hd_, res_; ATT_DECODE(0, b_, hd_, res_, ib_i); kv_i = HMq + HM_PLANE + ((size_t)(b_ * 8 + hd_) * SEQ + res_) * 128; }
#define ATT_DMA16(gp, la) asm volatile("s_mov_b32 m0, %1\n\tglobal_load_lds_dwordx4 %0, off" :: "v"(gp), "s"(la) : "memory", "m0")
#define ATT_ISSUE1() do { int ki_ = ib_i - 128 + 32 * ij + prow; ki_ = ki_ < 0 ? 0 : ki_; const bf16* src_ = kv_i + (size_t)ki_ * (DIL * 128) + 8 * pch; \
            const unsigned slot_ = __builtin_amdgcn_readfirstlane((unsigned)(unsigned long long)(F.lds + (is & 7) * 16384 + pdst)); ++is; \
            ATT_DMA16(src_, slot_); ATT_DMA16(src_ + HM_PLANE, slot_ + 8192u); \
            if (++ij == NTILE) { if (iu + 1 < nun) { ++iu; ij = 0; int b_, hd_, res_; ATT_DECODE(iu, b_, hd_, res_, ib_i); kv_i = HMq + HM_PLANE + ((size_t)(b_ * 8 + hd_) * SEQ + res_) * 128; } else ij = NTILE - 1; } } while (0)
        u32x4 qfr[8], on[8]; u32x2 mlx; mlx.x = 0u; mlx.y = 0u;
#define ATT_GLD16(dst, ptr, off) asm volatile("global_load_dwordx4 %0, %1, off offset:%2" : "=v"(dst) : "v"(ptr), "i"(off) : "memory")
#define ATT_PREFETCH(k_, qt_) do { int b_, hd_, res_, ib_; ATT_DECODE(k_, b_, hd_, res_, ib_); const size_t hr_ = (size_t)(b_ * 8 + hd_) * SEQ + (size_t)(ib_ + 32 * (qt_) + r) * DIL + res_; \
            const bf16* qp_ = HMq + hr_ * 128 + 8 * h; _Pragma("unroll") for (int kk = 0; kk < 8; ++kk) ATT_GLD16(qfr[kk], qp_, 32 * kk); \
            if (!FIRST) { const bf16* op_ = OST + hr_ * 128 + 8 * h; _Pragma("unroll") for (int db = 0; db < 4; ++db) _Pragma("unroll") for (int j2 = 0; j2 < 2; ++j2) ATT_GLD16(on[2 * db + j2], op_, 64 * db + 32 * j2); \
                const float* mlq_ = ML + hr_ * 2; asm volatile("global_load_dwordx2 %0, %1, off" : "=v"(mlx) : "v"(mlq_) : "memory"); } } while (0)
        ATT_PREFETCH(0, F.wave);
#pragma unroll
        for (int jt = 0; jt < PRE; ++jt) ATT_ISSUE1();
        int cs = 0;
        f32x16 o[4]; float m = -1e30f, l = 0.f;
#pragma unroll 1
        for (int k = 0; k < nun; ++k) {
            int b, hd, res, ibase; ATT_DECODE(k, b, hd, res, ibase);
#pragma unroll 1
            for (int j = 0; j < NTILE; ++j) {
                ATT_ISSUE1();
                const int dj = j - F.wave, mq = dj >> 3, kt = dj & 7, qt = F.wave + 8 * mq;
                const bool act = dj >= 0 && mq <= 3 && kt <= 4;
                const int i0 = ibase + 32 * qt;
                if (act && kt == 0) asm volatile("s_waitcnt vmcnt(8)" ::: "memory"); else asm volatile("s_waitcnt vmcnt(12)" ::: "memory");
                __builtin_amdgcn_s_barrier(); asm volatile("" ::: "memory");
                if (act) {
                    if (kt == 0) {
                        if (FIRST) {
#pragma unroll
                            for (int db = 0; db < 4; ++db)
#pragma unroll
                                for (int e = 0; e < 16; ++e) o[db][e] = 0.f;
                            m = -1e30f; l = 0.f;
                        } else {
#pragma unroll
                            for (int db = 0; db < 4; ++db)
#pragma unroll
                                for (int j2 = 0; j2 < 2; ++j2) { const u32x4 vv = on[2 * db + j2]; u32x2 va2[2]; va2[0].x = vv.x; va2[0].y = vv.y; va2[1].x = vv.z; va2[1].y = vv.w; swap32(va2[0], va2[1]);
#pragma unroll
                                    for (int q2 = 0; q2 < 2; ++q2) { const int g4 = 2 * j2 + q2; const u32x2 v = va2[q2];
                                        o[db][4 * g4] = __uint_as_float(v.x << 16); o[db][4 * g4 + 1] = __uint_as_float(v.x & 0xffff0000u); o[db][4 * g4 + 2] = __uint_as_float(v.y << 16); o[db][4 * g4 + 3] = __uint_as_float(v.y & 0xffff0000u); } }
                            m = __uint_as_float(mlx.x); l = __uint_as_float(mlx.y);
                        }
                    }
                    const LAS unsigned char* kimg = F.lds + (cs & 7) * 16384; const LAS unsigned char* vi = kimg + 8192;
                    f32x16 s;
#pragma unroll
                    for (int e = 0; e < 16; ++e) s[e] = 0.f;
                    const LAS unsigned char* krow = kimg + 256 * r;
                    bf16x8 ka[8];
#pragma unroll
                    for (int kk = 0; kk < 8; ++kk) ka[kk] = *(const LAS bf16x8*)(krow + 16 * ((2 * kk + h) ^ kmask));
                    __builtin_amdgcn_sched_barrier(0);
#pragma unroll
                    for (int kk = 0; kk < 8; ++kk) s = mfma32(ka[kk], __builtin_bit_cast(bf16x8, qfr[kk]), s);
                    bf16x8 va[2][4];
#pragma unroll
                    for (int s2 = 0; s2 < 2; ++s2)
#pragma unroll
                        for (int db = 0; db < 4; ++db) va[s2][db] = tr_frag2(vi, vB0[db], vB1[db], s2 * 4096);
                    __builtin_amdgcn_sched_barrier(0);
                    { const int kb = i0 - 128 + 32 * kt;
                      if (kt == 0 || kt == 4 || kb < 0) {
#pragma unroll
                        for (int e = 0; e < 16; ++e) { const int ce = crow(e, h); const bool bad = ((kb + ce) < 0) || (kt == 0 && ce < r) || (kt == 4 && ce > r); if (bad) s[e] = -1e30f; } } }
                    float mx = fmaxf(fmaxf(s[0], s[1]), s[2]);
#pragma unroll
                    for (int e = 3; e < 15; e += 2) mx = fmaxf(fmaxf(mx, s[e]), s[e + 1]);
                    mx = fmaxf(mx, s[15]);
                    mx = fmaxf(mx, __shfl_xor(mx, 32));
                    if (__any(mx > m + 8.0f)) { const float mn = fmaxf(m, mx), alpha = __builtin_amdgcn_exp2f(m - mn); l *= alpha; m = mn;
#pragma unroll
                        for (int db = 0; db < 4; ++db)
#pragma unroll
                            for (int e = 0; e < 16; ++e) o[db][e] *= alpha; }
                    float rs = 0.f;
#pragma unroll
                    for (int e = 0; e < 16; ++e) { s[e] = __builtin_amdgcn_exp2f(s[e] - m); rs += s[e]; }
                    rs += __shfl_xor(rs, 32); l += rs;
                    bf16x8 pb[2];
#pragma unroll
                    for (int s2 = 0; s2 < 2; ++s2) { u32x4 w; w.x = cvtpk(s[8 * s2], s[8 * s2 + 1]); w.y = cvtpk(s[8 * s2 + 2], s[8 * s2 + 3]); w.z = cvtpk(s[8 * s2 + 4], s[8 * s2 + 5]); w.w = cvtpk(s[8 * s2 + 6], s[8 * s2 + 7]);
                        pb[s2] = __builtin_bit_cast(bf16x8, w); }
#pragma unroll
                    for (int s2 = 0; s2 < 2; ++s2) {
#pragma unroll
                        for (int db = 0; db < 4; ++db) o[db] = mfma32(va[s2][db], pb[s2], o[db]);
                    }
                    if (kt == 4) {
                        const size_t hrow = (size_t)(b * 8 + hd) * SEQ + (size_t)(i0 + r) * DIL + res;
                        if (LAST) {
                            const size_t rowq = (size_t)b * SEQ + (size_t)(i0 + r) * DIL + res;
                            const float il = 1.0f / l;
                            bf16* mp = MIX + rowq * DM + hd * 128 + 8 * h;
#pragma unroll
                            for (int db = 0; db < 4; ++db)
#pragma unroll
                                for (int j2 = 0; j2 < 2; ++j2) { u32x2 w2[2];
#pragma unroll
                                    for (int q2 = 0; q2 < 2; ++q2) { const int g4 = 2 * j2 + q2; w2[q2].x = cvtpk(o[db][4 * g4] * il, o[db][4 * g4 + 1] * il); w2[q2].y = cvtpk(o[db][4 * g4 + 2] * il, o[db][4 * g4 + 3] * il); }
                                    swap32(w2[0], w2[1]); u32x4 w; w.x = w2[0].x; w.y = w2[0].y; w.z = w2[1].x; w.w = w2[1].y;
                                    *(u32x4*)(mp + 32 * db + 16 * j2) = w; }
                        } else {
                            bf16* ostp = OST + hrow * 128 + 8 * h; float* mlp = ML + hrow * 2;
#pragma unroll
                            for (int db = 0; db < 4; ++db)
#pragma unroll
                                for (int j2 = 0; j2 < 2; ++j2) { u32x2 w2[2];
#pragma unroll
                                    for (int q2 = 0; q2 < 2; ++q2) { const int g4 = 2 * j2 + q2; w2[q2].x = cvtpk(o[db][4 * g4], o[db][4 * g4 + 1]); w2[q2].y = cvtpk(o[db][4 * g4 + 2], o[db][4 * g4 + 3]); }
                                    swap32(w2[0], w2[1]); u32x4 w; w.x = w2[0].x; w.y = w2[0].y; w.z = w2[1].x; w.w = w2[1].y;
                                    *(u32x4*)(ostp + 32 * db + 16 * j2) = w; }
                            if (h == 0) { f32x2 mlv; mlv[0] = m; mlv[1] = l; *(f32x2*)mlp = mlv; }
                        }
                        if (mq < 3) ATT_PREFETCH(k, qt + 8); else if (k + 1 < nun) ATT_PREFETCH(k + 1, F.wave);
                    }
                }
                ++cs;
                __builtin_amdgcn_sched_barrier(0);
            }
        }
#undef ATT_ISSUE1
#undef ATT_DMA16
#undef ATT_PREFETCH
#undef ATT_GLD16
#undef ATT_DECODE
        asm volatile("s_waitcnt vmcnt(0)" ::: "memory");
    }
    __syncthreads();
}

DI float scan_incl_sum(float v, int lane) {
#pragma unroll
    for (int o = 1; o < 64; o <<= 1) { const float t = __shfl_up(v, o); if (lane >= o) v += t; }
    return v;
}
DI float scan_incl_max(float v, int lane) {
#pragma unroll
    for (int o = 1; o < 64; o <<= 1) { const float t = __shfl_up(v, o); if (lane >= o) v = fmaxf(v, t); }
    return v;
}
template <bool SCALE>
DI void load_img128(LAS unsigned char* img, const bf16* src, size_t ldg, const LAS float* rs, int tid) {
#pragma unroll
    for (int it = 0; it < 4; ++it) { const int idx = tid + NTHR * it, row = idx >> 4, ch = idx & 15;
        u32x4 v = *(const u32x4*)(src + (size_t)row * ldg + 8 * ch);
        if (SCALE) { const float w = rs[row];
#pragma unroll
            for (int e = 0; e < 4; ++e) { const float lo = __uint_as_float(v[e] << 16) * w, hi = __uint_as_float(v[e] & 0xffff0000u) * w; v[e] = cvtpk(lo, hi); } }
        *(LAS u32x4*)(img + img_off(row, ch)) = v; }
}
DI void dma_img128(LAS unsigned char* img, const bf16* src, size_t ldg, int wave, int lane) {
    const int g = lane >> 4, i16 = lane & 15;
#pragma unroll
    for (int i = 0; i < 4; ++i) { const int row = (wave * 4 + i) * 4 + g; const int ch = i16 ^ ((g << 2) | i);
        __builtin_amdgcn_global_load_lds((const unsigned*)(src + (size_t)row * ldg + 8 * ch), (LAS unsigned*)(img + (wave * 4 + i) * 1024), 16, 0, 0); }
}
DI void mlstm_m1_unit(Frame& F, int u) {
    const int bh = u >> 7, c = u & 127, b = bh >> 2, hd = bh & 3;
    const int tok0 = b * SEQ + c * 128;
    const float* GATES = (const float*)(F.ws + WS_GATES);
    LAS float* mf = (LAS float*)(F.lds + MISC_OFF);
    LAS unsigned char* imgK = F.lds, *imgV0 = F.lds + 32768, *imgV1 = F.lds + 65536;
    const int lane = F.lane;
    const bf16* KC = (const bf16*)(F.ws + WS_KC); const bf16* PROJ = (const bf16*)(F.ws + WS_PROJ);
    dma_img128(imgV0, PROJ + (size_t)tok0 * NPROJ + COL_MV + hd * 256, NPROJ, F.wave, lane);
    dma_img128(imgV1, PROJ + (size_t)tok0 * NPROJ + COL_MV + hd * 256 + 128, NPROJ, F.wave, lane);
    asm volatile("" ::: "memory");
    u32x4 kreg[4];
#pragma unroll
    for (int it = 0; it < 4; ++it) { const int idx = F.tid + NTHR * it, row = idx >> 4, ch = idx & 15; kreg[it] = *(const u32x4*)(KC + (size_t)(tok0 + row) * 512 + hd * 128 + 8 * ch); }
    if (F.wave == 0) {
        const int s0 = 2 * lane;
        const float ig0 = GATES[(size_t)(tok0 + s0) * 8 + hd], fg0 = GATES[(size_t)(tok0 + s0) * 8 + 4 + hd];
        const float ig1 = GATES[(size_t)(tok0 + s0 + 1) * 8 + hd], fg1 = GATES[(size_t)(tok0 + s0 + 1) * 8 + 4 + hd];
        const float lf0 = log_sigmoid(fg0), lf1 = log_sigmoid(fg1);
        const float b1 = scan_incl_sum(lf0 + lf1, lane), b0 = b1 - lf1;
        const float gt = __shfl(b1, 63);
        const float a0 = gt - b0 + ig0, a1 = gt - b1 + ig1;
        const float ml = wave_max(fmaxf(a0, a1));
        mf[s0] = __expf(a0 - ml); mf[s0 + 1] = __expf(a1 - ml);
        if (lane == 0) { ((float*)(F.ws + WS_SMALL + SM_G))[u] = gt; ((float*)(F.ws + WS_SMALL + SM_MLOC))[u] = ml; }
    }
    asm volatile("s_waitcnt vmcnt(4)" ::: "memory");
    __syncthreads();
#pragma unroll
    for (int it = 0; it < 4; ++it) { const int idx = F.tid + NTHR * it, row = idx >> 4, ch = idx & 15; const float w = mf[row]; u32x4 v = kreg[it];
#pragma unroll
        for (int e = 0; e < 4; ++e) { const float lo = __uint_as_float(v[e] << 16) * w, hi = __uint_as_float(v[e] & 0xffff0000u) * w; v[e] = cvtpk(lo, hi); }
        *(LAS u32x4*)(imgK + img_off(row, ch)) = v; }
    __syncthreads();
    const int mb = F.wave >> 1, nh = F.wave & 1, r = lane & 31, h = lane >> 5, g = lane >> 4, i16 = lane & 15, q4 = i16 >> 2, p4 = i16 & 3;
    LAS unsigned char* imgV = nh ? imgV1 : imgV0;
    f32x16 acc[4], accn;
    u32x4 onesv; onesv.x = 0x3F803F80u; onesv.y = 0x3F803F80u; onesv.z = 0x3F803F80u; onesv.w = 0x3F803F80u;
#pragma unroll
    for (int e = 0; e < 16; ++e) accn[e] = 0.f;
#pragma unroll
    for (int nb = 0; nb < 4; ++nb)
#pragma unroll
        for (int e = 0; e < 16; ++e) acc[nb][e] = 0.f;
    const int aA0 = tr_base(8 * h, 4 * mb + 2 * (g & 1), q4, p4), aA1 = tr_base(8 * h + 4, 4 * mb + 2 * (g & 1), q4, p4);
    int bB0[4], bB1[4];
#pragma unroll
    for (int nb = 0; nb < 4; ++nb) { bB0[nb] = tr_base(8 * h, 4 * nb + 2 * (g & 1), q4, p4); bB1[nb] = tr_base(8 * h + 4, 4 * nb + 2 * (g & 1), q4, p4); }
#pragma unroll
    for (int ks = 0; ks < 8; ++ks) {
        const bf16x8 a = tr_frag2(imgK, aA0, aA1, ks * 4096);
        if (nh == 0) accn = mfma32(a, __builtin_bit_cast(bf16x8, onesv), accn);
#pragma unroll
        for (int nb = 0; nb < 4; ++nb) { const bf16x8 bfr = tr_frag2(imgV, bB0[nb], bB1[nb], ks * 4096);
            acc[nb] = mfma32(a, bfr, acc[nb]); }
        __builtin_amdgcn_sched_barrier(0);
    }
    if (nh == 0 && r == 0) { float* NLo = (float*)(F.ws + WS_SMALL + SM_NLOC) + (size_t)u * 128 + 32 * mb;
#pragma unroll
        for (int e = 0; e < 16; ++e) NLo[crow(e, h)] = accn[e]; }
    bf16* CL = (bf16*)(F.ws + WS_CLOC) + (size_t)u * 128 * 256;
    __syncthreads();
    { LAS unsigned char* stg = F.lds + (size_t)(32 * mb) * 528 + (128 * nh + r) * 2;
#pragma unroll
      for (int nb = 0; nb < 4; ++nb)
#pragma unroll
          for (int e = 0; e < 16; ++e) *(LAS unsigned short*)(stg + crow(e, h) * 528 + 64 * nb) = (unsigned short)(cvtpk(acc[nb][e], 0.f) & 0xffffu); }
    __syncthreads();
#pragma unroll
    for (int i = 0; i < 8; ++i) { const int p = F.tid + NTHR * i, row = p >> 5, ch = p & 31; *(u32x4*)(CL + (size_t)row * 256 + 8 * ch) = *(const LAS u32x4*)(F.lds + row * 528 + 16 * ch); }
    __syncthreads();
}
DI void mlstm_scan(Frame& F) {
    const float* Gv = (const float*)(F.ws + WS_SMALL + SM_G); const float* MLv = (const float*)(F.ws + WS_SMALL + SM_MLOC);
    float* MP = (float*)(F.ws + WS_SMALL + SM_MPREV); const float* NL = (const float*)(F.ws + WS_SMALL + SM_NLOC); float* NP = (float*)(F.ws + WS_SMALL + SM_NPREV);
    const bf16* CL = (const bf16*)(F.ws + WS_CLOC); bf16* CP = (bf16*)(F.ws + WS_CPREV);
    const int lane = F.lane;
    for (int t = F.vcu + F.G * F.wave; t < 512; t += F.G * NWAVES) {
        const int bh = t >> 6, dk = (t & 63) * 2 + (lane >> 5), dv = (lane & 31) * 8;
        const float g0 = Gv[bh * 128 + lane], g1 = Gv[bh * 128 + 64 + lane], l0 = MLv[bh * 128 + lane], l1 = MLv[bh * 128 + 64 + lane];
        const size_t e0 = (size_t)bh * 128 * 32768 + (size_t)dk * 256 + dv;
        float st[8];
#pragma unroll
        for (int e = 0; e < 8; ++e) st[e] = 0.f;
        float m = 0.f, ns = 0.f;
        u32x4 cla[16], clb[16]; float nla[16], nlb[16];
#define SC_LOAD(cl_, nl_, cb_) do { _Pragma("unroll") for (int i = 0; i < 16; ++i) cl_[i] = *(const u32x4*)(CL + e0 + (size_t)((cb_) + i) * 32768); \
            _Pragma("unroll") for (int i = 0; i < 16; ++i) nl_[i] = NL[(size_t)(bh * 128 + (cb_) + i) * 128 + dk]; } while (0)
#define SC_BATCH(cl_, nl_, cb_) do { _Pragma("unroll") for (int i = 0; i < 16; ++i) { const int c = (cb_) + i; \
                const float gc = __uint_as_float(__builtin_amdgcn_readlane(__float_as_uint((cb_) < 64 ? g0 : g1), c & 63)), ml = __uint_as_float(__builtin_amdgcn_readlane(__float_as_uint((cb_) < 64 ? l0 : l1), c & 63)); \
                const float mn = fmaxf(gc + m, ml), dold = __expf(gc + m - mn), dnew = __expf(ml - mn); \
                u32x4 w; w.x = cvtpk(st[0], st[1]); w.y = cvtpk(st[2], st[3]); w.z = cvtpk(st[4], st[5]); w.w = cvtpk(st[6], st[7]); \
                *(u32x4*)(CP + e0 + (size_t)c * 32768) = w;                                          \
                _Pragma("unroll") for (int e = 0; e < 4; ++e) { st[2 * e] = dold * st[2 * e] + dnew * __uint_as_float(cl_[i][e] << 16); st[2 * e + 1] = dold * st[2 * e + 1] + dnew * __uint_as_float(cl_[i][e] & 0xffff0000u); } \
                if ((lane & 31) == 0) { const float nl = nl_[i]; NP[(size_t)(bh * 128 + c) * 128 + dk] = ns; ns = dold * ns + dnew * nl; } \
                if ((t & 63) == 0 && lane == 0) MP[bh * 128 + c] = m; \
                m = mn; } } while (0)
        SC_LOAD(cla, nla, 0);
#pragma unroll 1
        for (int cb = 0; cb < NCH; cb += 32) {
            SC_LOAD(clb, nlb, cb + 16);
            __builtin_amdgcn_sched_barrier(0);
            SC_BATCH(cla, nla, cb);
            { const int cn = cb + 32 < NCH ? cb + 32 : cb; SC_LOAD(cla, nla, cn); }
            __builtin_amdgcn_sched_barrier(0);
            SC_BATCH(clb, nlb, cb + 16);
        }
#undef SC_LOAD
#undef SC_BATCH
    }
}
DI void mlstm_m3_unit(Frame& F, int u) {
    const int bh = u >> 7, c = u & 127, b = bh >> 2, hd = bh & 3;
    const int tok0 = b * SEQ + c * 128;
    const float* GATES = (const float*)(F.ws + WS_GATES);
    LAS float* mf = (LAS float*)(F.lds + MISC_OFF);
    LAS unsigned char* imgV0 = F.lds, *imgV1 = F.lds + 32768, *imgC0 = F.lds + 65536, *imgC1 = F.lds + 98304, *imgK = F.lds + 65536;
    int lane_ = F.lane; asm volatile("" : "+v"(lane_));
    const int lane = lane_, tid_ = F.wave * 64 + lane, r = lane & 31, h = lane >> 5, g = lane >> 4, i16 = lane & 15, q4 = i16 >> 2, p4 = i16 & 3;
    const bf16* QC = (const bf16*)(F.ws + WS_QC); const bf16* KC = (const bf16*)(F.ws + WS_KC); const bf16* PROJ = (const bf16*)(F.ws + WS_PROJ);
    const bf16* CP = (const bf16*)(F.ws + WS_CPREV) + (size_t)u * 32768;
    dma_img128(imgV0, PROJ + (size_t)tok0 * NPROJ + COL_MV + hd * 256, NPROJ, F.wave, lane);
    dma_img128(imgV1, PROJ + (size_t)tok0 * NPROJ + COL_MV + hd * 256 + 128, NPROJ, F.wave, lane);
    dma_img128(imgC0, CP, 256, F.wave, lane);
    dma_img128(imgC1, CP + 128, 256, F.wave, lane);
    asm volatile("" ::: "memory");
    const int tb = F.wave & 3, dh = F.wave >> 2;
    const int tl = 32 * tb + r;
    bf16x8 qf[8];
    { const bf16* qp = QC + (size_t)(tok0 + tl) * 512 + hd * 128 + 8 * h;
#pragma unroll
      for (int kk = 0; kk < 8; ++kk) qf[kk] = *(const bf16x8*)(qp + 16 * kk); }
    u32x4 kreg[4];
#pragma unroll
    for (int it = 0; it < 4; ++it) { const int idx = tid_ + NTHR * it, row = idx >> 4, ch = idx & 15; kreg[it] = *(const u32x4*)(KC + (size_t)(tok0 + row) * 512 + hd * 128 + 8 * ch); }
    asm volatile("" ::: "memory");
    const float m_prev = ((const float*)(F.ws + WS_SMALL + SM_MPREV))[u];
    if (F.wave == 0) {
        const int s0 = 2 * lane;
        const float ig0 = GATES[(size_t)(tok0 + s0) * 8 + hd], fg0 = GATES[(size_t)(tok0 + s0) * 8 + 4 + hd];
        const float ig1 = GATES[(size_t)(tok0 + s0 + 1) * 8 + hd], fg1 = GATES[(size_t)(tok0 + s0 + 1) * 8 + 4 + hd];
        const float lf0 = log_sigmoid(fg0), lf1 = log_sigmoid(fg1);
        const float b1 = scan_incl_sum(lf0 + lf1, lane), b0 = b1 - lf1;
        const float u0 = ig0 - b0, u1 = ig1 - b1;
        const float im = scan_incl_max(fmaxf(u0, u1), lane);
        float ex = __shfl_up(im, 1); if (lane == 0) ex = -1e30f;
        const float cm0 = fmaxf(ex, u0), cm1 = im;
        const float M0 = fmaxf(m_prev, cm0), M1 = fmaxf(m_prev, cm1);
        mf[s0] = u0; mf[s0 + 1] = u1; mf[128 + s0] = M0; mf[128 + s0 + 1] = M1;
        mf[256 + s0] = __expf(m_prev - M0); mf[256 + s0 + 1] = __expf(m_prev - M1);
        mf[384 + s0] = __expf(-(b0 + M0)); mf[384 + s0 + 1] = __expf(-(b1 + M1));
    }
    if (F.wave == 1) { const float* NP = (const float*)(F.ws + WS_SMALL + SM_NPREV) + (size_t)u * 128; mf[512 + lane] = NP[lane]; mf[512 + 64 + lane] = NP[64 + lane]; }
    asm volatile("s_waitcnt vmcnt(4)" ::: "memory");
    __syncthreads();
    LAS unsigned char* imgC = dh ? imgC1 : imgC0; LAS unsigned char* imgV = dh ? imgV1 : imgV0;
    f32x16 acc[4];
#pragma unroll
    for (int nb = 0; nb < 4; ++nb)
#pragma unroll
        for (int e = 0; e < 16; ++e) acc[nb][e] = 0.f;
    int cB0[4], cB1[4];
#pragma unroll
    for (int nb = 0; nb < 4; ++nb) { cB0[nb] = tr_base(8 * h, 4 * nb + 2 * (g & 1), q4, p4); cB1[nb] = tr_base(8 * h + 4, 4 * nb + 2 * (g & 1), q4, p4); }
#pragma unroll
    for (int kk = 0; kk < 8; ++kk) {
#pragma unroll
        for (int nb = 0; nb < 4; ++nb) { const bf16x8 a = tr_frag2(imgC, cB0[nb], cB1[nb], kk * 4096);
            acc[nb] = mfma32(a, qf[kk], acc[nb]); }
        __builtin_amdgcn_sched_barrier(0);
    }
    const float wi = mf[256 + tl], Mt = mf[128 + tl], en = mf[384 + tl];
#pragma unroll
    for (int nb = 0; nb < 4; ++nb)
#pragma unroll
        for (int e = 0; e < 16; ++e) acc[nb][e] *= wi;
    float qn = 0.f;
#pragma unroll
    for (int kk = 0; kk < 8; ++kk) { const f32x4 n0 = *(const LAS f32x4*)(mf + 512 + 16 * kk + 8 * h), n1 = *(const LAS f32x4*)(mf + 512 + 16 * kk + 8 * h + 4);
        const u32x4 qq = __builtin_bit_cast(u32x4, qf[kk]);
        qn += __uint_as_float(qq[0] << 16) * n0[0] + __uint_as_float(qq[0] & 0xffff0000u) * n0[1] + __uint_as_float(qq[1] << 16) * n0[2] + __uint_as_float(qq[1] & 0xffff0000u) * n0[3];
        qn += __uint_as_float(qq[2] << 16) * n1[0] + __uint_as_float(qq[2] & 0xffff0000u) * n1[1] + __uint_as_float(qq[3] << 16) * n1[2] + __uint_as_float(qq[3] & 0xffff0000u) * n1[3]; }
    qn += __shfl_xor(qn, 32);
    __syncthreads();
#pragma unroll
    for (int it = 0; it < 4; ++it) { const int idx = tid_ + NTHR * it, row = idx >> 4, ch = idx & 15; *(LAS u32x4*)(imgK + img_off(row, ch)) = kreg[it]; }
    __syncthreads();
    u32x4 moreg[8];
    { const bf16* mop = PROJ + (size_t)(tok0 + tl) * NPROJ + COL_MO + hd * 256 + 128 * dh + 8 * h;
#pragma unroll
      for (int nb = 0; nb < 4; ++nb)
#pragma unroll
          for (int j2 = 0; j2 < 2; ++j2) moreg[2 * nb + j2] = *(const u32x4*)(mop + 32 * nb + 16 * j2); }
    float den = 0.f;
    int vB0[4], vB1[4];
#pragma unroll
    for (int nb = 0; nb < 4; ++nb) { vB0[nb] = tr_base(4 * h, 4 * nb + 2 * (g & 1), q4, p4); vB1[nb] = tr_base(8 + 4 * h, 4 * nb + 2 * (g & 1), q4, p4); }
    const int kmask = ((r & 3) << 2) | ((r >> 2) & 3);
#pragma unroll 1
    for (int sb = 0; sb <= tb; ++sb) {
        f32x16 s;
#pragma unroll
        for (int e = 0; e < 16; ++e) s[e] = 0.f;
        const LAS unsigned char* krow = imgK + 256 * (32 * sb + r);
#pragma unroll
        for (int kk = 0; kk < 8; ++kk) { const bf16x8 a = *(const LAS bf16x8*)(krow + 16 * ((2 * kk + h) ^ kmask)); s = mfma32(a, qf[kk], s); }
        __builtin_amdgcn_sched_barrier(0);
#pragma unroll
        for (int g4 = 0; g4 < 4; ++g4) { const f32x4 uu = *(const LAS f32x4*)(mf + 32 * sb + 8 * g4 + 4 * h);
#pragma unroll
            for (int j = 0; j < 4; ++j) { const int e = 4 * g4 + j; const int sl = 32 * sb + 8 * g4 + 4 * h + j;
                const float w = (sl <= tl) ? __expf(uu[j] - Mt) : 0.f; s[e] *= w; den += s[e]; } }
        bf16x8 pb[2];
#pragma unroll
        for (int s2 = 0; s2 < 2; ++s2) { u32x4 w; w.x = cvtpk(s[8 * s2], s[8 * s2 + 1]); w.y = cvtpk(s[8 * s2 + 2], s[8 * s2 + 3]); w.z = cvtpk(s[8 * s2 + 4], s[8 * s2 + 5]); w.w = cvtpk(s[8 * s2 + 6], s[8 * s2 + 7]);
            pb[s2] = __builtin_bit_cast(bf16x8, w); }
        const LAS unsigned char* vsb = imgV + 8192 * sb;
#pragma unroll
        for (int s2 = 0; s2 < 2; ++s2) {
#pragma unroll
            for (int nb = 0; nb < 4; ++nb) { const bf16x8 va = tr_frag2(vsb, vB0[nb], vB1[nb], s2 * 4096);
                acc[nb] = mfma32(va, pb[s2], acc[nb]); }
        }
        __builtin_amdgcn_sched_barrier(0);
    }
    f32x4 ggr[16];
    { const float* gq = F.mlout_g + hd * 256 + 128 * dh + 4 * h;
#pragma unroll
      for (int nb = 0; nb < 4; ++nb)
#pragma unroll
          for (int g4 = 0; g4 < 4; ++g4) ggr[4 * nb + g4] = *(const f32x4*)(gq + 32 * nb + 8 * g4); }
    den += __shfl_xor(den, 32);
    const float dt = wi * qn + den;
    const float inv = 1.0f / fmaxf(fabsf(dt), en);
    float ss = 0.f;
#pragma unroll
    for (int nb = 0; nb < 4; ++nb)
#pragma unroll
        for (int e = 0; e < 16; ++e) { acc[nb][e] *= inv; ss += acc[nb][e] * acc[nb][e]; }
    ss += __shfl_xor(ss, 32);
    if (h == 0) mf[640 + dh * 128 + tl] = ss;
    __syncthreads();
    const float rstd = 1.0f / sqrtf((mf[640 + tl] + mf[640 + 128 + tl]) * (1.f / 256.f) + EPS);
    const size_t tokr = (size_t)(tok0 + tl);
    const float* gp = F.mlout_g + hd * 256 + 128 * dh + 4 * h;
    bf16* outp = (bf16*)(F.ws + WS_MIX) + tokr * DM + 1024 + hd * 256 + 128 * dh + 8 * h;
#pragma unroll
    for (int nb = 0; nb < 4; ++nb)
#pragma unroll
        for (int j2 = 0; j2 < 2; ++j2) { const u32x4 mv = moreg[2 * nb + j2]; u32x2 mo2[2], w2[2]; mo2[0].x = mv.x; mo2[0].y = mv.y; mo2[1].x = mv.z; mo2[1].y = mv.w; swap32(mo2[0], mo2[1]);
#pragma unroll
            for (int q2 = 0; q2 < 2; ++q2) { const int g4 = 2 * j2 + q2; const u32x2 mo = mo2[q2]; const f32x4 gg = ggr[4 * nb + g4];
                const float z0 = __uint_as_float(mo.x << 16), z1 = __uint_as_float(mo.x & 0xffff0000u), z2 = __uint_as_float(mo.y << 16), z3 = __uint_as_float(mo.y & 0xffff0000u);
                const float y0 = acc[nb][4 * g4] * rstd * gg[0] * __builtin_amdgcn_rcpf(1.0f + __expf(-z0)), y1 = acc[nb][4 * g4 + 1] * rstd * gg[1] * __builtin_amdgcn_rcpf(1.0f + __expf(-z1));
                const float y2 = acc[nb][4 * g4 + 2] * rstd * gg[2] * __builtin_amdgcn_rcpf(1.0f + __expf(-z2)), y3 = acc[nb][4 * g4 + 3] * rstd * gg[3] * __builtin_amdgcn_rcpf(1.0f + __expf(-z3));
                w2[q2].x = cvtpk(y0, y1); w2[q2].y = cvtpk(y2, y3); }
            swap32(w2[0], w2[1]); u32x4 w; w.x = w2[0].x; w.y = w2[0].y; w.z = w2[1].x; w.w = w2[1].y;
            *(u32x4*)(outp + 32 * nb + 16 * j2) = w; }
    __syncthreads();
}

DI void p7_router(Frame& F) {
    const float* X1 = F.out; unsigned char* H2 = F.ws + WS_XN;
    const bf16* RH = (const bf16*)(F.ws + WS_RWT); const bf16* RL = RH + NE * DM;
    int* TOPI = (int*)(F.ws + WS_SMALL + SM_TOPI); float* TOPW = (float*)(F.ws + WS_SMALL + SM_TOPW); int* HIST = (int*)(F.ws + WS_CTL + CTL_HIST); float* RSTD = (float*)(F.ws + WS_SMALL + SM_RSTD);
    const int lane = F.lane, g4 = lane >> 4, c = lane & 15;
    LAS unsigned char* himg = F.lds + F.wave * 6144; LAS unsigned char* limg = himg + 2304;
    LAS float* lr = (LAS float*)(himg + 4608);
    LAS unsigned char* fimg = himg + 5120;
    LAS float* gl = (LAS float*)(F.lds + 49152);
    LAS unsigned char* wbuf = F.lds + 57344;
    __syncthreads();
    *(LAS f32x4*)(gl + 4 * F.tid) = *(const f32x4*)(F.ffn_g + 4 * F.tid);
    const char* rhb = (const char*)RH + F.tid * 16; const char* rlb = (const char*)RL + F.tid * 16;
#define P7_G16(gp, la) asm volatile("s_mov_b32 m0, %1\n\tglobal_load_lds_dwordx4 %0, off" :: "v"(gp), "s"(la) : "memory", "m0")
#define P7_DMA(s_) do { const unsigned d_ = __builtin_amdgcn_readfirstlane((unsigned)(unsigned long long)(wbuf + ((s_) & 1) * 32768 + F.wave * 1024)); const size_t so_ = (size_t)(s_) * 16384; \
        P7_G16(rhb + so_, d_); P7_G16(rhb + so_ + 8192, d_ + 8192u); P7_G16(rlb + so_, d_ + 16384u); P7_G16(rlb + so_ + 8192, d_ + 24576u); } while (0)
#define P7_LOADX(slot, ch_) do { xv[slot][0] = *(const f32x4*)(xp + 64 * (ch_)); xv[slot][1] = *(const f32x4*)(xp + 64 * (ch_) + 4 * DM); xv[slot][2] = *(const f32x4*)(xp + 64 * (ch_) + 8 * DM); xv[slot][3] = *(const f32x4*)(xp + 64 * (ch_) + 12 * DM); } while (0)
    for (int t0 = F.vcu * NWAVES; t0 < NTOK / 16; t0 += F.G * NWAVES) {
        const int tile = t0 + F.wave;
        const int tok0 = 16 * tile;
        f32x4 acc0 = {0.f, 0.f, 0.f, 0.f}, acc1 = {0.f, 0.f, 0.f, 0.f};
        float ss0 = 0.f, ss1 = 0.f, ss2 = 0.f, ss3 = 0.f;
        const float* xp = X1 + (size_t)(tok0 + g4) * DM + 4 * c;
        unsigned char* hp = H2 + (size_t)(tok0 + (lane >> 2)) * DM + 16 * (lane & 3);
        f32x4 xv[4][4];
        P7_DMA(0);
        P7_LOADX(0, 0); P7_LOADX(1, 1); P7_LOADX(2, 2);
#pragma unroll 2
        for (int sl = 0; sl < 8; ++sl) {
            asm volatile("s_waitcnt vmcnt(12) lgkmcnt(0)" ::: "memory");
            __builtin_amdgcn_s_barrier(); asm volatile("" ::: "memory");
            if (sl + 1 < 8) P7_DMA(sl + 1);
            const LAS unsigned char* wsl = wbuf + (sl & 1) * 32768 + lane * 16;
#pragma unroll
            for (int u = 0; u < 4; ++u) {
                const int ch = 4 * sl + u;
                { const int cn = (ch + 3 < 32) ? ch + 3 : 31; P7_LOADX((u + 3) & 3, cn); }
                __builtin_amdgcn_sched_barrier(0);
                const f32x4 gv = *(const LAS f32x4*)(gl + 64 * ch + 4 * c);
#define P7_ROW(v, i, ssacc) do { ssacc += (v[0] * v[0] + v[1] * v[1]) + (v[2] * v[2] + v[3] * v[3]); const f32x4 y = v * gv; \
                *(LAS unsigned*)(fimg + (4 * (i) + g4) * 64 + 4 * c) = pk4_fp8(y[0], y[1], y[2], y[3]); \
                u32x2 hi, lo; hi.x = cvtpk(v[0], v[1]); hi.y = cvtpk(v[2], v[3]); \
                lo.x = cvtpk(v[0] - __uint_as_float(hi.x << 16), v[1] - __uint_as_float(hi.x & 0xffff0000u)); lo.y = cvtpk(v[2] - __uint_as_float(hi.y << 16), v[3] - __uint_as_float(hi.y & 0xffff0000u)); \
                *(LAS u32x2*)(himg + (4 * (i) + g4) * 144 + 8 * c) = hi; *(LAS u32x2*)(limg + (4 * (i) + g4) * 144 + 8 * c) = lo; } while (0)
                P7_ROW(xv[u][0], 0, ss0); P7_ROW(xv[u][1], 1, ss1); P7_ROW(xv[u][2], 2, ss2); P7_ROW(xv[u][3], 3, ss3);
#undef P7_ROW
                *(u32x4*)(hp + 64 * ch) = *(const LAS u32x4*)(fimg + 16 * lane);
#pragma unroll
                for (int kk = 0; kk < 2; ++kk) {
                    const bf16x8 bh_ = *(const LAS bf16x8*)(himg + c * 144 + (32 * kk + 8 * g4) * 2), bl_ = *(const LAS bf16x8*)(limg + c * 144 + (32 * kk + 8 * g4) * 2);
                    const bf16x8 ah0 = *(const LAS bf16x8*)(wsl + u * 4096 + (kk * 2) * 1024), ah1 = *(const LAS bf16x8*)(wsl + u * 4096 + (kk * 2 + 1) * 1024);
                    const bf16x8 al0 = *(const LAS bf16x8*)(wsl + 16384 + u * 4096 + (kk * 2) * 1024), al1 = *(const LAS bf16x8*)(wsl + 16384 + u * 4096 + (kk * 2 + 1) * 1024);
                    acc0 = __builtin_amdgcn_mfma_f32_16x16x32_bf16(ah0, bh_, acc0, 0, 0, 0); acc0 = __builtin_amdgcn_mfma_f32_16x16x32_bf16(ah0, bl_, acc0, 0, 0, 0); acc0 = __builtin_amdgcn_mfma_f32_16x16x32_bf16(al0, bh_, acc0, 0, 0, 0);
                    acc1 = __builtin_amdgcn_mfma_f32_16x16x32_bf16(ah1, bh_, acc1, 0, 0, 0); acc1 = __builtin_amdgcn_mfma_f32_16x16x32_bf16(ah1, bl_, acc1, 0, 0, 0); acc1 = __builtin_amdgcn_mfma_f32_16x16x32_bf16(al1, bh_, acc1, 0, 0, 0);
                }
                __builtin_amdgcn_sched_barrier(0);
            }
        }
#undef P7_LOADX
#undef P7_DMA
#undef P7_G16
#define P7_RED(x) do { x += __shfl_xor(x, 1); x += __shfl_xor(x, 2); x += __shfl_xor(x, 4); x += __shfl_xor(x, 8); x = 1.0f / sqrtf(x * (1.f / DM) + EPS); } while (0)
        P7_RED(ss0); P7_RED(ss1); P7_RED(ss2); P7_RED(ss3);
#undef P7_RED
        if (c == 0) { lr[g4] = ss0; lr[4 + g4] = ss1; lr[8 + g4] = ss2; lr[12 + g4] = ss3;
            RSTD[tok0 + g4] = ss0; RSTD[tok0 + 4 + g4] = ss1; RSTD[tok0 + 8 + g4] = ss2; RSTD[tok0 + 12 + g4] = ss3; }
        const float rs = lr[c];
        float v[8];
#pragma unroll
        for (int j = 0; j < 4; ++j) { v[j] = acc0[j] * rs + F.router_b[4 * g4 + j]; v[4 + j] = acc1[j] * rs + F.router_b[16 + 4 * g4 + j]; }
        float sv[4]; int si[4];
#pragma unroll
        for (int k = 0; k < 4; ++k) {
            float bv = v[0]; int bi = 4 * g4;
#pragma unroll
            for (int j = 1; j < 8; ++j) { const int ce = (j < 4) ? (4 * g4 + j) : (16 + 4 * g4 + j - 4); if (v[j] > bv) { bv = v[j]; bi = ce; } }
            { const float ov = __shfl_xor(bv, 16); const int oi = __shfl_xor(bi, 16); if (ov > bv || (ov == bv && oi < bi)) { bv = ov; bi = oi; } }
            { const float ov = __shfl_xor(bv, 32); const int oi = __shfl_xor(bi, 32); if (ov > bv || (ov == bv && oi < bi)) { bv = ov; bi = oi; } }
            sv[k] = bv; si[k] = bi;
#pragma unroll
            for (int j = 0; j < 8; ++j) { const int ce = (j < 4) ? (4 * g4 + j) : (16 + 4 * g4 + j - 4); if (ce == bi) v[j] = -3.0e38f; }
        }
        const float e1 = __expf(sv[1] - sv[0]), e2 = __expf(sv[2] - sv[0]), e3 = __expf(sv[3] - sv[0]);
        const float isum = 1.0f / (1.0f + e1 + e2 + e3);
        const int tok = tok0 + c;
        if (g4 == 0) { *(int4*)(TOPI + (size_t)tok * 4) = make_int4(si[0], si[1], si[2], si[3]); *(f32x4*)(TOPW + (size_t)tok * 4) = (f32x4){isum, e1 * isum, e2 * isum, e3 * isum}; }
        int cnt = 0;
#pragma unroll 4
        for (int e = 0; e < 32; ++e) { const bool has = (g4 == 0) && (si[0] == e || si[1] == e || si[2] == e || si[3] == e);
            const unsigned long long bm = __ballot(has); if (lane == e) cnt = __popcll(bm); }
        if (lane < 32 && cnt > 0) atomicAdd(HIST + (tile >> 1) * 32 + lane, cnt);
    }
}

DI void p8_dispatch(Frame& F) {
    const int* TOPI = (const int*)(F.ws + WS_SMALL + SM_TOPI); const float* TOPW = (const float*)(F.ws + WS_SMALL + SM_TOPW); const int* HIST = (const int*)(F.ws + WS_CTL + CTL_HIST); const float* RSTD = (const float*)(F.ws + WS_SMALL + SM_RSTD); float* ROWS = (float*)(F.ws + WS_SMALL + SM_ROWS);
    int* POS = (int*)(F.ws + WS_SMALL + SM_POS); int* ROWTOK = (int*)(F.ws + WS_SMALL + SM_ROWTOK); float* ROWW = (float*)(F.ws + WS_SMALL + SM_ROWW); int* TILEE = (int*)(F.ws + WS_SMALL + SM_TILEE);
    LAS int* pre = (LAS int*)F.lds;
    LAS int* seg = (LAS int*)(F.lds + MISC_OFF);
    for (int i = F.tid; i < 1024 * 32; i += NTHR) pre[i] = HIST[i];
    __syncthreads();
    { const int e = F.tid & 31, sg = F.tid >> 5; int run = 0;
      for (int i = 0; i < 64; ++i) { const int idx = (sg * 64 + i) * 32 + e; const int v = pre[idx]; pre[idx] = run; run += v; }
      seg[sg * 32 + e] = run; }
    __syncthreads();
    { const int e = F.tid & 31, sg = F.tid >> 5; int base = 0;
      for (int j = 0; j < sg; ++j) base += seg[j * 32 + e];
      for (int i = 0; i < 64; ++i) pre[(sg * 64 + i) * 32 + e] += base;
      if (sg == 15) seg[512 + e] = base + seg[15 * 32 + e]; }
    __syncthreads();
    if (F.tid == 0) { int ps = 0; for (int e = 0; e < 32; ++e) { const int c = seg[512 + e], pc = (c + 255) & ~255; seg[544 + e] = ps; seg[576 + e] = pc; ps += pc; } seg[608] = ps >> 8; }
    __syncthreads();
    const int NT = seg[608];
    const int gw = F.vcu * NWAVES + F.wave, NGW = F.G * NWAVES, lane = F.lane;
    for (int tile = gw; tile < 1024; tile += NGW) {
        const int tok = 32 * tile + (lane & 31);
        const int4 ti = *(const int4*)(TOPI + (size_t)tok * 4); const f32x4 tw = *(const f32x4*)(TOPW + (size_t)tok * 4);
        const int ek = (lane < 32) ? ti.x : ti.y, ek2 = (lane < 32) ? ti.z : ti.w;
        int rk = 0, rk2 = 0;
        for (int e = 0; e < 32; ++e) { const bool has = (lane < 32) && (ti.x == e || ti.y == e || ti.z == e || ti.w == e);
            const unsigned long long bm = __ballot(has); const int below = __popcll(bm & ((1ull << (lane & 31)) - 1ull));
            if (ek == e) rk = below; if (ek2 == e) rk2 = below; }
        const int d1 = seg[544 + ek] + pre[tile * 32 + ek] + rk, d2 = seg[544 + ek2] + pre[tile * 32 + ek2] + rk2;
        const int k1 = (lane < 32) ? 0 : 1, k2 = k1 + 2;
        const float rsd = RSTD[tok];
        ROWTOK[d1] = tok; ROWW[d1] = (lane < 32) ? tw[0] : tw[1]; ROWS[d1] = rsd; POS[(size_t)tok * 4 + k1] = d1;
        ROWTOK[d2] = tok; ROWW[d2] = (lane < 32) ? tw[2] : tw[3]; ROWS[d2] = rsd; POS[(size_t)tok * 4 + k2] = d2;
    }
    if (F.vcu < 32) { const int e = F.vcu, c = seg[512 + e], ps = seg[544 + e], pc = seg[576 + e];
        for (int i = c + F.tid; i < pc; i += NTHR) { ROWTOK[ps + i] = 0; ROWW[ps + i] = 0.f; ROWS[ps + i] = 0.f; } }
    if (F.vcu == 32 % F.G) { for (int rt = F.tid; rt < MAXRT; rt += NTHR) { int e = 31; for (int j = 31; j >= 0; --j) if (rt * 256 < seg[544 + j] + seg[576 + j] && seg[576 + j] > 0 && rt * 256 >= seg[544 + j]) e = j; TILEE[rt] = e; }
        if (F.tid == 0) TILEE[MAXRT] = NT; }
    __syncthreads();
}

DI void p11_combine(Frame& F) {
    const int* POS = (const int*)(F.ws + WS_SMALL + SM_POS); const unsigned char* YB = F.ws + WS_YB;
    const int gw = F.vcu * NWAVES + F.wave, NGW = F.G * NWAVES;
    int4 ps = *(const int4*)(POS + (size_t)(gw < NTOK ? gw : 0) * 4);
#pragma unroll 1
    for (int tok = gw; tok < NTOK; tok += NGW) {
        const int tn = tok + NGW < NTOK ? tok + NGW : tok;
        const int4 psn = *(const int4*)(POS + (size_t)tn * 4);
        f32x4* orow = (f32x4*)(F.out + (size_t)tok * DM) + F.lane;
        const unsigned* y0 = (const unsigned*)(YB + (size_t)ps.x * DM) + F.lane; const unsigned* y1 = (const unsigned*)(YB + (size_t)ps.y * DM) + F.lane;
        const unsigned* y2 = (const unsigned*)(YB + (size_t)ps.z * DM) + F.lane; const unsigned* y3 = (const unsigned*)(YB + (size_t)ps.w * DM) + F.lane;
        f32x4 v[8]; unsigned qa[8], qb[8], qc[8], qd[8];
#pragma unroll
        for (int j = 0; j < 8; ++j) { v[j] = orow[64 * j]; qa[j] = y0[64 * j]; qb[j] = y1[64 * j]; qc[j] = y2[64 * j]; qd[j] = y3[64 * j]; }
        __builtin_amdgcn_sched_barrier(0);
#pragma unroll
        for (int j = 0; j < 8; ++j) { const unsigned a = qa[j], bq = qb[j], cq = qc[j], dq = qd[j];
            const f32x2 a0 = __builtin_amdgcn_cvt_pk_f32_fp8((int)a, false), a1 = __builtin_amdgcn_cvt_pk_f32_fp8((int)a, true), b0 = __builtin_amdgcn_cvt_pk_f32_fp8((int)bq, false), b1 = __builtin_amdgcn_cvt_pk_f32_fp8((int)bq, true);
            const f32x2 c0 = __builtin_amdgcn_cvt_pk_f32_fp8((int)cq, false), c1 = __builtin_amdgcn_cvt_pk_f32_fp8((int)cq, true), d0 = __builtin_amdgcn_cvt_pk_f32_fp8((int)dq, false), d1 = __builtin_amdgcn_cvt_pk_f32_fp8((int)dq, true);
            f32x4 vv = v[j];
            vv[0] += (((a0[0] + b0[0]) + c0[0]) + d0[0]) * 0.0625f; vv[1] += (((a0[1] + b0[1]) + c0[1]) + d0[1]) * 0.0625f;
            vv[2] += (((a1[0] + b1[0]) + c1[0]) + d1[0]) * 0.0625f; vv[3] += (((a1[1] + b1[1]) + c1[1]) + d1[1]) * 0.0625f; orow[64 * j] = vv; }
        ps = psn;
    }
}

constexpr int NPHASE = 12;
__global__ void __launch_bounds__(NTHR, 2) mk_fwd(Args args) {
    extern __shared__ __attribute__((aligned(16))) unsigned char lds_raw[];
    Frame F;
    F.lds = (LAS unsigned char*)lds_raw;
    F.tid = threadIdx.x; F.lane = F.tid & 63; F.wave = __builtin_amdgcn_readfirstlane(F.tid >> 6);
    F.G = gridDim.x; { const int bx = blockIdx.x; F.vcu = (F.G % 8 == 0) ? (bx % 8) * (F.G / 8) + bx / 8 : bx; }
    F.x = args.in[0]; F.attn_g = args.in[1]; F.w_in = args.in[2]; F.qg = args.in[3]; F.kg = args.in[4]; F.conv_w = args.in[5]; F.conv_b = args.in[6]; F.i_b = args.in[7]; F.f_b = args.in[8];
    F.mlout_g = args.in[9]; F.w_out = args.in[10]; F.ffn_g = args.in[11]; F.router_w = args.in[12]; F.router_b = args.in[13]; F.w_up = args.in[14]; F.b_up = args.in[15]; F.w_down = args.in[16]; F.b_down = args.in[17];
    F.out = args.out; F.ws = args.ws;
    volatile LAS unsigned* MISCW = (volatile LAS unsigned*)(F.lds + LDS_BYTES - 64);
    if (F.tid < 16) MISCW[F.tid] = 0u;
    __syncthreads();
    XcdBarrier bar; bar.bar = (unsigned*)(F.ws + WS_CTL) + CW_BAR; bar.x = 0; bar.st = nullptr;
    if (N_LAUNCHES == 1) bar = xcd_barrier_post((unsigned*)(F.ws + WS_CTL) + CW_BAR, MISCW);
    const int lo = args.ph_lo, hi = args.ph_hi;
#ifndef PHASE_MASK
#define PHASE_MASK 0xfff
#endif
#define IN(k) ((((PHASE_MASK) >> (k)) & 1) && lo <= (k) && (k) < hi)
#define SEAM(k) do { if (IN(k) && IN((k) + 1)) xcd_barrier(bar); } while (0)

    if (IN(0)) { p0_prologue(F); } SEAM(0);
    if (IN(1)) {
        const int NGEMM = (F.G == 256) ? 192 : F.G;
        if ((int)blockIdx.x < NGEMM) { pg8::Gemm g{(const bf16*)(F.ws + WS_XN), (const bf16*)(F.ws + WS_WIN), DM, 0, nullptr, nullptr, nullptr, nullptr}; pg8::StaticOrder S; S.init(NTOK / 256, NPROJ / 256, NGEMM, (int)blockIdx.x);
            pg8::EpiProj E{(bf16*)(F.ws + WS_PROJ), NPROJ, F.qg, F.kg, (const float*)(F.ws + WS_SMALL + SM_ROPE), (LAS float*)(F.lds + MISC_OFF), (bf16*)(F.ws + WS_HM)}; pg8::gemm_phase<pg8::EpiProj, false, false, false>(F.lds, g, S, E);
            { VM_WAIT(); __syncthreads();
              if (F.tid == 0) { unsigned* ctr = (unsigned*)(F.ws + WS_CTL) + CW_SUB; __builtin_amdgcn_fence(__ATOMIC_RELEASE, "agent"); VM_WAIT(); xb_add(ctr, 1u);
                  unsigned sp = 0; while (xb_ld(ctr) < (unsigned)NGEMM) { __builtin_amdgcn_s_sleep(2); if (++sp > (1u << 22)) break; }
                  __builtin_amdgcn_fence(__ATOMIC_ACQUIRE, "agent"); VM_WAIT(); }
              __syncthreads(); }
            p2_conv(F, (int)blockIdx.x, NGEMM); }
        if (F.G == 256) { if ((int)blockIdx.x >= NGEMM) p0_expert_weights(F, (int)blockIdx.x - NGEMM, F.G - NGEMM); }
        else p0_expert_weights(F, F.vcu, F.G);
    } SEAM(1);
    if (IN(3)) {
#ifndef SKIP_ML
        for (int u = F.vcu; u < 1024; u += F.G) mlstm_m1_unit(F, u);
#endif
#ifndef SKIP_ATTN
        attn_phase<1, true, false>(F);
#endif
    } SEAM(3);
    if (IN(4)) {
#ifndef SKIP_ML
        mlstm_scan(F);
#endif
#ifndef SKIP_ATTN
        attn_phase<4, false, false>(F);
#endif
    } SEAM(4);
    if (IN(5)) {
#ifndef SKIP_ML
        for (int u = F.vcu; u < 1024; u += F.G) mlstm_m3_unit(F, u);
#endif
#ifndef SKIP_ATTN
        attn_phase<16, false, true>(F);
#endif
    } SEAM(5);
    if (IN(6)) { pg8::Gemm g{(const bf16*)(F.ws + WS_MIX), (const bf16*)(F.ws + WS_WOUT), DM, 0, nullptr, nullptr, nullptr, nullptr}; pg8::StaticOrder S; S.init(NTOK / 256, DM / 256, F.G, (int)blockIdx.x);
        pg8::EpiResid E{F.x, F.out, DM}; pg8::gemm_phase<pg8::EpiResid, false, false, false>(F.lds, g, S, E); } SEAM(6);
    if (IN(7)) { p7_router(F); } SEAM(7);
    if (IN(8)) { p8_dispatch(F); } SEAM(8);
    if (IN(9) || IN(10)) {
        LAS int* te = (LAS int*)(F.lds + MISC_OFF);
        const int* TILEE = (const int*)(F.ws + WS_SMALL + SM_TILEE);
        __syncthreads();
        for (int i = F.tid; i <= MAXRT; i += NTHR) te[i] = (int)__hip_atomic_load(TILEE + i, __ATOMIC_RELAXED, __HIP_MEMORY_SCOPE_AGENT);
        __syncthreads();
        const int NT = te[MAXRT];
        if (IN(9)) { pg8::Gemm g{(const bf16*)(F.ws + WS_XN), (const bf16*)(F.ws + WS_WUP), DM / 2, (size_t)UPW * DM, (const int*)(F.ws + WS_SMALL + SM_ROWTOK), te, F.lds + MISC_OFF + 4096, F.lds + ESTASH_OFF};   pg8::StaticOrder S; S.init(NT, UPW / 256, F.G, (int)blockIdx.x);
            pg8::EpiUp E{F.ws + WS_ACT, F.b_up, (const float*)(F.ws + WS_SMALL + SM_ROWS)}; pg8::gemm_phase<pg8::EpiUp, true, true, true>(F.lds, g, S, E); }
        SEAM(9);
        if (IN(10)) { pg8::Gemm g{(const bf16*)(F.ws + WS_ACT), (const bf16*)(F.ws + WS_WDN), FF / 2, (size_t)DM * FF, nullptr, te, nullptr, F.lds + ESTASH_OFF}; pg8::StaticOrder S; S.init(NT, DM / 256, F.G, (int)blockIdx.x);
            pg8::EpiDown E{F.ws + WS_YB, F.b_down, (const float*)(F.ws + WS_SMALL + SM_ROWW)}; pg8::gemm_phase<pg8::EpiDown, false, true, true>(F.lds, g, S, E); }
    }
    SEAM(10);
    if (IN(11)) { p11_combine(F); }
#undef IN
#undef SEAM
}

extern "C" void kernel_launch(void* const* d_in, const int* in_sizes, int n_in, void* d_out, int out_size, void* d_ws, size_t ws_size, hipStream_t stream) {
    static int grid = 0;
    if (grid == 0) {
        if (n_in != 18 || out_size != NTOK * DM || ws_size < WS_END) { fprintf(stderr, "kernel_launch: unexpected shapes (n_in %d, out %d, ws %zu)\n", n_in, out_size, ws_size); grid = -1; return; }
        int dev = 0, cus = 0, per_cu = 0;
        if (hipGetDevice(&dev) != hipSuccess || hipDeviceGetAttribute(&cus, hipDeviceAttributeMultiprocessorCount, dev) != hipSuccess) { grid = -1; return; }
        if (hipFuncSetAttribute((const void*)mk_fwd, hipFuncAttributeMaxDynamicSharedMemorySize, LDS_BYTES) != hipSuccess) { fprintf(stderr, "kernel_launch: hipFuncSetAttribute failed\n"); grid = -1; return; }
        if (hipOccupancyMaxActiveBlocksPerMultiprocessor(&per_cu, (const void*)mk_fwd, NTHR, LDS_BYTES) != hipSuccess || per_cu < 1) fprintf(stderr, "kernel_launch: occupancy query says %d\n", per_cu);
        (void)hipGetLastError();
        grid = cus;
    }
    if (grid < 0) return;
    (void)hipMemsetAsync((char*)d_ws + WS_CTL, 0, CTL_ZERO_BYTES, stream);
    Args a{};
    for (int i = 0; i < 18; ++i) a.in[i] = (const float*)d_in[i];
    a.out = (float*)d_out; a.ws = (unsigned char*)d_ws;
    if (N_LAUNCHES == 1) { a.ph_lo = 0; a.ph_hi = PH_STOP; hipLaunchKernelGGL(mk_fwd, dim3(grid), dim3(NTHR), LDS_BYTES, stream, a); }
    else { for (int ph = 0; ph < PH_STOP; ++ph) { a.ph_lo = ph; a.ph_hi = ph + 1; hipLaunchKernelGGL(mk_fwd, dim3(grid), dim3(NTHR), LDS_BYTES, stream, a); } }
}
```

```cpp
#include <hip/hip_runtime.h>
#include <cstdio>
#include <cstdint>

#ifndef N_LAUNCHES
#define N_LAUNCHES 1
#endif
#ifndef PH_STOP
#define PH_STOP 12
#endif

#define DI __device__ __forceinline__
#define GAS __attribute__((address_space(1)))
#define LAS __attribute__((address_space(3)))
typedef unsigned short bf16;
typedef short bf16x8 __attribute__((ext_vector_type(8)));
typedef short s16x4 __attribute__((ext_vector_type(4)));
typedef float f32x4 __attribute__((ext_vector_type(4)));
typedef float f32x2 __attribute__((ext_vector_type(2)));
typedef float f32x16 __attribute__((ext_vector_type(16)));
typedef unsigned u32x4 __attribute__((ext_vector_type(4)));
typedef unsigned u32x2 __attribute__((ext_vector_type(2)));
typedef __bf16 bf16x2_t __attribute__((ext_vector_type(2)));
typedef GAS unsigned gu32;

constexpr int SEQ = 16384, NBATCH = 2, NTOK = NBATCH * SEQ, DM = 2048, NPROJ = 6144, INW = 6152;
constexpr int COL_AQ = 0, COL_AK = 1024, COL_AV = 2048, COL_MQ = 3072, COL_MK = 3584, COL_MV = 4096, COL_MO = 5120;
constexpr int NE = 32, FF = 2048, UPW = 4096;
constexpr int MAXRT = 544, MAXSLOT = MAXRT * 256;
constexpr int NCH = 128;
constexpr float EPS = 1e-6f;
constexpr float QSCALE = 0.08838834764831845f;

constexpr size_t MiB = 1u << 20;
constexpr size_t WS_CTL = 0, CTL_ZERO_BYTES = 1 * MiB;
constexpr size_t WS_WIN = 2 * MiB;
constexpr size_t WS_WOUT = 26 * MiB;
constexpr size_t WS_RWT = 34 * MiB;
constexpr size_t WS_GATES = 35 * MiB;
constexpr size_t WS_SMALL = 36 * MiB;
constexpr size_t WS_WUP = 64 * MiB;
constexpr size_t WS_WDN = 576 * MiB;
constexpr size_t WS_XN = 832 * MiB;
constexpr size_t WS_PROJ = 960 * MiB;
constexpr size_t WS_QC = 1344 * MiB;
constexpr size_t WS_KC = 1376 * MiB;
constexpr size_t WS_CLOC = 1408 * MiB;
constexpr size_t WS_CPREV = 1536 * MiB;
constexpr size_t WS_OST = 1600 * MiB;
constexpr size_t WS_ML = 1728 * MiB;
constexpr size_t WS_MIX = 1732 * MiB;
constexpr size_t WS_ACT = 1860 * MiB;
constexpr size_t WS_YB = 2404 * MiB;
constexpr size_t WS_HM = WS_YB + 272 * MiB;
constexpr size_t HM_PLANE = (size_t)NTOK * 1024;
constexpr size_t WS_END = 2948 * MiB;
constexpr size_t SM_NLOC = 0;
constexpr size_t SM_NPREV = 512 * 1024;
constexpr size_t SM_G = 1024 * 1024;
constexpr size_t SM_MLOC = SM_G + 4096;
constexpr size_t SM_MPREV = SM_MLOC + 4096;
constexpr size_t SM_TOPI = SM_MPREV + 4096;
constexpr size_t SM_TOPW = SM_TOPI + 512 * 1024;
constexpr size_t SM_HIST = SM_TOPW + 512 * 1024;
constexpr size_t SM_POS = SM_HIST + 128 * 1024;
constexpr size_t SM_ROWTOK = SM_POS + 512 * 1024;
constexpr size_t SM_ROWW = SM_ROWTOK + 544 * 1024;
constexpr size_t SM_TILEE = SM_ROWW + 544 * 1024;
constexpr size_t SM_RSTD = SM_TILEE + 4096;
constexpr size_t SM_ROWS = SM_RSTD + 128 * 1024;
constexpr size_t SM_ROPE = SM_ROWS + 544 * 1024;
static_assert(SM_ROPE + 2 * MiB <= 16 * MiB, "small tables (WS_SMALL .. WS_WUP is 28 MiB)");
constexpr size_t CTL_HIST = 256 * 1024;
constexpr int CW_BAR = 4096, CW_SUB = 8192;

constexpr int RING_BYTES = 131072, MISC_OFF = RING_BYTES, ESTASH_OFF = MISC_OFF + 16384, LDS_BYTES = ESTASH_OFF + 8 * 768 + 64;
constexpr int NWAVES = 8, NTHR = 512;

DI unsigned cvtpk(float lo, float hi) { f32x2 v = {lo, hi}; bf16x2_t b = __builtin_convertvector(v, bf16x2_t); return __builtin_bit_cast(unsigned, b); }
DI unsigned pk4_fp8(float a, float b, float c, float d) {
    a = fminf(fmaxf(a, -448.f), 448.f); b = fminf(fmaxf(b, -448.f), 448.f); c = fminf(fmaxf(c, -448.f), 448.f); d = fminf(fmaxf(d, -448.f), 448.f);
    int v = __builtin_amdgcn_cvt_pk_fp8_f32(a, b, 0, false); v = __builtin_amdgcn_cvt_pk_fp8_f32(c, d, v, true); return (unsigned)v; }
DI unsigned pk4_fp8m(float a, float b, float c, float d) {
    a = __builtin_amdgcn_fmed3f(a, -448.f, 448.f); b = __builtin_amdgcn_fmed3f(b, -448.f, 448.f); c = __builtin_amdgcn_fmed3f(c, -448.f, 448.f); d = __builtin_amdgcn_fmed3f(d, -448.f, 448.f);
    int v = __builtin_amdgcn_cvt_pk_fp8_f32(a, b, 0, false); v = __builtin_amdgcn_cvt_pk_fp8_f32(c, d, v, true); return (unsigned)v; }
DI void swap32(u32x2& a, u32x2& b) {
    const auto r0 = __builtin_amdgcn_permlane32_swap(a.x, b.x, false, false); const auto r1 = __builtin_amdgcn_permlane32_swap(a.y, b.y, false, false);
    a.x = r0[0]; b.x = r0[1]; a.y = r1[0]; b.y = r1[1]; }
DI float bf2f(unsigned short b) { return __uint_as_float(((unsigned)b) << 16); }
DI float wave_sum(float v) {
#pragma unroll
    for (int o = 1; o < 64; o <<= 1) v += __shfl_xor(v, o);
    return v;
}
DI float wave_max(float v) {
#pragma unroll
    for (int o = 1; o < 64; o <<= 1) v = fmaxf(v, __shfl_xor(v, o));
    return v;
}
DI f32x16 mfma32(bf16x8 a, bf16x8 b, f32x16 c) { return __builtin_amdgcn_mfma_f32_32x32x16_bf16(a, b, c, 0, 0, 0); }
DI int crow(int reg, int h) { return (reg & 3) + 8 * (reg >> 2) + 4 * h; }
DI int img_off(int row, int ch) { return 256 * row + 16 * (ch ^ (((row & 3) << 2) | ((row >> 2) & 3))); }
typedef short v4i16_t __attribute__((ext_vector_type(4)));
DI s16x4 tr16(const LAS unsigned char* p) { return __builtin_bit_cast(s16x4, __builtin_amdgcn_ds_read_tr16_b64_v4i16((LAS v4i16_t*)p)); }
DI bf16x8 tr_frag(const LAS unsigned char* img, int r0a, int r0b, int cch, int q, int p) {
    const s16x4 lo = tr16(img + img_off(r0a + q, cch + (p >> 1)) + 8 * (p & 1));
    const s16x4 hi = tr16(img + img_off(r0b + q, cch + (p >> 1)) + 8 * (p & 1));
    return __builtin_shufflevector(lo, hi, 0, 1, 2, 3, 4, 5, 6, 7);
}
DI int tr_base(int rlane, int cch, int q, int p) { return img_off(rlane + q, cch + (p >> 1)) + 8 * (p & 1); }
DI bf16x8 tr_frag2(const LAS unsigned char* img, int ba, int bb, int off) { const s16x4 lo = tr16(img + ba + off), hi = tr16(img + bb + off); return __builtin_shufflevector(lo, hi, 0, 1, 2, 3, 4, 5, 6, 7); }
DI bf16x8 row_frag(const LAS unsigned char* img, int row, int ch) { return *(const LAS bf16x8*)(img + img_off(row, ch)); }
#define LDS_WAIT() asm volatile("s_waitcnt lgkmcnt(0)" ::: "memory")
#define VM_WAIT() asm volatile("s_waitcnt vmcnt(0)" ::: "memory")

#define XB_TMO      128
#define XB_XCNT(j)  (256  + 64 * (j))
#define XB_XSUB(j)  (1280 + 64 * (j))
#define XB_XGEN(j)  (2304 + 64 * (j))
#define XB_TOP      3328
#define XB_TOPGEN   3392
#define XCD_BAR_WORDS 3456
#define XB_SPIN_CAP (1u << 18)
DI unsigned xb_ld(unsigned* p)              { return __hip_atomic_load(p, __ATOMIC_RELAXED, __HIP_MEMORY_SCOPE_AGENT); }
DI unsigned xb_add(unsigned* p, unsigned v) { return __hip_atomic_fetch_add(p, v, __ATOMIC_RELAXED, __HIP_MEMORY_SCOPE_AGENT); }
DI unsigned xb_xcc_id() { return (unsigned)__builtin_amdgcn_s_getreg((3 << 11) | 20) & 0xFu; }
#define XB_SPIN(cond, bar) do { unsigned _sp = 0; while (cond) { __builtin_amdgcn_s_sleep(1); \
    if ((++_sp & 255u) == 0u) { if (xb_ld(&(bar)[XB_TMO])) break; if (_sp > XB_SPIN_CAP) { atomicAdd(&(bar)[XB_TMO], 1u); break; } } } } while (0)
struct XcdBarrier { unsigned* bar; unsigned x; volatile LAS unsigned* st; };
DI XcdBarrier xcd_barrier_post(unsigned* bar, volatile LAS unsigned* st) {
    XcdBarrier b; b.bar = bar; b.x = xb_xcc_id(); b.st = st;
    if (threadIdx.x == 0) (void)xb_add(&bar[XB_XCNT(b.x)], 1u);
    return b;
}
DI void xcd_barrier_complete(unsigned* bar, unsigned x, unsigned& nloc, unsigned& nx) {
    const unsigned G = gridDim.x * gridDim.y * gridDim.z;
    unsigned sum, cnt, mine, sp = 0u;
    for (;;) {
        sum = 0u; cnt = 0u; mine = 0u;
#pragma unroll
        for (unsigned j = 0; j < 16; ++j) { const unsigned c = xb_ld(&bar[XB_XCNT(j)]); sum += c; cnt += (c > 0u) ? 1u : 0u; mine = (j == x) ? c : mine; }
        if (sum == G) break;
        __builtin_amdgcn_s_sleep(1);
        if ((++sp & 255u) == 0u) { if (xb_ld(&bar[XB_TMO])) break; if (sp > XB_SPIN_CAP) { atomicAdd(&bar[XB_TMO], 1u); break; } }
    }
    nloc = mine > 0u ? mine : 1u; nx = cnt > 0u ? cnt : 1u;
}
DI void xcd_barrier(const XcdBarrier& b) {
    asm volatile("s_waitcnt vmcnt(0)" ::: "memory");
    __syncthreads();
    if (threadIdx.x == 0) {
        unsigned* bar = b.bar;
        __builtin_amdgcn_s_waitcnt(0);
        unsigned nloc = b.st[0], nx = b.st[1];
        if (nloc == 0u) { xcd_barrier_complete(bar, b.x, nloc, nx); b.st[0] = nloc; b.st[1] = nx; }
        const unsigned old = xb_add(&bar[XB_XSUB(b.x)], 1u);
        const unsigned gen = old / nloc;
        if (old + 1u == (gen + 1u) * nloc) {
            __builtin_amdgcn_fence(__ATOMIC_RELEASE, "agent");
            asm volatile("s_waitcnt vmcnt(0)" ::: "memory");
            const unsigned og = xb_add(&bar[XB_TOP], 1u);
            const unsigned tg = og / nx;
            if (og + 1u == (tg + 1u) * nx) xb_add(&bar[XB_TOPGEN], 1u);
            else XB_SPIN(xb_ld(&bar[XB_TOPGEN]) == tg, bar);
            __builtin_amdgcn_fence(__ATOMIC_ACQUIRE, "agent");
            xb_add(&bar[XB_XGEN(b.x)], 1u);
            asm volatile("s_waitcnt vmcnt(0)" ::: "memory");
        } else {
            XB_SPIN(xb_ld(&bar[XB_XGEN(b.x)]) == gen, bar);
            __builtin_amdgcn_fence(__ATOMIC_ACQUIRE, "agent");
            asm volatile("s_waitcnt vmcnt(0)" ::: "memory");
        }
    }
    __syncthreads();
}

struct Args { const float* in[18]; float* out; unsigned char* ws; int ph_lo, ph_hi; };
struct Frame {
    LAS unsigned char* lds; int tid, lane, wave, vcu, G;
    const float *x, *attn_g, *w_in, *qg, *kg, *conv_w, *conv_b, *i_b, *f_b, *mlout_g, *w_out, *ffn_g, *router_w, *router_b, *w_up, *b_up, *w_down, *b_down;
    float* out; unsigned char* ws;
};

namespace pg8 {
typedef int v8i32 __attribute__((ext_vector_type(8)));
constexpr int BM = 256, BK = 64, HALF = 128, HTB = HALF * BK * 2, STAGE_BYTES = 8 * HTB, NXCD = 8, WGM = 8;
DI int lds_byte(int r, int c) { const int st = (r >> 4) * 2 + (c >> 5), rr = r & 15, cc = c & 31, ob = rr * 64 + cc * 2; return st * 1024 + (ob ^ (((ob >> 9) & 1) << 5)); }
DI void stage_rc(int b, int& R, int& C) { const int st = b / 1024, sb = b % 1024, swz = sb ^ (((sb >> 9) & 1) << 5); R = (st >> 1) * 16 + swz / 64; C = (st & 1) * 32 + (swz % 64) / 2; }
DI int perm32(int rho) { const int n = rho >> 4, i = rho & 15; return 8 * (i >> 2) + 4 * n + (i & 3); }
DI const char* sptr(const char* p) { const unsigned long long v = (unsigned long long)p; const unsigned lo = __builtin_amdgcn_readfirstlane((unsigned)v), hi = __builtin_amdgcn_readfirstlane((unsigned)(v >> 32)); return (const char*)(((unsigned long long)hi << 32) | lo); }
struct Unit { int pm, pn, e; };
struct Gemm { const bf16* A; const bf16* Bt; int K; size_t estride; const int* rowtok; const LAS int* tile_e; LAS unsigned char* stash; LAS unsigned char* estash; };
struct StaticOrder {
    int nM, nN, nwg, G, c;
    DI void init(int nM_, int nN_, int G_, int c_) { nM = nM_; nN = nN_; nwg = nM * nN; G = G_; c = c_; }
    DI bool next(int i, Unit& u) const {
        const long L = (long)i * G + c; if (L >= nwg) return false;
        int wgid = (int)L; { const int q = nwg / NXCD, r = nwg % NXCD, xcd = wgid % NXCD, off = wgid / NXCD; wgid = (xcd < r ? xcd * (q + 1) : r * (q + 1) + (xcd - r) * q) + off; }
        const int nig = WGM * nN, gid = wgid / nig, fm = gid * WGM, gsz = (nM - fm) < WGM ? (nM - fm) : WGM;
        u.pm = fm + ((wgid % nig) % gsz); u.pn = (wgid % nig) / gsz; u.e = 0; return true;
    }
};
template <class Epi, bool GATHER, bool EXPERT, bool FP8>
DI void gemm_phase(LAS unsigned char* lds, const Gemm g, const StaticOrder& S, const Epi& E) {
    const int tid = threadIdx.x, wid = __builtin_amdgcn_readfirstlane(tid >> 6), lane = tid & 63, wr = wid >> 2, wc = wid & 3, fr = lane & 15, fq = lane >> 4;
    const int K = g.K, nt = K / BK;
    unsigned voffB[2], coffA[2][2];
    const size_t kstep = (size_t)(BK * 2), hstep = (size_t)HALF * K * 2, tstep = 2 * hstep;
#pragma unroll
    for (int i = 0; i < 2; ++i) { int R, C; stage_rc(tid * 16 + i * 8192, R, C); const int Rb = Epi::PERM ? ((R & ~31) + perm32(R & 31)) : R;
        voffB[i] = (unsigned)(Rb * K + C) * 2u; }
    const unsigned ldsw = (unsigned)wid * 1024u;
    const int aoff = lds_byte(wr * 64 + fr, fq * 8), boff = lds_byte(wc * 32 + fr, fq * 8);
#define PG8_SA(b, h) (((b) * 2 + (h)) * HTB)
#define PG8_SB(b, h) ((4 + (b) * 2 + (h)) * HTB)
#define PG8_GLDS(gp, lp) __builtin_amdgcn_global_load_lds((const unsigned*)(gp), (LAS unsigned*)(lp), 16, 0, 0)
#define PG8_OPQ(x) ({ unsigned o_ = (x); asm volatile("" : "+v"(o_)); o_; })
#define PG8_STAGE_B(bufoff, gbase) do { const char* sb_ = (const char*)(gbase); PG8_GLDS(sb_ + PG8_OPQ(voffB[0]), lds + (bufoff) + ldsw); PG8_GLDS(sb_ + PG8_OPQ(voffB[1]), lds + (bufoff) + ldsw + 8192); } while (0)
#define PG8_STAGE_A(bufoff, gbase, o0, o1) do { const char* sb_ = (const char*)(gbase); PG8_GLDS(sb_ + PG8_OPQ(o0), lds + (bufoff) + ldsw); PG8_GLDS(sb_ + PG8_OPQ(o1), lds + (bufoff) + ldsw + 8192); } while (0)
#define PG8_LDA(dst, b, h) do { _Pragma("unroll") for (int m = 0; m < 4; ++m) _Pragma("unroll") for (int k = 0; k < 2; ++k) dst[m][k] = *(const LAS bf16x8*)(lds + PG8_SA(b, h) + aoff + m * 2048 + k * 1024); } while (0)
#define PG8_LDB(dst, b, h) do { _Pragma("unroll") for (int n = 0; n < 2; ++n) _Pragma("unroll") for (int k = 0; k < 2; ++k) dst[n][k] = *(const LAS bf16x8*)(lds + PG8_SB(b, h) + boff + n * 2048 + k * 1024); } while (0)
#define PG8_CAT(x) __builtin_bit_cast(v8i32, __builtin_shufflevector(x[0], x[1], 0, 1, 2, 3, 4, 5, 6, 7, 8, 9, 10, 11, 12, 13, 14, 15))
#define PG8_MMA(ai, bj, At, Bt) do { __builtin_amdgcn_s_setprio(1); _Pragma("unroll") for (int m = 0; m < 4; ++m) _Pragma("unroll") for (int n = 0; n < 2; ++n) { \
        if (FP8) acc[ai][bj][m][n] = __builtin_amdgcn_mfma_scale_f32_16x16x128_f8f6f4(PG8_CAT(Bt[n]), PG8_CAT(At[m]), acc[ai][bj][m][n], 0, 0, 0, 0x7F7F7F7F, 0, 0x7F7F7F7F); \
        else { _Pragma("unroll") for (int k = 0; k < 2; ++k) acc[ai][bj][m][n] = __builtin_amdgcn_mfma_f32_16x16x32_bf16(Bt[n][k], At[m][k], acc[ai][bj][m][n], 0, 0, 0); } } \
        __builtin_amdgcn_s_setprio(0); \
        asm volatile("" : "+v"(acc[ai][bj][0][0]), "+v"(acc[ai][bj][0][1]), "+v"(acc[ai][bj][1][0]), "+v"(acc[ai][bj][1][1]), "+v"(acc[ai][bj][2][0]), "+v"(acc[ai][bj][2][1]), "+v"(acc[ai][bj][3][0]), "+v"(acc[ai][bj][3][1])); } while (0)
#define PG8_WAIT_V(n) asm volatile("s_waitcnt vmcnt(" #n ")" ::: "memory")
#define PG8_WAIT_L(n) asm volatile("s_waitcnt lgkmcnt(" #n ")" ::: "memory")
#define PG8_BAR __builtin_amdgcn_s_barrier()
#define PG8_SCHED __builtin_amdgcn_sched_barrier(0)
#define PG8_OFFS(dst, pm_) do { int t2_ = threadIdx.x; asm volatile("" : "+v"(t2_)); _Pragma("unroll") for (int i_ = 0; i_ < 2; ++i_) { int R_, C_; stage_rc(t2_ * 16 + i_ * 8192, R_, C_); \
        _Pragma("unroll") for (int h_ = 0; h_ < 2; ++h_) { \
        if (GATHER) dst[h_][i_] = (unsigned)g.rowtok[(pm_) * 256 + h_ * 128 + R_] * (unsigned)(K * 2) + (unsigned)(C_ * 2); \
        else dst[h_][i_] = (unsigned)((h_ * 128 + R_) * K + C_) * 2u; } } } while (0)
    Unit cur, nxt; int ui = 0;
    if (!S.next(0, cur)) return;
    if (EXPERT) cur.e = __builtin_amdgcn_readfirstlane(g.tile_e[cur.pm]);
    f32x4 acc[2][2][4][2];
#pragma unroll
    for (int a = 0; a < 2; ++a)
#pragma unroll
        for (int b = 0; b < 2; ++b)
#pragma unroll
            for (int m = 0; m < 4; ++m)
#pragma unroll
                for (int n = 0; n < 2; ++n) acc[a][b][m][n] = (f32x4){0.f, 0.f, 0.f, 0.f};
    bf16x8 At[4][2], B0[2][2], B1[2][2];
    PG8_OFFS(coffA, cur.pm);
    const char* cA = sptr((const char*)g.A + (GATHER ? (size_t)0 : (size_t)cur.pm * tstep));
    const char* cB = sptr((const char*)g.Bt + (size_t)cur.e * g.estride + (size_t)cur.pn * tstep);
    LAS unsigned char* est = g.estash + wid * 768;
    if (Epi::STASH) E.prefetch(cur, wr, wc, lane, est);
    LAS unsigned char* stash = g.stash + wid * 256;
    PG8_STAGE_B(PG8_SB(0, 0), cB); PG8_STAGE_B(PG8_SB(0, 1), cB + hstep); PG8_STAGE_A(PG8_SA(0, 0), cA, coffA[0][0], coffA[0][1]); PG8_STAGE_A(PG8_SA(0, 1), cA, coffA[1][0], coffA[1][1]);
    if (wr == 1) PG8_BAR;
    PG8_WAIT_V(2); PG8_BAR;
    PG8_STAGE_B(PG8_SB(1, 0), cB + kstep); PG8_STAGE_A(PG8_SA(1, 0), cA + kstep, coffA[0][0], coffA[0][1]); PG8_STAGE_B(PG8_SB(1, 1), cB + hstep + kstep);
    PG8_WAIT_V(6); PG8_BAR;
#define PG8_TRIP(a1, a2, b2, a3, b3, o00, o01, o10, o11) do { \
            PG8_LDB(B0, 0, 0); PG8_LDB(B1, 0, 1); PG8_SCHED; PG8_LDA(At, 0, 0); PG8_STAGE_A(PG8_SA(1, 1), a1, coffA[1][0], coffA[1][1]); \
            PG8_WAIT_V(8); PG8_WAIT_L(0); PG8_BAR; PG8_MMA(0, 0, At, B0); PG8_MMA(0, 1, At, B1); PG8_BAR; PG8_SCHED; \
            PG8_LDA(At, 0, 1); PG8_STAGE_B(PG8_SB(0, 0), b2); PG8_STAGE_B(PG8_SB(0, 1), (b2) + hstep); PG8_STAGE_A(PG8_SA(0, 0), a2, o00, o01); \
            PG8_WAIT_V(8); PG8_WAIT_L(0); PG8_BAR; PG8_MMA(1, 0, At, B0); PG8_MMA(1, 1, At, B1); PG8_BAR; PG8_SCHED; \
            PG8_LDB(B0, 1, 0); PG8_LDB(B1, 1, 1); PG8_SCHED; PG8_LDA(At, 1, 0); PG8_STAGE_A(PG8_SA(0, 1), a2, o10, o11); \
            PG8_WAIT_V(8); PG8_WAIT_L(0); PG8_BAR; PG8_MMA(0, 0, At, B0); PG8_MMA(0, 1, At, B1); PG8_BAR; PG8_SCHED; \
            PG8_LDA(At, 1, 1); PG8_STAGE_B(PG8_SB(1, 0), b3); PG8_STAGE_B(PG8_SB(1, 1), (b3) + hstep); PG8_STAGE_A(PG8_SA(1, 0), a3, o00, o01); \
            PG8_WAIT_V(8); PG8_WAIT_L(0); PG8_BAR; PG8_MMA(1, 0, At, B0); PG8_MMA(1, 1, At, B1); PG8_BAR; PG8_SCHED; } while (0)
    for (;;) {
        const bool has_next = S.next(ui + 1, nxt);
        if (EXPERT) nxt.e = has_next ? __builtin_amdgcn_readfirstlane(g.tile_e[nxt.pm]) : 0;
        const char* nA = sptr(has_next ? (const char*)g.A + (GATHER ? (size_t)0 : (size_t)nxt.pm * tstep) : cA);
        const char* nB = sptr(has_next ? (const char*)g.Bt + (size_t)nxt.e * g.estride + (size_t)nxt.pn * tstep : cB);
        if (GATHER && has_next) {
            int t2_ = threadIdx.x; asm volatile("" : "+v"(t2_));
#pragma unroll
            for (int i_ = 0; i_ < 2; ++i_) { int R_, C_; stage_rc(t2_ * 16 + i_ * 8192, R_, C_);
#pragma unroll
                for (int h_ = 0; h_ < 2; ++h_) __builtin_amdgcn_global_load_lds((const unsigned*)(g.rowtok + nxt.pm * 256 + h_ * 128 + R_), (LAS unsigned*)(stash + (h_ * 2 + i_) * 2048), 4, 0, 0); }
        }
        int C0x2 = 0, C1x2 = 0; const LAS unsigned* sp = nullptr;
        if (GATHER) { int t2_ = threadIdx.x; asm volatile("" : "+v"(t2_)); int R0_, C0_, R1_, C1_; stage_rc(t2_ * 16, R0_, C0_); stage_rc(t2_ * 16 + 8192, R1_, C1_); C0x2 = C0_ * 2; C1x2 = C1_ * 2;
            sp = (const LAS unsigned*)(stash + (t2_ & 63) * 4); }
        asm volatile(".p2align 8" ::: "memory");
#pragma unroll 1
        for (int t = 0; t < nt; t += 2) {
            const bool last = (t == nt - 2);
            const char* a1 = cA + (size_t)(t + 1) * kstep;
            const char* a2 = last ? nA : cA + (size_t)(t + 2) * kstep; const char* b2 = last ? nB : cB + (size_t)(t + 2) * kstep;
            const char* a3 = a2 + kstep; const char* b3 = b2 + kstep;
            unsigned o00 = coffA[0][0], o01 = coffA[0][1], o10 = coffA[1][0], o11 = coffA[1][1];
            if (GATHER && last && has_next) {
                o00 = sp[0] * (unsigned)(K * 2) + (unsigned)C0x2; o01 = sp[512] * (unsigned)(K * 2) + (unsigned)C1x2;
                o10 = sp[1024] * (unsigned)(K * 2) + (unsigned)C0x2; o11 = sp[1536] * (unsigned)(K * 2) + (unsigned)C1x2; }
            PG8_TRIP(a1, a2, b2, a3, b3, o00, o01, o10, o11);
            if (last) { coffA[0][0] = o00; coffA[0][1] = o01; coffA[1][0] = o10; coffA[1][1] = o11; }
        }
        if (wr == 0) PG8_BAR;
        { int l2 = threadIdx.x & 63; asm volatile("" : "+v"(l2)); E(acc, cur, wr, wc, l2 & 15, l2 >> 4, est); }
        if (!has_next) break;
#pragma unroll
        for (int a = 0; a < 2; ++a)
#pragma unroll
            for (int b = 0; b < 2; ++b)
#pragma unroll
                for (int m = 0; m < 4; ++m)
#pragma unroll
                    for (int n = 0; n < 2; ++n) acc[a][b][m][n] = (f32x4){0.f, 0.f, 0.f, 0.f};
        cur = nxt; cA = nA; cB = nB; ++ui;
        if (Epi::STASH) { int l2 = threadIdx.x & 63; asm volatile("" : "+v"(l2)); E.prefetch(cur, wr, wc, l2, est); }
        if (wr == 1) PG8_BAR;
    }
    PG8_WAIT_V(0);
    PG8_BAR;
#undef PG8_TRIP
#undef PG8_SA
#undef PG8_SB
#undef PG8_GLDS
#undef PG8_STAGE_A
#undef PG8_OPQ
#undef PG8_STAGE_B
#undef PG8_LDA
#undef PG8_LDB
#undef PG8_MMA
#undef PG8_CAT
#undef PG8_WAIT_V
#undef PG8_WAIT_L
#undef PG8_BAR
#undef PG8_SCHED
#undef PG8_OFFS
}

struct EpiProj {
    static constexpr bool PERM = true; static constexpr bool STASH = false;
    DI void prefetch(const Unit&, int, int, int, LAS unsigned char*) const {}
    bf16* O; int ldc; const float* qg; const float* kg; const float* rope; LAS float* P; bf16* HM;
    DI void operator()(const f32x4 (&acc)[2][2][4][2], const Unit& u, int wr, int wc, int fr, int fq, const LAS unsigned char* st) const {
        const int row0 = u.pm * BM + wr * 64 + fr, col0 = u.pn * BM + wc * 32 + 8 * fq;
        if (u.pn >= 8) {
#pragma unroll
            for (int ai = 0; ai < 2; ++ai)
#pragma unroll
                for (int m = 0; m < 4; ++m) { const int row = row0 + ai * HALF + m * 16; bf16* rowp = O + (size_t)row * ldc + col0;
                    if (u.pn < 12) rowp = HM + 2 * HM_PLANE + ((size_t)((row >> 14) * 8 + ((2 * u.pn) & 7)) * SEQ + (row & (SEQ - 1))) * 128 + wc * 32 + 8 * fq;
#pragma unroll
                    for (int bj = 0; bj < 2; ++bj) { const f32x4 v0 = acc[ai][bj][m][0], v1 = acc[ai][bj][m][1];
                        u32x4 w; w.x = cvtpk(v0[0], v0[1]); w.y = cvtpk(v0[2], v0[3]); w.z = cvtpk(v1[0], v1[1]); w.w = cvtpk(v1[2], v1[3]);
                        *(u32x4*)(rowp + (u.pn < 12 ? (size_t)bj * SEQ * 128 : (size_t)bj * HALF)) = w; } }
            return;
        }
        f32x4 rc[3][4];
#define EPR_LOAD(it_) do { const int rl_ = ((it_) >> 2) * HALF + wr * 64 + ((it_) & 3) * 16 + fr; const float* tp_ = rope + (size_t)((u.pm * BM + rl_) & (SEQ - 1)) * 32 + 8 * (fq & 1); \
            rc[(it_) % 3][0] = *(const f32x4*)tp_; rc[(it_) % 3][1] = *(const f32x4*)(tp_ + 4); rc[(it_) % 3][2] = *(const f32x4*)(tp_ + 16); rc[(it_) % 3][3] = *(const f32x4*)(tp_ + 20); } while (0)
        if (wc == 0) { EPR_LOAD(0); EPR_LOAD(1); }
#pragma unroll
        for (int ai = 0; ai < 2; ++ai)
#pragma unroll
            for (int m = 0; m < 4; ++m)
#pragma unroll
                for (int bj = 0; bj < 2; ++bj) { const f32x4 v0 = acc[ai][bj][m][0], v1 = acc[ai][bj][m][1];
                    float ss = (v0[0] * v0[0] + v0[1] * v0[1]) + (v0[2] * v0[2] + v0[3] * v0[3]) + (v1[0] * v1[0] + v1[1] * v1[1]) + (v1[2] * v1[2] + v1[3] * v1[3]);
                    ss += __shfl_xor(ss, 16); ss += __shfl_xor(ss, 32);
                    if (fq == 0) P[((ai * HALF + wr * 64 + m * 16 + fr) * 2 + bj) * 4 + wc] = ss; }
        asm volatile("s_waitcnt lgkmcnt(0)" ::: "memory"); __builtin_amdgcn_s_barrier(); asm volatile("" ::: "memory");
        const bool isk = u.pn >= 4; const float* gp = (isk ? kg : qg) + wc * 32 + 8 * fq; const float sc = isk ? 1.0f : QSCALE * 1.4426950408889634f;
        const f32x4 gA = *(const f32x4*)gp, gB = *(const f32x4*)(gp + 4);
#pragma unroll
        for (int ai = 0; ai < 2; ++ai)
#pragma unroll
            for (int m = 0; m < 4; ++m) { const int rl = ai * HALF + wr * 64 + m * 16 + fr; const int row = u.pm * BM + rl;
                bf16* rowp = HM + (isk ? HM_PLANE : (size_t)0) + ((size_t)((row >> 14) * 8 + ((2 * u.pn) & 7)) * SEQ + (row & (SEQ - 1))) * 128 + wc * 32 + 8 * fq;
                f32x4 cA = {1.f, 1.f, 1.f, 1.f}, cB = cA, sA = {0.f, 0.f, 0.f, 0.f}, sB = sA;
                if (wc == 0) { const int it = 4 * ai + m; if (it + 2 < 8) EPR_LOAD(it + 2);
                    cA = rc[it % 3][0]; cB = rc[it % 3][1]; sA = rc[it % 3][2]; sB = rc[it % 3][3]; if (fq < 2) { sA = -sA; sB = -sB; } }
#pragma unroll
                for (int bj = 0; bj < 2; ++bj) { const f32x4 pp = *(const LAS f32x4*)(P + (rl * 2 + bj) * 4);
                    const float rstd = 1.0f / sqrtf(((pp[0] + pp[1]) + (pp[2] + pp[3])) * (1.f / 128.f) + EPS);
                    f32x4 y0 = acc[ai][bj][m][0] * rstd * gA, y1 = acc[ai][bj][m][1] * rstd * gB;
                    if (wc == 0) { f32x4 o0, o1;
#pragma unroll
                        for (int j = 0; j < 4; ++j) { o0[j] = __shfl_xor(y0[j], 32); o1[j] = __shfl_xor(y1[j], 32); }
                        y0 = y0 * cA + o0 * sA; y1 = y1 * cB + o1 * sB; }
                    y0 = y0 * sc; y1 = y1 * sc;
                    u32x4 w; w.x = cvtpk(y0[0], y0[1]); w.y = cvtpk(y0[2], y0[3]); w.z = cvtpk(y1[0], y1[1]); w.w = cvtpk(y1[2], y1[3]);
                    *(u32x4*)(rowp + (size_t)bj * SEQ * 128) = w; } }
#undef EPR_LOAD
    }
};
struct EpiResid {
    static constexpr bool PERM = false; static constexpr bool STASH = false;
    const float* base; float* C; int ldc;
    DI void prefetch(const Unit&, int, int, int, LAS unsigned char*) const {}
    DI void operator()(const f32x4 (&acc)[2][2][4][2], const Unit& u, int wr, int wc, int fr, int fq, const LAS unsigned char* st) const {
        const int row0 = u.pm * BM + wr * 64 + fr, col0 = u.pn * BM + wc * 32 + 4 * fq;
        f32x4 rb[4][4];
#define EPS_LOAD(g_) do { const size_t off_ = (size_t)(row0 + ((g_) >> 2) * HALF + ((g_) & 3) * 16) * ldc + col0; \
            _Pragma("unroll") for (int bj = 0; bj < 2; ++bj) _Pragma("unroll") for (int n = 0; n < 2; ++n) rb[(g_) & 3][2 * bj + n] = *(const f32x4*)(base + off_ + bj * HALF + n * 16); } while (0)
        EPS_LOAD(0); EPS_LOAD(1); EPS_LOAD(2);
#pragma unroll
        for (int ai = 0; ai < 2; ++ai)
#pragma unroll
            for (int m = 0; m < 4; ++m) { const int g = 4 * ai + m; const size_t off = (size_t)(row0 + ai * HALF + m * 16) * ldc + col0;
                if (g + 3 < 8) EPS_LOAD(g + 3);
#pragma unroll
                for (int bj = 0; bj < 2; ++bj)
#pragma unroll
                    for (int n = 0; n < 2; ++n) *(f32x4*)(C + off + bj * HALF + n * 16) = rb[g & 3][2 * bj + n] + acc[ai][bj][m][n]; }
#undef EPS_LOAD
    }
};
DI float swiglu4(float hg, float hl) {
    const float glu = fminf(hg, 7.0f), lin = __builtin_amdgcn_fmed3f(hl, -7.0f, 7.0f);
    const float sg = __builtin_amdgcn_rcpf(1.0f + __builtin_amdgcn_exp2f(glu * (-1.702f * 1.4426950408889634f)));
    return (glu * sg) * __builtin_fmaf(lin, 4.0f, 4.0f);
}
DI f32x2 swiglu4_2(f32x2 hg, f32x2 hl) {
    f32x2 glu, lin, ex, sg;
    glu[0] = fminf(hg[0], 7.0f); glu[1] = fminf(hg[1], 7.0f); lin[0] = __builtin_amdgcn_fmed3f(hl[0], -7.0f, 7.0f); lin[1] = __builtin_amdgcn_fmed3f(hl[1], -7.0f, 7.0f);
    const f32x2 t = glu * (-1.702f * 1.4426950408889634f);
    ex[0] = __builtin_amdgcn_exp2f(t[0]); ex[1] = __builtin_amdgcn_exp2f(t[1]);
    const f32x2 den = ex + 1.0f;
    sg[0] = __builtin_amdgcn_rcpf(den[0]); sg[1] = __builtin_amdgcn_rcpf(den[1]);
    return (glu * sg) * (lin * 4.0f + 4.0f);
}
DI unsigned pk4_fp8n(float a, float b, float c, float d) { int v = __builtin_amdgcn_cvt_pk_fp8_f32(a, b, 0, false); v = __builtin_amdgcn_cvt_pk_fp8_f32(c, d, v, true); return (unsigned)v; }
DI u32x4 pair16(u32x2 a, u32x2 b) {
    const auto r0 = __builtin_amdgcn_permlane16_swap(a.x, b.x, false, false); const auto r1 = __builtin_amdgcn_permlane16_swap(a.y, b.y, false, false);
    u32x4 w; w.x = r0[0]; w.y = r1[0]; w.z = r0[1]; w.w = r1[1]; return w; }
#define PG8_DMA4(gp, lp) __builtin_amdgcn_global_load_lds((const unsigned*)(gp), (LAS unsigned*)(lp), 4, 0, 0)
struct EpiUp {
    static constexpr bool PERM = true; static constexpr bool STASH = true;
    unsigned char* ACT; const float* b_up; const float* rows;
    DI void prefetch(const Unit& u, int wr, int wc, int lane, LAS unsigned char* st) const {
        const float* rp = rows + u.pm * BM + wr * 64 + lane;
        PG8_DMA4(rp, st); PG8_DMA4(rp + HALF, st + 256);
        PG8_DMA4(b_up + (size_t)u.e * UPW + 2 * (u.pn * HALF + wc * 32) + lane, st + 512);
    }
    DI void operator()(const f32x4 (&acc)[2][2][4][2], const Unit& u, int wr, int wc, int fr, int fq, const LAS unsigned char* st) const {
        const int row0 = u.pm * BM + wr * 64 + fr, f0 = u.pn * HALF + wc * 32 + 8 * fq;
        f32x2 bg[4], bl[4];
        { const LAS float* sb = (const LAS float*)(st + 512 + fq * 64);
#pragma unroll
          for (int p = 0; p < 4; ++p) { bg[p][0] = sb[4 * p]; bg[p][1] = sb[4 * p + 2]; bl[p][0] = sb[4 * p + 1]; bl[p][1] = sb[4 * p + 3]; } }
#pragma unroll
        for (int ai = 0; ai < 2; ++ai)
#pragma unroll
            for (int mp = 0; mp < 2; ++mp) {
                u32x2 w2[2];
#pragma unroll
                for (int mm = 0; mm < 2; ++mm) { const int m = 2 * mp + mm; const float ws = *(const LAS float*)(st + ai * 256 + (m * 16 + fr) * 4) * (1.0f / 32.0f);
                    const f32x4 g0 = acc[ai][0][m][0], g1 = acc[ai][0][m][1], l0 = acc[ai][1][m][0], l1 = acc[ai][1][m][1];
                    f32x2 ws2; ws2[0] = ws; ws2[1] = ws;
                    const f32x2 a01 = swiglu4_2(__builtin_shufflevector(g0, g0, 0, 1) * ws2 + bg[0], __builtin_shufflevector(l0, l0, 0, 1) * ws2 + bl[0]);
                    const f32x2 a23 = swiglu4_2(__builtin_shufflevector(g0, g0, 2, 3) * ws2 + bg[1], __builtin_shufflevector(l0, l0, 2, 3) * ws2 + bl[1]);
                    const f32x2 a45 = swiglu4_2(__builtin_shufflevector(g1, g1, 0, 1) * ws2 + bg[2], __builtin_shufflevector(l1, l1, 0, 1) * ws2 + bl[2]);
                    const f32x2 a67 = swiglu4_2(__builtin_shufflevector(g1, g1, 2, 3) * ws2 + bg[3], __builtin_shufflevector(l1, l1, 2, 3) * ws2 + bl[3]);
                    w2[mm].x = pk4_fp8n(a01[0], a01[1], a23[0], a23[1]); w2[mm].y = pk4_fp8n(a45[0], a45[1], a67[0], a67[1]); }
                const u32x4 w = pair16(w2[0], w2[1]);
                *(u32x4*)(ACT + (size_t)(row0 + ai * HALF + (2 * mp + (fq & 1)) * 16) * FF + (f0 - 8 * (fq & 1))) = w; }
    }
};
struct EpiDown {
    static constexpr bool PERM = true; static constexpr bool STASH = true;
    unsigned char* YB; const float* b_down; const float* roww;
    DI void prefetch(const Unit& u, int wr, int wc, int lane, LAS unsigned char* st) const {
        const float* rp = roww + u.pm * BM + wr * 64 + lane;
        PG8_DMA4(rp, st); PG8_DMA4(rp + HALF, st + 256);
        PG8_DMA4(b_down + (size_t)u.e * DM + u.pn * BM + (lane >> 5) * HALF + wc * 32 + (lane & 31), st + 512);
    }
    DI void operator()(const f32x4 (&acc)[2][2][4][2], const Unit& u, int wr, int wc, int fr, int fq, const LAS unsigned char* st) const {
        const int row0 = u.pm * BM + wr * 64 + fr, col0 = u.pn * BM + wc * 32 + 8 * fq;
        f32x4 bv[2][2];
#pragma unroll
        for (int bj = 0; bj < 2; ++bj)
#pragma unroll
            for (int n = 0; n < 2; ++n) bv[bj][n] = *(const LAS f32x4*)(st + 512 + bj * 128 + fq * 32 + 16 * n);
#pragma unroll
        for (int ai = 0; ai < 2; ++ai)
#pragma unroll
            for (int mp = 0; mp < 2; ++mp) {
                const float wA = *(const LAS float*)(st + ai * 256 + ((2 * mp) * 16 + fr) * 4) * 16.0f, wB = *(const LAS float*)(st + ai * 256 + ((2 * mp + 1) * 16 + fr) * 4) * 16.0f;
                unsigned char* rowp = YB + (size_t)(row0 + ai * HALF + (2 * mp + (fq & 1)) * 16) * DM + (col0 - 8 * (fq & 1));
#pragma unroll
                for (int bj = 0; bj < 2; ++bj) { u32x2 w2[2];
#pragma unroll
                    for (int mm = 0; mm < 2; ++mm) { const int m = 2 * mp + mm; const float w8 = mm ? wB : wA;
                        const f32x4 v0 = (acc[ai][bj][m][0] * (1.0f / 128.0f) + bv[bj][0]) * w8, v1 = (acc[ai][bj][m][1] * (1.0f / 128.0f) + bv[bj][1]) * w8;
                        w2[mm].x = pk4_fp8m(v0[0], v0[1], v0[2], v0[3]); w2[mm].y = pk4_fp8m(v1[0], v1[1], v1[2], v1[3]); }
                    *(u32x4*)(rowp + bj * HALF) = pair16(w2[0], w2[1]); } }
    }
};
#undef PG8_DMA4
}

template <int MODE  >
DI void p0_tr_item(const float* W, int ld, bf16* WT, int K, int k0, int n0, LAS unsigned char* img, int lane) {
    const float* wp = W + (size_t)(k0 + (lane >> 5)) * ld + n0 + 4 * (lane & 31);
    const int ioff = img_off(lane >> 5, (lane & 31) >> 1) + (lane & 1) * 8;
#pragma unroll 1
    for (int bt = 0; bt < 4; ++bt) {
        f32x4 v[8];
#pragma unroll
        for (int i = 0; i < 8; ++i) v[i] = *(const f32x4*)(wp + (size_t)(2 * (8 * bt + i)) * ld);
#pragma unroll
        for (int i = 0; i < 8; ++i) { const int kk = 2 * (8 * bt + i) + (lane >> 5), n = 4 * (lane & 31);
            u32x2 pk; pk.x = cvtpk(v[i][0], v[i][1]); pk.y = cvtpk(v[i][2], v[i][3]);
            *(LAS u32x2*)(img + img_off(kk, n >> 3) + (n & 7) * 2) = pk; }
    }
    (void)ioff;
    LDS_WAIT();
    const int g = lane >> 4, i16 = lane & 15, q = i16 >> 2, p = i16 & 3;
#pragma unroll 4
    for (int step = 0; step < 16; ++step) { const int kc = 4 * (step & 1) + g, nb = step >> 1;
        const bf16x8 f = tr_frag(img, 8 * kc, 8 * kc + 4, 2 * nb, q, p);
        const int n = n0 + 16 * nb + i16; int row = n;
        if (MODE == 1) { const int ff = n >> 1; row = 256 * (ff >> 7) + 128 * (n & 1) + (ff & 127); }
        *(bf16x8*)(WT + (size_t)row * K + k0 + 8 * kc) = f; }
    LDS_WAIT();
}
DI float log_sigmoid(float x) { return fminf(x, 0.f) - log1pf(__expf(-fabsf(x))); }
DI void p0_prologue(Frame& F) {
    const int gw = F.vcu * NWAVES + F.wave, NGW = F.G * NWAVES;
    LAS float* lg = (LAS float*)F.lds;
    { float gvv[32];
#pragma unroll
      for (int i = 0; i < 32; ++i) { const int idx = F.tid + NTHR * i; gvv[i] = F.w_in[(size_t)(idx >> 3) * INW + NPROJ + (idx & 7)]; }
#pragma unroll
      for (int i = 0; i < 32; ++i) { const int idx = F.tid + NTHR * i; lg[(idx & 7) * DM + (idx >> 3)] = gvv[i]; } }
    __syncthreads();
    bf16* XN = (bf16*)(F.ws + WS_XN); float* GATES = (float*)(F.ws + WS_GATES);
#define P0_XLOAD(dst, row_) do { const f32x4* xr_ = (const f32x4*)(F.x + (size_t)(row_) * DM) + F.lane; _Pragma("unroll") for (int j = 0; j < 8; ++j) dst[j] = xr_[64 * j]; } while (0)
#define P0_XROW(v, row_) do { float ss = 0.f; \
        _Pragma("unroll") for (int j = 0; j < 8; ++j) ss += (v[j][0] * v[j][0] + v[j][1] * v[j][1]) + (v[j][2] * v[j][2] + v[j][3] * v[j][3]); \
        const float rstd = 1.0f / sqrtf(wave_sum(ss) * (1.f / DM) + EPS); \
        float ga[8]; _Pragma("unroll") for (int c = 0; c < 8; ++c) ga[c] = 0.f; \
        u32x2* o8 = (u32x2*)(XN + (size_t)(row_) * DM) + F.lane; \
        _Pragma("unroll") for (int j = 0; j < 8; ++j) { const f32x4 hh = v[j] * rstd * gnr[j]; \
            u32x2 pk; pk.x = cvtpk(hh[0], hh[1]); pk.y = cvtpk(hh[2], hh[3]); o8[64 * j] = pk; \
            _Pragma("unroll") for (int c = 0; c < 8; ++c) { const f32x4 w = *(const LAS f32x4*)(lg + c * DM + 4 * F.lane + 256 * j); ga[c] += (hh[0] * w[0] + hh[1] * w[1]) + (hh[2] * w[2] + hh[3] * w[3]); } \
            __builtin_amdgcn_sched_barrier(0); } \
        _Pragma("unroll") for (int c = 0; c < 8; ++c) ga[c] = wave_sum(ga[c]); \
        if (F.lane < 8) { float gv = ga[0]; \
            _Pragma("unroll") for (int c = 1; c < 8; ++c) gv = (F.lane == c) ? ga[c] : gv; \
            gv += gbias; \
            GATES[(size_t)(row_) * 8 + F.lane] = gv; } } while (0)
    { f32x4 va[8], vb[8], gnr[8];
#pragma unroll
      for (int j = 0; j < 8; ++j) gnr[j] = ((const f32x4*)F.attn_g)[F.lane + 64 * j];
      const float gbias = (F.lane < 4) ? F.i_b[F.lane & 3] : F.f_b[(F.lane - 4) & 3];
      int row = gw;
      if (row < NTOK) P0_XLOAD(va, row);
#pragma unroll 1
      for (; row < NTOK; row += 2 * NGW) {
          const int row1 = row + NGW, row2 = row + 2 * NGW;
          P0_XLOAD(vb, (row1 < NTOK ? row1 : NTOK - 1));
          __builtin_amdgcn_sched_barrier(0);
          P0_XROW(va, row);
          P0_XLOAD(va, (row2 < NTOK ? row2 : NTOK - 1));
          __builtin_amdgcn_sched_barrier(0);
          if (row1 < NTOK) P0_XROW(vb, row1);
      } }
#undef P0_XLOAD
#undef P0_XROW
    __syncthreads();
    { bf16* RH = (bf16*)(F.ws + WS_RWT); bf16* RL = RH + NE * DM;
      for (int idx = F.vcu * NTHR + F.tid; idx < NE * DM; idx += F.G * NTHR) { const int e = idx & 31, k = idx >> 5; const float w = F.router_w[idx] * F.ffn_g[k];
          const unsigned hi = cvtpk(w, 0.f) & 0xffffu; const float rem = w - __uint_as_float(hi << 16);
          const int off = (((((k >> 6) * 2 + ((k >> 5) & 1)) * 2 + (e >> 4)) * 64) + 16 * ((k >> 3) & 3) + (e & 15)) * 8 + (k & 7);
          RH[off] = (bf16)hi; RL[off] = (bf16)(cvtpk(rem, 0.f) & 0xffffu); } }
    { float* TAB = (float*)(F.ws + WS_SMALL + SM_ROPE);
      for (int idx = F.vcu * NTHR + F.tid; idx < SEQ * 16; idx += F.G * NTHR) { const int pos = idx >> 4, i = idx & 15;
          const float inv = exp2f(-(float)i * (2.0f / 32.0f) * 18.931568569324174f); const float ang = (float)pos * inv; const float nrev = rintf(ang * 0.15915494309189535f);
          const float rr = (float)__builtin_fma(-(double)nrev, 6.283185307179586476925, (double)ang);
          TAB[pos * 32 + i] = cosf(rr); TAB[pos * 32 + 16 + i] = sinf(rr); } }
    LAS unsigned char* img = F.lds + F.wave * 16384;
    constexpr int I_IN = 32 * 48, I_OUT = 32 * 16, NITEMS = I_IN + I_OUT;
    for (int it = gw; it < NITEMS; it += NGW) {
        int r = it;
        if (r < I_IN) { const int kb = r / 48, nb = r % 48; p0_tr_item<0>(F.w_in, INW, (bf16*)(F.ws + WS_WIN), DM, 64 * kb, 128 * nb, img, F.lane); continue; } r -= I_IN;
        { const int kb = r / 16, nb = r % 16; p0_tr_item<0>(F.w_out, DM, (bf16*)(F.ws + WS_WOUT), DM, 64 * kb, 128 * nb, img, F.lane); }
    }
}
template <int MODE>
DI void p0_strip_fp8(const float* W, int ld, unsigned char* WT, int K, int n0, LAS unsigned char* img, int lane) {
    const float* wp = W + (size_t)(lane >> 5) * ld + n0 + 4 * (lane & 31);
    const int g = lane >> 4, i16 = lane & 15, q = i16 >> 2, p = i16 & 3;
    int wb[8];
#pragma unroll
    for (int i = 0; i < 8; ++i) { const int kk = 2 * i + (lane >> 5), n = 4 * (lane & 31); wb[i] = img_off(kk, n >> 3) + (n & 7) * 2; }
    int rb[4], cx[4];
#pragma unroll
    for (int t = 0; t < 4; ++t) { const int M = (q << 2) | t; rb[t] = 256 * (16 * g + 4 * t + q) + 16 * ((p >> 1) ^ (M & 1)) + 8 * (p & 1); cx[t] = M >> 1; }
    int orow[8];
#pragma unroll
    for (int nb = 0; nb < 8; ++nb) { const int n = n0 + 16 * nb + i16; int row = n; if (MODE == 1) { const int ff = n >> 1; row = 256 * (ff >> 7) + 128 * (n & 1) + (ff & 127); } orow[nb] = row * K + 16 * g; }
    f32x4 va[16], vb[16];
#define P0S_LOAD(dst, krow0) do { _Pragma("unroll") for (int i = 0; i < 16; ++i) dst[i] = *(const f32x4*)(wp + (size_t)((krow0) + 2 * i) * ld); } while (0)
#define P0S_PUT(src, r0) do { _Pragma("unroll") for (int i = 0; i < 16; ++i) { \
        u32x2 pk; pk.x = cvtpk(src[i][0], src[i][1]) + 0x02800280u; pk.y = cvtpk(src[i][2], src[i][3]) + 0x02800280u;        \
        *(LAS u32x2*)(img + wb[i & 7] + ((r0) / 16 + (i >> 3)) * 4096) = pk; } } while (0)
#define P0S_F8(lo, hi) pk4_fp8m(__uint_as_float((lo) << 16), __uint_as_float((lo) & 0xffff0000u), __uint_as_float((hi) << 16), __uint_as_float((hi) & 0xffff0000u))
    P0S_LOAD(va, 0);
#pragma unroll 1
    for (int kb = 0; kb < 32; ++kb) {
        P0S_LOAD(vb, 64 * kb + 32);
        P0S_PUT(va, 0);
        if (kb < 31) P0S_LOAD(va, 64 * kb + 64);
        P0S_PUT(vb, 32);
        LDS_WAIT();
#pragma unroll 2
        for (int nb = 0; nb < 8; ++nb) {
            const s16x4 t0 = tr16(img + rb[0] + 32 * (nb ^ cx[0])), t1 = tr16(img + rb[1] + 32 * (nb ^ cx[1])), t2 = tr16(img + rb[2] + 32 * (nb ^ cx[2])), t3 = tr16(img + rb[3] + 32 * (nb ^ cx[3]));
            const u32x2 f0 = __builtin_bit_cast(u32x2, t0), f1 = __builtin_bit_cast(u32x2, t1), f2 = __builtin_bit_cast(u32x2, t2), f3 = __builtin_bit_cast(u32x2, t3);
            u32x4 o; o.x = P0S_F8(f0.x, f0.y); o.y = P0S_F8(f1.x, f1.y); o.z = P0S_F8(f2.x, f2.y); o.w = P0S_F8(f3.x, f3.y);
            *(u32x4*)(WT + (size_t)(unsigned)orow[nb] + 64 * kb) = o; }
        LDS_WAIT();
    }
#undef P0S_LOAD
#undef P0S_PUT
#undef P0S_F8
}
DI void p0_expert_weights(Frame& F, int wk, int nwk) {
    LAS unsigned char* img = F.lds + F.wave * 16384;
    constexpr int C_UP = NE * 32, C_DN = NE * 16, NCH = C_UP + C_DN;
    for (int cx = wk * NWAVES + F.wave; cx < NCH; cx += nwk * NWAVES) {
        if (cx < C_UP) { const int e = cx >> 5, nb = cx & 31; p0_strip_fp8<1>(F.w_up + (size_t)e * DM * UPW, UPW, F.ws + WS_WUP + (size_t)e * UPW * DM, DM, 128 * nb, img, F.lane); }
        else { const int r = cx - C_UP, e = r >> 4, nb = r & 15; p0_strip_fp8<0>(F.w_down + (size_t)e * FF * DM, DM, F.ws + WS_WDN + (size_t)e * DM * FF, FF, 128 * nb, img, F.lane); }
    }
}

DI void p2_conv(Frame& F, int wk, int nwk) {
    bf16* PROJ = (bf16*)(F.ws + WS_PROJ);
    bf16* QC = (bf16*)(F.ws + WS_QC); bf16* KC = (bf16*)(F.ws + WS_KC);
    const int c8 = (F.tid & 127) * 8, tok0 = (wk * NTHR + F.tid) >> 7, tstr = (nwk * NTHR) >> 7;
    float cb[8], cw[4][8];
#pragma unroll
    for (int e = 0; e < 8; ++e) cb[e] = F.conv_b[c8 + e];
#pragma unroll
    for (int j = 0; j < 4; ++j)
#pragma unroll
        for (int e = 0; e < 8; ++e) cw[j][e] = F.conv_w[j * 1024 + c8 + e];
    const float sc = (c8 < 512) ? 1.0f : QSCALE;
#pragma unroll 1
    for (int tokb = tok0; tokb < NTOK; tokb += 4 * tstr) {
        u32x4 raw[4][4];
#pragma unroll
        for (int u = 0; u < 4; ++u) { int tok = tokb + u * tstr; tok = tok < NTOK ? tok : NTOK - 1; const int t = tok & (SEQ - 1);
#pragma unroll
            for (int j = 0; j < 4; ++j) { const int back = (t - 3 + j < 0) ? t : 3 - j;
                raw[u][j] = *(const u32x4*)(PROJ + (size_t)(tok - back) * NPROJ + COL_MQ + c8); } }
#pragma unroll
        for (int u = 0; u < 4; ++u) { const int tok = tokb + u * tstr; const int tc = tok < NTOK ? tok : NTOK - 1; const int t = tc & (SEQ - 1);
            float a[8];
#pragma unroll
            for (int e = 0; e < 8; ++e) a[e] = cb[e];
#pragma unroll
            for (int j = 0; j < 4; ++j) { const float on_ = (t - 3 + j < 0) ? 0.0f : 1.0f;
#pragma unroll
                for (int e = 0; e < 4; ++e) { a[2 * e] += __uint_as_float(raw[u][j][e] << 16) * (cw[j][2 * e] * on_); a[2 * e + 1] += __uint_as_float(raw[u][j][e] & 0xffff0000u) * (cw[j][2 * e + 1] * on_); } }
#pragma unroll
            for (int e = 0; e < 8; ++e) a[e] = a[e] * __builtin_amdgcn_rcpf(1.0f + __expf(-a[e])) * sc;
            u32x4 w; w.x = cvtpk(a[0], a[1]); w.y = cvtpk(a[2], a[3]); w.z = cvtpk(a[4], a[5]); w.w = cvtpk(a[6], a[7]);
            if (tok < NTOK) { if (c8 < 512) *(u32x4*)(QC + (size_t)tok * 512 + c8) = w; else *(u32x4*)(KC + (size_t)tok * 512 + (c8 - 512)) = w; } }
    }
}

template <int DIL, bool FIRST, bool LAST>
DI void attn_phase(Frame& F) {
    constexpr int BPR = 16 / DIL, PRE = 6, NTILE = 36;
    bf16* OST = (bf16*)(F.ws + WS_OST); float* ML = (float*)(F.ws + WS_ML); bf16* MIX = (bf16*)(F.ws + WS_MIX);
    const bf16* HMq = (const bf16*)(F.ws + WS_HM);
    const int lane = F.lane, r = lane & 31, h = lane >> 5, g = lane >> 4, i16 = lane & 15, q4 = i16 >> 2, p4 = i16 & 3;
    const int prow = 4 * F.wave + g, pch = i16 ^ ((g << 2) | (F.wave & 3));
    const unsigned pdst = (unsigned)F.wave * 1024u;
    int vB0[4], vB1[4];
#pragma unroll
    for (int db = 0; db < 4; ++db) { vB0[db] = tr_base(4 * h, 4 * db + 2 * (g & 1), q4, p4); vB1[db] = tr_base(8 + 4 * h, 4 * db + 2 * (g & 1), q4, p4); }
    const int kmask = ((r & 3) << 2) | ((r >> 2) & 3);
    __syncthreads();
    const int nun = (F.vcu < 256) ? (255 - F.vcu) / F.G + 1 : 0;
    if (nun > 0) {
#define ATT_DECODE(k_, b_, hd_, res_, ib_) do { const int u_ = F.vcu + (k_) * F.G; const int bh_ = u_ >> 4, uu_ = u_ & 15; b_ = bh_ >> 3; hd_ = bh_ & 7; res_ = uu_ / BPR; ib_ = (uu_ % BPR) * 1024; } while (0)
        int iu = 0, ij = 0, is = 0, ib_i; const bf16* kv_i;
        { int b_, hd_, res_; ATT_DECODE(0, b_, hd_, res_, ib_i); kv_i = HMq + HM_PLANE + ((size_t)(b_ * 8 + hd_) * SEQ + res_) * 128; }
#define ATT_DMA16(gp, la) asm volatile("s_mov_b32 m0, %1\n\tglobal_load_lds_dwordx4 %0, off" :: "v"(gp), "s"(la) : "memory", "m0")
#define ATT_ISSUE1() do { int ki_ = ib_i - 128 + 32 * ij + prow; ki_ = ki_ < 0 ? 0 : ki_; const bf16* src_ = kv_i + (size_t)ki_ * (DIL * 128) + 8 * pch; \
            const unsigned slot_ = __builtin_amdgcn_readfirstlane((unsigned)(unsigned long long)(F.lds + (is & 7) * 16384 + pdst)); ++is; \
            ATT_DMA16(src_, slot_); ATT_DMA16(src_ + HM_PLANE, slot_ + 8192u); \
            if (++ij == NTILE) { if (iu + 1 < nun) { ++iu; ij = 0; int b_, hd_, res_; ATT_DECODE(iu, b_, hd_, res_, ib_i); kv_i = HMq + HM_PLANE + ((size_t)(b_ * 8 + hd_) * SEQ + res_) * 128; } else ij = NTILE - 1; } } while (0)
        u32x4 qfr[8], on[8]; u32x2 mlx; mlx.x = 0u; mlx.y = 0u;
#define ATT_GLD16(dst, ptr, off) asm volatile("global_load_dwordx4 %0, %1, off offset:%2" : "=v"(dst) : "v"(ptr), "i"(off) : "memory")
#define ATT_PREFETCH(k_, qt_) do { int b_, hd_, res_, ib_; ATT_DECODE(k_, b_, hd_, res_, ib_); const size_t hr_ = (size_t)(b_ * 8 + hd_) * SEQ + (size_t)(ib_ + 32 * (qt_) + r) * DIL + res_; \
            const bf16* qp_ = HMq + hr_ * 128 + 8 * h; _Pragma("unroll") for (int kk = 0; kk < 8; ++kk) ATT_GLD16(qfr[kk], qp_, 32 * kk); \
            if (!FIRST) { const bf16* op_ = OST + hr_ * 128 + 8 * h; _Pragma("unroll") for (int db = 0; db < 4; ++db) _Pragma("unroll") for (int j2 = 0; j2 < 2; ++j2) ATT_GLD16(on[2 * db + j2], op_, 64 * db + 32 * j2); \
                const float* mlq_ = ML + hr_ * 2; asm volatile("global_load_dwordx2 %0, %1, off" : "=v"(mlx) : "v"(mlq_) : "memory"); } } while (0)
        ATT_PREFETCH(0, F.wave);
#pragma unroll
        for (int jt = 0; jt < PRE; ++jt) ATT_ISSUE1();
        int cs = 0;
        f32x16 o[4]; float m = -1e30f, l = 0.f;
#pragma unroll 1
        for (int k = 0; k < nun; ++k) {
            int b, hd, res, ibase; ATT_DECODE(k, b, hd, res, ibase);
#pragma unroll 1
            for (int j = 0; j < NTILE; ++j) {
                ATT_ISSUE1();
                const int dj = j - F.wave, mq = dj >> 3, kt = dj & 7, qt = F.wave + 8 * mq;
                const bool act = dj >= 0 && mq <= 3 && kt <= 4;
                const int i0 = ibase + 32 * qt;
                if (act && kt == 0) asm volatile("s_waitcnt vmcnt(8)" ::: "memory"); else asm volatile("s_waitcnt vmcnt(12)" ::: "memory");
                __builtin_amdgcn_s_barrier(); asm volatile("" ::: "memory");
                if (act) {
                    if (kt == 0) {
                        if (FIRST) {
#pragma unroll
                            for (int db = 0; db < 4; ++db)
#pragma unroll
                                for (int e = 0; e < 16; ++e) o[db][e] = 0.f;
                            m = -1e30f; l = 0.f;
                        } else {
#pragma unroll
                            for (int db = 0; db < 4; ++db)
#pragma unroll
                                for (int j2 = 0; j2 < 2; ++j2) { const u32x4 vv = on[2 * db + j2]; u32x2 va2[2]; va2[0].x = vv.x; va2[0].y = vv.y; va2[1].x = vv.z; va2[1].y = vv.w; swap32(va2[0], va2[1]);
#pragma unroll
                                    for (int q2 = 0; q2 < 2; ++q2) { const int g4 = 2 * j2 + q2; const u32x2 v = va2[q2];
                                        o[db][4 * g4] = __uint_as_float(v.x << 16); o[db][4 * g4 + 1] = __uint_as_float(v.x & 0xffff0000u); o[db][4 * g4 + 2] = __uint_as_float(v.y << 16); o[db][4 * g4 + 3] = __uint_as_float(v.y & 0xffff0000u); } }
                            m = __uint_as_float(mlx.x); l = __uint_as_float(mlx.y);
                        }
                    }
                    const LAS unsigned char* kimg = F.lds + (cs & 7) * 16384; const LAS unsigned char* vi = kimg + 8192;
                    f32x16 s;
#pragma unroll
                    for (int e = 0; e < 16; ++e) s[e] = 0.f;
                    const LAS unsigned char* krow = kimg + 256 * r;
                    bf16x8 ka[8];
#pragma unroll
                    for (int kk = 0; kk < 8; ++kk) ka[kk] = *(const LAS bf16x8*)(krow + 16 * ((2 * kk + h) ^ kmask));
                    __builtin_amdgcn_sched_barrier(0);
#pragma unroll
                    for (int kk = 0; kk < 8; ++kk) s = mfma32(ka[kk], __builtin_bit_cast(bf16x8, qfr[kk]), s);
                    bf16x8 va[2][4];
#pragma unroll
                    for (int s2 = 0; s2 < 2; ++s2)
#pragma unroll
                        for (int db = 0; db < 4; ++db) va[s2][db] = tr_frag2(vi, vB0[db], vB1[db], s2 * 4096);
                    __builtin_amdgcn_sched_barrier(0);
                    { const int kb = i0 - 128 + 32 * kt;
                      if (kt == 0 || kt == 4 || kb < 0) {
#pragma unroll
                        for (int e = 0; e < 16; ++e) { const int ce = crow(e, h); const bool bad = ((kb + ce) < 0) || (kt == 0 && ce < r) || (kt == 4 && ce > r); if (bad) s[e] = -1e30f; } } }
                    float mx = fmaxf(fmaxf(s[0], s[1]), s[2]);
#pragma unroll
                    for (int e = 3; e < 15; e += 2) mx = fmaxf(fmaxf(mx, s[e]), s[e + 1]);
                    mx = fmaxf(mx, s[15]);
                    mx = fmaxf(mx, __shfl_xor(mx, 32));
                    if (__any(mx > m + 8.0f)) { const float mn = fmaxf(m, mx), alpha = __builtin_amdgcn_exp2f(m - mn); l *= alpha; m = mn;
#pragma unroll
                        for (int db = 0; db < 4; ++db)
#pragma unroll
                            for (int e = 0; e < 16; ++e) o[db][e] *= alpha; }
                    float rs = 0.f;
#pragma unroll
                    for (int e = 0; e < 16; ++e) { s[e] = __builtin_amdgcn_exp2f(s[e] - m); rs += s[e]; }
                    rs += __shfl_xor(rs, 32); l += rs;
                    bf16x8 pb[2];
#pragma unroll
                    for (int s2 = 0; s2 < 2; ++s2) { u32x4 w; w.x = cvtpk(s[8 * s2], s[8 * s2 + 1]); w.y = cvtpk(s[8 * s2 + 2], s[8 * s2 + 3]); w.z = cvtpk(s[8 * s2 + 4], s[8 * s2 + 5]); w.w = cvtpk(s[8 * s2 + 6], s[8 * s2 + 7]);
                        pb[s2] = __builtin_bit_cast(bf16x8, w); }
#pragma unroll
                    for (int s2 = 0; s2 < 2; ++s2) {
#pragma unroll
                        for (int db = 0; db < 4; ++db) o[db] = mfma32(va[s2][db], pb[s2], o[db]);
                    }
                    if (kt == 4) {
                        const size_t hrow = (size_t)(b * 8 + hd) * SEQ + (size_t)(i0 + r) * DIL + res;
                        if (LAST) {
                            const size_t rowq = (size_t)b * SEQ + (size_t)(i0 + r) * DIL + res;
                            const float il = 1.0f / l;
                            bf16* mp = MIX + rowq * DM + hd * 128 + 8 * h;
#pragma unroll
                            for (int db = 0; db < 4; ++db)
#pragma unroll
                                for (int j2 = 0; j2 < 2; ++j2) { u32x2 w2[2];
#pragma unroll
                                    for (int q2 = 0; q2 < 2; ++q2) { const int g4 = 2 * j2 + q2; w2[q2].x = cvtpk(o[db][4 * g4] * il, o[db][4 * g4 + 1] * il); w2[q2].y = cvtpk(o[db][4 * g4 + 2] * il, o[db][4 * g4 + 3] * il); }
                                    swap32(w2[0], w2[1]); u32x4 w; w.x = w2[0].x; w.y = w2[0].y; w.z = w2[1].x; w.w = w2[1].y;
                                    *(u32x4*)(mp + 32 * db + 16 * j2) = w; }
                        } else {
                            bf16* ostp = OST + hrow * 128 + 8 * h; float* mlp = ML + hrow * 2;
#pragma unroll
                            for (int db = 0; db < 4; ++db)
#pragma unroll
                                for (int j2 = 0; j2 < 2; ++j2) { u32x2 w2[2];
#pragma unroll
                                    for (int q2 = 0; q2 < 2; ++q2) { const int g4 = 2 * j2 + q2; w2[q2].x = cvtpk(o[db][4 * g4], o[db][4 * g4 + 1]); w2[q2].y = cvtpk(o[db][4 * g4 + 2], o[db][4 * g4 + 3]); }
                                    swap32(w2[0], w2[1]); u32x4 w; w.x = w2[0].x; w.y = w2[0].y; w.z = w2[1].x; w.w = w2[1].y;
                                    *(u32x4*)(ostp + 32 * db + 16 * j2) = w; }
                            if (h == 0) { f32x2 mlv; mlv[0] = m; mlv[1] = l; *(f32x2*)mlp = mlv; }
                        }
                        if (mq < 3) ATT_PREFETCH(k, qt + 8); else if (k + 1 < nun) ATT_PREFETCH(k + 1, F.wave);
                    }
                }
                ++cs;
                __builtin_amdgcn_sched_barrier(0);
            }
        }
#undef ATT_ISSUE1
#undef ATT_DMA16
#undef ATT_PREFETCH
#undef ATT_GLD16
#undef ATT_DECODE
        asm volatile("s_waitcnt vmcnt(0)" ::: "memory");
    }
    __syncthreads();
}

DI float scan_incl_sum(float v, int lane) {
#pragma unroll
    for (int o = 1; o < 64; o <<= 1) { const float t = __shfl_up(v, o); if (lane >= o) v += t; }
    return v;
}
DI float scan_incl_max(float v, int lane) {
#pragma unroll
    for (int o = 1; o < 64; o <<= 1) { const float t = __shfl_up(v, o); if (lane >= o) v = fmaxf(v, t); }
    return v;
}
template <bool SCALE>
DI void load_img128(LAS unsigned char* img, const bf16* src, size_t ldg, const LAS float* rs, int tid) {
#pragma unroll
    for (int it = 0; it < 4; ++it) { const int idx = tid + NTHR * it, row = idx >> 4, ch = idx & 15;
        u32x4 v = *(const u32x4*)(src + (size_t)row * ldg + 8 * ch);
        if (SCALE) { const float w = rs[row];
#pragma unroll
            for (int e = 0; e < 4; ++e) { const float lo = __uint_as_float(v[e] << 16) * w, hi = __uint_as_float(v[e] & 0xffff0000u) * w; v[e] = cvtpk(lo, hi); } }
        *(LAS u32x4*)(img + img_off(row, ch)) = v; }
}
DI void dma_img128(LAS unsigned char* img, const bf16* src, size_t ldg, int wave, int lane) {
    const int g = lane >> 4, i16 = lane & 15;
#pragma unroll
    for (int i = 0; i < 4; ++i) { const int row = (wave * 4 + i) * 4 + g; const int ch = i16 ^ ((g << 2) | i);
        __builtin_amdgcn_global_load_lds((const unsigned*)(src + (size_t)row * ldg + 8 * ch), (LAS unsigned*)(img + (wave * 4 + i) * 1024), 16, 0, 0); }
}
DI void mlstm_m1_unit(Frame& F, int u) {
    const int bh = u >> 7, c = u & 127, b = bh >> 2, hd = bh & 3;
    const int tok0 = b * SEQ + c * 128;
    const float* GATES = (const float*)(F.ws + WS_GATES);
    LAS float* mf = (LAS float*)(F.lds + MISC_OFF);
    LAS unsigned char* imgK = F.lds, *imgV0 = F.lds + 32768, *imgV1 = F.lds + 65536;
    const int lane = F.lane;
    const bf16* KC = (const bf16*)(F.ws + WS_KC); const bf16* PROJ = (const bf16*)(F.ws + WS_PROJ);
    dma_img128(imgV0, PROJ + (size_t)tok0 * NPROJ + COL_MV + hd * 256, NPROJ, F.wave, lane);
    dma_img128(imgV1, PROJ + (size_t)tok0 * NPROJ + COL_MV + hd * 256 + 128, NPROJ, F.wave, lane);
    asm volatile("" ::: "memory");
    u32x4 kreg[4];
#pragma unroll
    for (int it = 0; it < 4; ++it) { const int idx = F.tid + NTHR * it, row = idx >> 4, ch = idx & 15; kreg[it] = *(const u32x4*)(KC + (size_t)(tok0 + row) * 512 + hd * 128 + 8 * ch); }
    if (F.wave == 0) {
        const int s0 = 2 * lane;
        const float ig0 = GATES[(size_t)(tok0 + s0) * 8 + hd], fg0 = GATES[(size_t)(tok0 + s0) * 8 + 4 + hd];
        const float ig1 = GATES[(size_t)(tok0 + s0 + 1) * 8 + hd], fg1 = GATES[(size_t)(tok0 + s0 + 1) * 8 + 4 + hd];
        const float lf0 = log_sigmoid(fg0), lf1 = log_sigmoid(fg1);
        const float b1 = scan_incl_sum(lf0 + lf1, lane), b0 = b1 - lf1;
        const float gt = __shfl(b1, 63);
        const float a0 = gt - b0 + ig0, a1 = gt - b1 + ig1;
        const float ml = wave_max(fmaxf(a0, a1));
        mf[s0] = __expf(a0 - ml); mf[s0 + 1] = __expf(a1 - ml);
        if (lane == 0) { ((float*)(F.ws + WS_SMALL + SM_G))[u] = gt; ((float*)(F.ws + WS_SMALL + SM_MLOC))[u] = ml; }
    }
    asm volatile("s_waitcnt vmcnt(4)" ::: "memory");
    __syncthreads();
#pragma unroll
    for (int it = 0; it < 4; ++it) { const int idx = F.tid + NTHR * it, row = idx >> 4, ch = idx & 15; const float w = mf[row]; u32x4 v = kreg[it];
#pragma unroll
        for (int e = 0; e < 4; ++e) { const float lo = __uint_as_float(v[e] << 16) * w, hi = __uint_as_float(v[e] & 0xffff0000u) * w; v[e] = cvtpk(lo, hi); }
        *(LAS u32x4*)(imgK + img_off(row, ch)) = v; }
    __syncthreads();
    if (F.tid < 128) { const int dk = F.tid; float a = 0.f;
        for (int s = 0; s < 128; ++s) a += bf2f(*(const LAS unsigned short*)(imgK + img_off(s, dk >> 3) + (dk & 7) * 2));
        ((float*)(F.ws + WS_SMALL + SM_NLOC))[(size_t)u * 128 + dk] = a; }
    const int mb = F.wave >> 1, nh = F.wave & 1, r = lane & 31, h = lane >> 5, g = lane >> 4, i16 = lane & 15, q4 = i16 >> 2, p4 = i16 & 3;
    LAS unsigned char* imgV = nh ? imgV1 : imgV0;
    f32x16 acc[4];
#pragma unroll
    for (int nb = 0; nb < 4; ++nb)
#pragma unroll
        for (int e = 0; e < 16; ++e) acc[nb][e] = 0.f;
    const int aA0 = tr_base(8 * h, 4 * mb + 2 * (g & 1), q4, p4), aA1 = tr_base(8 * h + 4, 4 * mb + 2 * (g & 1), q4, p4);
    int bB0[4], bB1[4];
#pragma unroll
    for (int nb = 0; nb < 4; ++nb) { bB0[nb] = tr_base(8 * h, 4 * nb + 2 * (g & 1), q4, p4); bB1[nb] = tr_base(8 * h + 4, 4 * nb + 2 * (g & 1), q4, p4); }
#pragma unroll
    for (int ks = 0; ks < 8; ++ks) {
        const bf16x8 a = tr_frag2(imgK, aA0, aA1, ks * 4096);
#pragma unroll
        for (int nb = 0; nb < 4; ++nb) { const bf16x8 bfr = tr_frag2(imgV, bB0[nb], bB1[nb], ks * 4096);
            acc[nb] = mfma32(a, bfr, acc[nb]); }
        __builtin_amdgcn_sched_barrier(0);
    }
    bf16* CL = (bf16*)(F.ws + WS_CLOC) + (size_t)u * 128 * 256;
    __syncthreads();
    { LAS unsigned char* stg = F.lds + (size_t)(32 * mb) * 528 + (128 * nh + r) * 2;
#pragma unroll
      for (int nb = 0; nb < 4; ++nb)
#pragma unroll
          for (int e = 0; e < 16; ++e) *(LAS unsigned short*)(stg + crow(e, h) * 528 + 64 * nb) = (unsigned short)(cvtpk(acc[nb][e], 0.f) & 0xffffu); }
    __syncthreads();
#pragma unroll
    for (int i = 0; i < 8; ++i) { const int p = F.tid + NTHR * i, row = p >> 5, ch = p & 31; *(u32x4*)(CL + (size_t)row * 256 + 8 * ch) = *(const LAS u32x4*)(F.lds + row * 528 + 16 * ch); }
    __syncthreads();
}
DI void mlstm_scan(Frame& F) {
    const float* Gv = (const float*)(F.ws + WS_SMALL + SM_G); const float* MLv = (const float*)(F.ws + WS_SMALL + SM_MLOC);
    float* MP = (float*)(F.ws + WS_SMALL + SM_MPREV); const float* NL = (const float*)(F.ws + WS_SMALL + SM_NLOC); float* NP = (float*)(F.ws + WS_SMALL + SM_NPREV);
    const bf16* CL = (const bf16*)(F.ws + WS_CLOC); bf16* CP = (bf16*)(F.ws + WS_CPREV);
    const int lane = F.lane;
    for (int t = F.vcu + F.G * F.wave; t < 512; t += F.G * NWAVES) {
        const int bh = t >> 6, dk = (t & 63) * 2 + (lane >> 5), dv = (lane & 31) * 8;
        const float g0 = Gv[bh * 128 + lane], g1 = Gv[bh * 128 + 64 + lane], l0 = MLv[bh * 128 + lane], l1 = MLv[bh * 128 + 64 + lane];
        const size_t e0 = (size_t)bh * 128 * 32768 + (size_t)dk * 256 + dv;
        float st[8];
#pragma unroll
        for (int e = 0; e < 8; ++e) st[e] = 0.f;
        float m = 0.f, ns = 0.f;
        u32x4 cla[16], clb[16]; float nla[16], nlb[16];
#define SC_LOAD(cl_, nl_, cb_) do { _Pragma("unroll") for (int i = 0; i < 16; ++i) cl_[i] = *(const u32x4*)(CL + e0 + (size_t)((cb_) + i) * 32768); \
            _Pragma("unroll") for (int i = 0; i < 16; ++i) nl_[i] = NL[(size_t)(bh * 128 + (cb_) + i) * 128 + dk]; } while (0)
#define SC_BATCH(cl_, nl_, cb_) do { _Pragma("unroll") for (int i = 0; i < 16; ++i) { const int c = (cb_) + i; \
                const float gc = __uint_as_float(__builtin_amdgcn_readlane(__float_as_uint((cb_) < 64 ? g0 : g1), c & 63)), ml = __uint_as_float(__builtin_amdgcn_readlane(__float_as_uint((cb_) < 64 ? l0 : l1), c & 63)); \
                const float mn = fmaxf(gc + m, ml), dold = __expf(gc + m - mn), dnew = __expf(ml - mn); \
                u32x4 w; w.x = cvtpk(st[0], st[1]); w.y = cvtpk(st[2], st[3]); w.z = cvtpk(st[4], st[5]); w.w = cvtpk(st[6], st[7]); \
                *(u32x4*)(CP + e0 + (size_t)c * 32768) = w;                                          \
                _Pragma("unroll") for (int e = 0; e < 4; ++e) { st[2 * e] = dold * st[2 * e] + dnew * __uint_as_float(cl_[i][e] << 16); st[2 * e + 1] = dold * st[2 * e + 1] + dnew * __uint_as_float(cl_[i][e] & 0xffff0000u); } \
                if ((lane & 31) == 0) { const float nl = nl_[i]; NP[(size_t)(bh * 128 + c) * 128 + dk] = ns; ns = dold * ns + dnew * nl; } \
                if ((t & 63) == 0 && lane == 0) MP[bh * 128 + c] = m; \
                m = mn; } } while (0)
        SC_LOAD(cla, nla, 0);
#pragma unroll 1
        for (int cb = 0; cb < NCH; cb += 32) {
            SC_LOAD(clb, nlb, cb + 16);
            __builtin_amdgcn_sched_barrier(0);
            SC_BATCH(cla, nla, cb);
            { const int cn = cb + 32 < NCH ? cb + 32 : cb; SC_LOAD(cla, nla, cn); }
            __builtin_amdgcn_sched_barrier(0);
            SC_BATCH(clb, nlb, cb + 16);
        }
#undef SC_LOAD
#undef SC_BATCH
    }
}
DI void mlstm_m3_unit(Frame& F, int u) {
    const int bh = u >> 7, c = u & 127, b = bh >> 2, hd = bh & 3;
    const int tok0 = b * SEQ + c * 128;
    const float* GATES = (const float*)(F.ws + WS_GATES);
    LAS float* mf = (LAS float*)(F.lds + MISC_OFF);
    LAS unsigned char* imgV0 = F.lds, *imgV1 = F.lds + 32768, *imgC0 = F.lds + 65536, *imgC1 = F.lds + 98304, *imgK = F.lds + 65536;
    int lane_ = F.lane; asm volatile("" : "+v"(lane_));
    const int lane = lane_, tid_ = F.wave * 64 + lane, r = lane & 31, h = lane >> 5, g = lane >> 4, i16 = lane & 15, q4 = i16 >> 2, p4 = i16 & 3;
    const bf16* QC = (const bf16*)(F.ws + WS_QC); const bf16* KC = (const bf16*)(F.ws + WS_KC); const bf16* PROJ = (const bf16*)(F.ws + WS_PROJ);
    const bf16* CP = (const bf16*)(F.ws + WS_CPREV) + (size_t)u * 32768;
    dma_img128(imgV0, PROJ + (size_t)tok0 * NPROJ + COL_MV + hd * 256, NPROJ, F.wave, lane);
    dma_img128(imgV1, PROJ + (size_t)tok0 * NPROJ + COL_MV + hd * 256 + 128, NPROJ, F.wave, lane);
    dma_img128(imgC0, CP, 256, F.wave, lane);
    dma_img128(imgC1, CP + 128, 256, F.wave, lane);
    asm volatile("" ::: "memory");
    const int tb = F.wave & 3, dh = F.wave >> 2;
    const int tl = 32 * tb + r;
    bf16x8 qf[8];
    { const bf16* qp = QC + (size_t)(tok0 + tl) * 512 + hd * 128 + 8 * h;
#pragma unroll
      for (int kk = 0; kk < 8; ++kk) qf[kk] = *(const bf16x8*)(qp + 16 * kk); }
    u32x4 kreg[4];
#pragma unroll
    for (int it = 0; it < 4; ++it) { const int idx = tid_ + NTHR * it, row = idx >> 4, ch = idx & 15; kreg[it] = *(const u32x4*)(KC + (size_t)(tok0 + row) * 512 + hd * 128 + 8 * ch); }
    asm volatile("" ::: "memory");
    const float m_prev = ((const float*)(F.ws + WS_SMALL + SM_MPREV))[u];
    if (F.wave == 0) {
        const int s0 = 2 * lane;
        const float ig0 = GATES[(size_t)(tok0 + s0) * 8 + hd], fg0 = GATES[(size_t)(tok0 + s0) * 8 + 4 + hd];
        const float ig1 = GATES[(size_t)(tok0 + s0 + 1) * 8 + hd], fg1 = GATES[(size_t)(tok0 + s0 + 1) * 8 + 4 + hd];
        const float lf0 = log_sigmoid(fg0), lf1 = log_sigmoid(fg1);
        const float b1 = scan_incl_sum(lf0 + lf1, lane), b0 = b1 - lf1;
        const float u0 = ig0 - b0, u1 = ig1 - b1;
        const float im = scan_incl_max(fmaxf(u0, u1), lane);
        float ex = __shfl_up(im, 1); if (lane == 0) ex = -1e30f;
        const float cm0 = fmaxf(ex, u0), cm1 = im;
        const float M0 = fmaxf(m_prev, cm0), M1 = fmaxf(m_prev, cm1);
        mf[s0] = u0; mf[s0 + 1] = u1; mf[128 + s0] = M0; mf[128 + s0 + 1] = M1;
        mf[256 + s0] = __expf(m_prev - M0); mf[256 + s0 + 1] = __expf(m_prev - M1);
        mf[384 + s0] = __expf(-(b0 + M0)); mf[384 + s0 + 1] = __expf(-(b1 + M1));
    }
    if (F.wave == 1) { const float* NP = (const float*)(F.ws + WS_SMALL + SM_NPREV) + (size_t)u * 128; mf[512 + lane] = NP[lane]; mf[512 + 64 + lane] = NP[64 + lane]; }
    asm volatile("s_waitcnt vmcnt(4)" ::: "memory");
    __syncthreads();
    LAS unsigned char* imgC = dh ? imgC1 : imgC0; LAS unsigned char* imgV = dh ? imgV1 : imgV0;
    f32x16 acc[4];
#pragma unroll
    for (int nb = 0; nb < 4; ++nb)
#pragma unroll
        for (int e = 0; e < 16; ++e) acc[nb][e] = 0.f;
    int cB0[4], cB1[4];
#pragma unroll
    for (int nb = 0; nb < 4; ++nb) { cB0[nb] = tr_base(8 * h, 4 * nb + 2 * (g & 1), q4, p4); cB1[nb] = tr_base(8 * h + 4, 4 * nb + 2 * (g & 1), q4, p4); }
#pragma unroll
    for (int kk = 0; kk < 8; ++kk) {
#pragma unroll
        for (int nb = 0; nb < 4; ++nb) { const bf16x8 a = tr_frag2(imgC, cB0[nb], cB1[nb], kk * 4096);
            acc[nb] = mfma32(a, qf[kk], acc[nb]); }
        __builtin_amdgcn_sched_barrier(0);
    }
    const float wi = mf[256 + tl], Mt = mf[128 + tl], en = mf[384 + tl];
#pragma unroll
    for (int nb = 0; nb < 4; ++nb)
#pragma unroll
        for (int e = 0; e < 16; ++e) acc[nb][e] *= wi;
    float qn = 0.f;
#pragma unroll
    for (int kk = 0; kk < 8; ++kk) { const f32x4 n0 = *(const LAS f32x4*)(mf + 512 + 16 * kk + 8 * h), n1 = *(const LAS f32x4*)(mf + 512 + 16 * kk + 8 * h + 4);
        const u32x4 qq = __builtin_bit_cast(u32x4, qf[kk]);
        qn += __uint_as_float(qq[0] << 16) * n0[0] + __uint_as_float(qq[0] & 0xffff0000u) * n0[1] + __uint_as_float(qq[1] << 16) * n0[2] + __uint_as_float(qq[1] & 0xffff0000u) * n0[3];
        qn += __uint_as_float(qq[2] << 16) * n1[0] + __uint_as_float(qq[2] & 0xffff0000u) * n1[1] + __uint_as_float(qq[3] << 16) * n1[2] + __uint_as_float(qq[3] & 0xffff0000u) * n1[3]; }
    qn += __shfl_xor(qn, 32);
    __syncthreads();
#pragma unroll
    for (int it = 0; it < 4; ++it) { const int idx = tid_ + NTHR * it, row = idx >> 4, ch = idx & 15; *(LAS u32x4*)(imgK + img_off(row, ch)) = kreg[it]; }
    __syncthreads();
    u32x4 moreg[8];
    { const bf16* mop = PROJ + (size_t)(tok0 + tl) * NPROJ + COL_MO + hd * 256 + 128 * dh + 8 * h;
#pragma unroll
      for (int nb = 0; nb < 4; ++nb)
#pragma unroll
          for (int j2 = 0; j2 < 2; ++j2) moreg[2 * nb + j2] = *(const u32x4*)(mop + 32 * nb + 16 * j2); }
    float den = 0.f;
    int vB0[4], vB1[4];
#pragma unroll
    for (int nb = 0; nb < 4; ++nb) { vB0[nb] = tr_base(4 * h, 4 * nb + 2 * (g & 1), q4, p4); vB1[nb] = tr_base(8 + 4 * h, 4 * nb + 2 * (g & 1), q4, p4); }
    const int kmask = ((r & 3) << 2) | ((r >> 2) & 3);
#pragma unroll 1
    for (int sb = 0; sb <= tb; ++sb) {
        f32x16 s;
#pragma unroll
        for (int e = 0; e < 16; ++e) s[e] = 0.f;
        const LAS unsigned char* krow = imgK + 256 * (32 * sb + r);
#pragma unroll
        for (int kk = 0; kk < 8; ++kk) { const bf16x8 a = *(const LAS bf16x8*)(krow + 16 * ((2 * kk + h) ^ kmask)); s = mfma32(a, qf[kk], s); }
        __builtin_amdgcn_sched_barrier(0);
#pragma unroll
        for (int g4 = 0; g4 < 4; ++g4) { const f32x4 uu = *(const LAS f32x4*)(mf + 32 * sb + 8 * g4 + 4 * h);
#pragma unroll
            for (int j = 0; j < 4; ++j) { const int e = 4 * g4 + j; const int sl = 32 * sb + 8 * g4 + 4 * h + j;
                const float w = (sl <= tl) ? __expf(uu[j] - Mt) : 0.f; s[e] *= w; den += s[e]; } }
        bf16x8 pb[2];
#pragma unroll
        for (int s2 = 0; s2 < 2; ++s2) { u32x4 w; w.x = cvtpk(s[8 * s2], s[8 * s2 + 1]); w.y = cvtpk(s[8 * s2 + 2], s[8 * s2 + 3]); w.z = cvtpk(s[8 * s2 + 4], s[8 * s2 + 5]); w.w = cvtpk(s[8 * s2 + 6], s[8 * s2 + 7]);
            pb[s2] = __builtin_bit_cast(bf16x8, w); }
        const LAS unsigned char* vsb = imgV + 8192 * sb;
#pragma unroll
        for (int s2 = 0; s2 < 2; ++s2) {
#pragma unroll
            for (int nb = 0; nb < 4; ++nb) { const bf16x8 va = tr_frag2(vsb, vB0[nb], vB1[nb], s2 * 4096);
                acc[nb] = mfma32(va, pb[s2], acc[nb]); }
        }
        __builtin_amdgcn_sched_barrier(0);
    }
    f32x4 ggr[16];
    { const float* gq = F.mlout_g + hd * 256 + 128 * dh + 4 * h;
#pragma unroll
      for (int nb = 0; nb < 4; ++nb)
#pragma unroll
          for (int g4 = 0; g4 < 4; ++g4) ggr[4 * nb + g4] = *(const f32x4*)(gq + 32 * nb + 8 * g4); }
    den += __shfl_xor(den, 32);
    const float dt = wi * qn + den;
    const float inv = 1.0f / fmaxf(fabsf(dt), en);
    float ss = 0.f;
#pragma unroll
    for (int nb = 0; nb < 4; ++nb)
#pragma unroll
        for (int e = 0; e < 16; ++e) { acc[nb][e] *= inv; ss += acc[nb][e] * acc[nb][e]; }
    ss += __shfl_xor(ss, 32);
    if (h == 0) mf[640 + dh * 128 + tl] = ss;
    __syncthreads();
    const float rstd = 1.0f / sqrtf((mf[640 + tl] + mf[640 + 128 + tl]) * (1.f / 256.f) + EPS);
    const size_t tokr = (size_t)(tok0 + tl);
    const float* gp = F.mlout_g + hd * 256 + 128 * dh + 4 * h;
    bf16* outp = (bf16*)(F.ws + WS_MIX) + tokr * DM + 1024 + hd * 256 + 128 * dh + 8 * h;
#pragma unroll
    for (int nb = 0; nb < 4; ++nb)
#pragma unroll
        for (int j2 = 0; j2 < 2; ++j2) { const u32x4 mv = moreg[2 * nb + j2]; u32x2 mo2[2], w2[2]; mo2[0].x = mv.x; mo2[0].y = mv.y; mo2[1].x = mv.z; mo2[1].y = mv.w; swap32(mo2[0], mo2[1]);
#pragma unroll
            for (int q2 = 0; q2 < 2; ++q2) { const int g4 = 2 * j2 + q2; const u32x2 mo = mo2[q2]; const f32x4 gg = ggr[4 * nb + g4];
                const float z0 = __uint_as_float(mo.x << 16), z1 = __uint_as_float(mo.x & 0xffff0000u), z2 = __uint_as_float(mo.y << 16), z3 = __uint_as_float(mo.y & 0xffff0000u);
                const float y0 = acc[nb][4 * g4] * rstd * gg[0] * __builtin_amdgcn_rcpf(1.0f + __expf(-z0)), y1 = acc[nb][4 * g4 + 1] * rstd * gg[1] * __builtin_amdgcn_rcpf(1.0f + __expf(-z1));
                const float y2 = acc[nb][4 * g4 + 2] * rstd * gg[2] * __builtin_amdgcn_rcpf(1.0f + __expf(-z2)), y3 = acc[nb][4 * g4 + 3] * rstd * gg[3] * __builtin_amdgcn_rcpf(1.0f + __expf(-z3));
                w2[q2].x = cvtpk(y0, y1); w2[q2].y = cvtpk(y2, y3); }
            swap32(w2[0], w2[1]); u32x4 w; w.x = w2[0].x; w.y = w2[0].y; w.z = w2[1].x; w.w = w2[1].y;
            *(u32x4*)(outp + 32 * nb + 16 * j2) = w; }
    __syncthreads();
}

DI void p7_router(Frame& F) {
    const float* X1 = F.out; unsigned char* H2 = F.ws + WS_XN;
    const bf16* RH = (const bf16*)(F.ws + WS_RWT); const bf16* RL = RH + NE * DM;
    int* TOPI = (int*)(F.ws + WS_SMALL + SM_TOPI); float* TOPW = (float*)(F.ws + WS_SMALL + SM_TOPW); int* HIST = (int*)(F.ws + WS_CTL + CTL_HIST); float* RSTD = (float*)(F.ws + WS_SMALL + SM_RSTD);
    const int lane = F.lane, g4 = lane >> 4, c = lane & 15;
    LAS unsigned char* himg = F.lds + F.wave * 6144; LAS unsigned char* limg = himg + 2304;
    LAS float* lr = (LAS float*)(himg + 4608);
    LAS unsigned char* fimg = himg + 5120;
    LAS float* gl = (LAS float*)(F.lds + 49152);
    LAS unsigned char* wbuf = F.lds + 57344;
    __syncthreads();
    *(LAS f32x4*)(gl + 4 * F.tid) = *(const f32x4*)(F.ffn_g + 4 * F.tid);
    const char* rhb = (const char*)RH + F.tid * 16; const char* rlb = (const char*)RL + F.tid * 16;
#define P7_G16(gp, la) asm volatile("s_mov_b32 m0, %1\n\tglobal_load_lds_dwordx4 %0, off" :: "v"(gp), "s"(la) : "memory", "m0")
#define P7_DMA(s_) do { const unsigned d_ = __builtin_amdgcn_readfirstlane((unsigned)(unsigned long long)(wbuf + ((s_) & 1) * 32768 + F.wave * 1024)); const size_t so_ = (size_t)(s_) * 16384; \
        P7_G16(rhb + so_, d_); P7_G16(rhb + so_ + 8192, d_ + 8192u); P7_G16(rlb + so_, d_ + 16384u); P7_G16(rlb + so_ + 8192, d_ + 24576u); } while (0)
#define P7_LOADX(slot, ch_) do { xv[slot][0] = *(const f32x4*)(xp + 64 * (ch_)); xv[slot][1] = *(const f32x4*)(xp + 64 * (ch_) + 4 * DM); xv[slot][2] = *(const f32x4*)(xp + 64 * (ch_) + 8 * DM); xv[slot][3] = *(const f32x4*)(xp + 64 * (ch_) + 12 * DM); } while (0)
    for (int t0 = F.vcu * NWAVES; t0 < NTOK / 16; t0 += F.G * NWAVES) {
        const int tile = t0 + F.wave;
        const int tok0 = 16 * tile;
        f32x4 acc0 = {0.f, 0.f, 0.f, 0.f}, acc1 = {0.f, 0.f, 0.f, 0.f};
        float ss0 = 0.f, ss1 = 0.f, ss2 = 0.f, ss3 = 0.f;
        const float* xp = X1 + (size_t)(tok0 + g4) * DM + 4 * c;
        unsigned char* hp = H2 + (size_t)(tok0 + (lane >> 2)) * DM + 16 * (lane & 3);
        f32x4 xv[4][4];
        P7_DMA(0);
        P7_LOADX(0, 0); P7_LOADX(1, 1); P7_LOADX(2, 2);
#pragma unroll 2
        for (int sl = 0; sl < 8; ++sl) {
            asm volatile("s_waitcnt vmcnt(12) lgkmcnt(0)" ::: "memory");
            __builtin_amdgcn_s_barrier(); asm volatile("" ::: "memory");
            if (sl + 1 < 8) P7_DMA(sl + 1);
            const LAS unsigned char* wsl = wbuf + (sl & 1) * 32768 + lane * 16;
#pragma unroll
            for (int u = 0; u < 4; ++u) {
                const int ch = 4 * sl + u;
                { const int cn = (ch + 3 < 32) ? ch + 3 : 31; P7_LOADX((u + 3) & 3, cn); }
                __builtin_amdgcn_sched_barrier(0);
                const f32x4 gv = *(const LAS f32x4*)(gl + 64 * ch + 4 * c);
#define P7_ROW(v, i, ssacc) do { ssacc += (v[0] * v[0] + v[1] * v[1]) + (v[2] * v[2] + v[3] * v[3]); const f32x4 y = v * gv; \
                *(LAS unsigned*)(fimg + (4 * (i) + g4) * 64 + 4 * c) = pk4_fp8(y[0], y[1], y[2], y[3]); \
                u32x2 hi, lo; hi.x = cvtpk(v[0], v[1]); hi.y = cvtpk(v[2], v[3]); \
                lo.x = cvtpk(v[0] - __uint_as_float(hi.x << 16), v[1] - __uint_as_float(hi.x & 0xffff0000u)); lo.y = cvtpk(v[2] - __uint_as_float(hi.y << 16), v[3] - __uint_as_float(hi.y & 0xffff0000u)); \
                *(LAS u32x2*)(himg + (4 * (i) + g4) * 144 + 8 * c) = hi; *(LAS u32x2*)(limg + (4 * (i) + g4) * 144 + 8 * c) = lo; } while (0)
                P7_ROW(xv[u][0], 0, ss0); P7_ROW(xv[u][1], 1, ss1); P7_ROW(xv[u][2], 2, ss2); P7_ROW(xv[u][3], 3, ss3);
#undef P7_ROW
                *(u32x4*)(hp + 64 * ch) = *(const LAS u32x4*)(fimg + 16 * lane);
#pragma unroll
                for (int kk = 0; kk < 2; ++kk) {
                    const bf16x8 bh_ = *(const LAS bf16x8*)(himg + c * 144 + (32 * kk + 8 * g4) * 2), bl_ = *(const LAS bf16x8*)(limg + c * 144 + (32 * kk + 8 * g4) * 2);
                    const bf16x8 ah0 = *(const LAS bf16x8*)(wsl + u * 4096 + (kk * 2) * 1024), ah1 = *(const LAS bf16x8*)(wsl + u * 4096 + (kk * 2 + 1) * 1024);
                    const bf16x8 al0 = *(const LAS bf16x8*)(wsl + 16384 + u * 4096 + (kk * 2) * 1024), al1 = *(const LAS bf16x8*)(wsl + 16384 + u * 4096 + (kk * 2 + 1) * 1024);
                    acc0 = __builtin_amdgcn_mfma_f32_16x16x32_bf16(ah0, bh_, acc0, 0, 0, 0); acc0 = __builtin_amdgcn_mfma_f32_16x16x32_bf16(ah0, bl_, acc0, 0, 0, 0); acc0 = __builtin_amdgcn_mfma_f32_16x16x32_bf16(al0, bh_, acc0, 0, 0, 0);
                    acc1 = __builtin_amdgcn_mfma_f32_16x16x32_bf16(ah1, bh_, acc1, 0, 0, 0); acc1 = __builtin_amdgcn_mfma_f32_16x16x32_bf16(ah1, bl_, acc1, 0, 0, 0); acc1 = __builtin_amdgcn_mfma_f32_16x16x32_bf16(al1, bh_, acc1, 0, 0, 0);
                }
                __builtin_amdgcn_sched_barrier(0);
            }
        }
#undef P7_LOADX
#undef P7_DMA
#undef P7_G16
#define P7_RED(x) do { x += __shfl_xor(x, 1); x += __shfl_xor(x, 2); x += __shfl_xor(x, 4); x += __shfl_xor(x, 8); x = 1.0f / sqrtf(x * (1.f / DM) + EPS); } while (0)
        P7_RED(ss0); P7_RED(ss1); P7_RED(ss2); P7_RED(ss3);
#undef P7_RED
        if (c == 0) { lr[g4] = ss0; lr[4 + g4] = ss1; lr[8 + g4] = ss2; lr[12 + g4] = ss3;
            RSTD[tok0 + g4] = ss0; RSTD[tok0 + 4 + g4] = ss1; RSTD[tok0 + 8 + g4] = ss2; RSTD[tok0 + 12 + g4] = ss3; }
        const float rs = lr[c];
        float v[8];
#pragma unroll
        for (int j = 0; j < 4; ++j) { v[j] = acc0[j] * rs + F.router_b[4 * g4 + j]; v[4 + j] = acc1[j] * rs + F.router_b[16 + 4 * g4 + j]; }
        float sv[4]; int si[4];
#pragma unroll
        for (int k = 0; k < 4; ++k) {
            float bv = v[0]; int bi = 4 * g4;
#pragma unroll
            for (int j = 1; j < 8; ++j) { const int ce = (j < 4) ? (4 * g4 + j) : (16 + 4 * g4 + j - 4); if (v[j] > bv) { bv = v[j]; bi = ce; } }
            { const float ov = __shfl_xor(bv, 16); const int oi = __shfl_xor(bi, 16); if (ov > bv || (ov == bv && oi < bi)) { bv = ov; bi = oi; } }
            { const float ov = __shfl_xor(bv, 32); const int oi = __shfl_xor(bi, 32); if (ov > bv || (ov == bv && oi < bi)) { bv = ov; bi = oi; } }
            sv[k] = bv; si[k] = bi;
#pragma unroll
            for (int j = 0; j < 8; ++j) { const int ce = (j < 4) ? (4 * g4 + j) : (16 + 4 * g4 + j - 4); if (ce == bi) v[j] = -3.0e38f; }
        }
        const float e1 = __expf(sv[1] - sv[0]), e2 = __expf(sv[2] - sv[0]), e3 = __expf(sv[3] - sv[0]);
        const float isum = 1.0f / (1.0f + e1 + e2 + e3);
        const int tok = tok0 + c;
        if (g4 == 0) { *(int4*)(TOPI + (size_t)tok * 4) = make_int4(si[0], si[1], si[2], si[3]); *(f32x4*)(TOPW + (size_t)tok * 4) = (f32x4){isum, e1 * isum, e2 * isum, e3 * isum}; }
        int cnt = 0;
#pragma unroll 4
        for (int e = 0; e < 32; ++e) { const bool has = (g4 == 0) && (si[0] == e || si[1] == e || si[2] == e || si[3] == e);
            const unsigned long long bm = __ballot(has); if (lane == e) cnt = __popcll(bm); }
        if (lane < 32 && cnt > 0) atomicAdd(HIST + (tile >> 1) * 32 + lane, cnt);
    }
}

DI void p8_dispatch(Frame& F) {
    const int* TOPI = (const int*)(F.ws + WS_SMALL + SM_TOPI); const float* TOPW = (const float*)(F.ws + WS_SMALL + SM_TOPW); const int* HIST = (const int*)(F.ws + WS_CTL + CTL_HIST); const float* RSTD = (const float*)(F.ws + WS_SMALL + SM_RSTD); float* ROWS = (float*)(F.ws + WS_SMALL + SM_ROWS);
    int* POS = (int*)(F.ws + WS_SMALL + SM_POS); int* ROWTOK = (int*)(F.ws + WS_SMALL + SM_ROWTOK); float* ROWW = (float*)(F.ws + WS_SMALL + SM_ROWW); int* TILEE = (int*)(F.ws + WS_SMALL + SM_TILEE);
    LAS int* pre = (LAS int*)F.lds;
    LAS int* seg = (LAS int*)(F.lds + MISC_OFF);
    for (int i = F.tid; i < 1024 * 32; i += NTHR) pre[i] = HIST[i];
    __syncthreads();
    { const int e = F.tid & 31, sg = F.tid >> 5; int run = 0;
      for (int i = 0; i < 64; ++i) { const int idx = (sg * 64 + i) * 32 + e; const int v = pre[idx]; pre[idx] = run; run += v; }
      seg[sg * 32 + e] = run; }
    __syncthreads();
    { const int e = F.tid & 31, sg = F.tid >> 5; int base = 0;
      for (int j = 0; j < sg; ++j) base += seg[j * 32 + e];
      for (int i = 0; i < 64; ++i) pre[(sg * 64 + i) * 32 + e] += base;
      if (sg == 15) seg[512 + e] = base + seg[15 * 32 + e]; }
    __syncthreads();
    if (F.tid == 0) { int ps = 0; for (int e = 0; e < 32; ++e) { const int c = seg[512 + e], pc = (c + 255) & ~255; seg[544 + e] = ps; seg[576 + e] = pc; ps += pc; } seg[608] = ps >> 8; }
    __syncthreads();
    const int NT = seg[608];
    const int gw = F.vcu * NWAVES + F.wave, NGW = F.G * NWAVES, lane = F.lane;
    for (int tile = gw; tile < 1024; tile += NGW) {
        const int tok = 32 * tile + (lane & 31);
        const int4 ti = *(const int4*)(TOPI + (size_t)tok * 4); const f32x4 tw = *(const f32x4*)(TOPW + (size_t)tok * 4);
        const int ek = (lane < 32) ? ti.x : ti.y, ek2 = (lane < 32) ? ti.z : ti.w;
        int rk = 0, rk2 = 0;
        for (int e = 0; e < 32; ++e) { const bool has = (lane < 32) && (ti.x == e || ti.y == e || ti.z == e || ti.w == e);
            const unsigned long long bm = __ballot(has); const int below = __popcll(bm & ((1ull << (lane & 31)) - 1ull));
            if (ek == e) rk = below; if (ek2 == e) rk2 = below; }
        const int d1 = seg[544 + ek] + pre[tile * 32 + ek] + rk, d2 = seg[544 + ek2] + pre[tile * 32 + ek2] + rk2;
        const int k1 = (lane < 32) ? 0 : 1, k2 = k1 + 2;
        const float rsd = RSTD[tok];
        ROWTOK[d1] = tok; ROWW[d1] = (lane < 32) ? tw[0] : tw[1]; ROWS[d1] = rsd; POS[(size_t)tok * 4 + k1] = d1;
        ROWTOK[d2] = tok; ROWW[d2] = (lane < 32) ? tw[2] : tw[3]; ROWS[d2] = rsd; POS[(size_t)tok * 4 + k2] = d2;
    }
    if (F.vcu < 32) { const int e = F.vcu, c = seg[512 + e], ps = seg[544 + e], pc = seg[576 + e];
        for (int i = c + F.tid; i < pc; i += NTHR) { ROWTOK[ps + i] = 0; ROWW[ps + i] = 0.f; ROWS[ps + i] = 0.f; } }
    if (F.vcu == 32 % F.G) { for (int rt = F.tid; rt < MAXRT; rt += NTHR) { int e = 31; for (int j = 31; j >= 0; --j) if (rt * 256 < seg[544 + j] + seg[576 + j] && seg[576 + j] > 0 && rt * 256 >= seg[544 + j]) e = j; TILEE[rt] = e; }
        if (F.tid == 0) TILEE[MAXRT] = NT; }
    __syncthreads();
}

DI void p11_combine(Frame& F) {
    const int* POS = (const int*)(F.ws + WS_SMALL + SM_POS); const unsigned char* YB = F.ws + WS_YB;
    const int gw = F.vcu * NWAVES + F.wave, NGW = F.G * NWAVES;
    int4 ps = *(const int4*)(POS + (size_t)(gw < NTOK ? gw : 0) * 4);
#pragma unroll 1
    for (int tok = gw; tok < NTOK; tok += NGW) {
        const int tn = tok + NGW < NTOK ? tok + NGW : tok;
        const int4 psn = *(const int4*)(POS + (size_t)tn * 4);
        f32x4* orow = (f32x4*)(F.out + (size_t)tok * DM) + F.lane;
        const unsigned* y0 = (const unsigned*)(YB + (size_t)ps.x * DM) + F.lane; const unsigned* y1 = (const unsigned*)(YB + (size_t)ps.y * DM) + F.lane;
        const unsigned* y2 = (const unsigned*)(YB + (size_t)ps.z * DM) + F.lane; const unsigned* y3 = (const unsigned*)(YB + (size_t)ps.w * DM) + F.lane;
        f32x4 v[8]; unsigned qa[8], qb[8], qc[8], qd[8];
#pragma unroll
        for (int j = 0; j < 8; ++j) { v[j] = orow[64 * j]; qa[j] = y0[64 * j]; qb[j] = y1[64 * j]; qc[j] = y2[64 * j]; qd[j] = y3[64 * j]; }
        __builtin_amdgcn_sched_barrier(0);
#pragma unroll
        for (int j = 0; j < 8; ++j) { const unsigned a = qa[j], bq = qb[j], cq = qc[j], dq = qd[j];
            const f32x2 a0 = __builtin_amdgcn_cvt_pk_f32_fp8((int)a, false), a1 = __builtin_amdgcn_cvt_pk_f32_fp8((int)a, true), b0 = __builtin_amdgcn_cvt_pk_f32_fp8((int)bq, false), b1 = __builtin_amdgcn_cvt_pk_f32_fp8((int)bq, true);
            const f32x2 c0 = __builtin_amdgcn_cvt_pk_f32_fp8((int)cq, false), c1 = __builtin_amdgcn_cvt_pk_f32_fp8((int)cq, true), d0 = __builtin_amdgcn_cvt_pk_f32_fp8((int)dq, false), d1 = __builtin_amdgcn_cvt_pk_f32_fp8((int)dq, true);
            f32x4 vv = v[j];
            vv[0] += (((a0[0] + b0[0]) + c0[0]) + d0[0]) * 0.0625f; vv[1] += (((a0[1] + b0[1]) + c0[1]) + d0[1]) * 0.0625f;
            vv[2] += (((a1[0] + b1[0]) + c1[0]) + d1[0]) * 0.0625f; vv[3] += (((a1[1] + b1[1]) + c1[1]) + d1[1]) * 0.0625f; orow[64 * j] = vv; }
        ps = psn;
    }
}

constexpr int NPHASE = 12;
__global__ void __launch_bounds__(NTHR, 2) mk_fwd(Args args) {
    extern __shared__ __attribute__((aligned(16))) unsigned char lds_raw[];
    Frame F;
    F.lds = (LAS unsigned char*)lds_raw;
    F.tid = threadIdx.x; F.lane = F.tid & 63; F.wave = __builtin_amdgcn_readfirstlane(F.tid >> 6);
    F.G = gridDim.x; { const int bx = blockIdx.x; F.vcu = (F.G % 8 == 0) ? (bx % 8) * (F.G / 8) + bx / 8 : bx; }
    F.x = args.in[0]; F.attn_g = args.in[1]; F.w_in = args.in[2]; F.qg = args.in[3]; F.kg = args.in[4]; F.conv_w = args.in[5]; F.conv_b = args.in[6]; F.i_b = args.in[7]; F.f_b = args.in[8];
    F.mlout_g = args.in[9]; F.w_out = args.in[10]; F.ffn_g = args.in[11]; F.router_w = args.in[12]; F.router_b = args.in[13]; F.w_up = args.in[14]; F.b_up = args.in[15]; F.w_down = args.in[16]; F.b_down = args.in[17];
    F.out = args.out; F.ws = args.ws;
    volatile LAS unsigned* MISCW = (volatile LAS unsigned*)(F.lds + LDS_BYTES - 64);
    if (F.tid < 16) MISCW[F.tid] = 0u;
    __syncthreads();
    XcdBarrier bar; bar.bar = (unsigned*)(F.ws + WS_CTL) + CW_BAR; bar.x = 0; bar.st = nullptr;
    if (N_LAUNCHES == 1) bar = xcd_barrier_post((unsigned*)(F.ws + WS_CTL) + CW_BAR, MISCW);
    const int lo = args.ph_lo, hi = args.ph_hi;
#ifndef PHASE_MASK
#define PHASE_MASK 0xfff
#endif
#define IN(k) ((((PHASE_MASK) >> (k)) & 1) && lo <= (k) && (k) < hi)
#define SEAM(k) do { if (IN(k) && IN((k) + 1)) xcd_barrier(bar); } while (0)

    if (IN(0)) { p0_prologue(F); } SEAM(0);
    if (IN(1)) {
        const int NGEMM = (F.G == 256) ? 192 : F.G;
        if ((int)blockIdx.x < NGEMM) { pg8::Gemm g{(const bf16*)(F.ws + WS_XN), (const bf16*)(F.ws + WS_WIN), DM, 0, nullptr, nullptr, nullptr, nullptr}; pg8::StaticOrder S; S.init(NTOK / 256, NPROJ / 256, NGEMM, (int)blockIdx.x);
            pg8::EpiProj E{(bf16*)(F.ws + WS_PROJ), NPROJ, F.qg, F.kg, (const float*)(F.ws + WS_SMALL + SM_ROPE), (LAS float*)(F.lds + MISC_OFF), (bf16*)(F.ws + WS_HM)}; pg8::gemm_phase<pg8::EpiProj, false, false, false>(F.lds, g, S, E);
            { VM_WAIT(); __syncthreads();
              if (F.tid == 0) { unsigned* ctr = (unsigned*)(F.ws + WS_CTL) + CW_SUB; __builtin_amdgcn_fence(__ATOMIC_RELEASE, "agent"); VM_WAIT(); xb_add(ctr, 1u);
                  unsigned sp = 0; while (xb_ld(ctr) < (unsigned)NGEMM) { __builtin_amdgcn_s_sleep(2); if (++sp > (1u << 22)) break; }
                  __builtin_amdgcn_fence(__ATOMIC_ACQUIRE, "agent"); VM_WAIT(); }
              __syncthreads(); }
            p2_conv(F, (int)blockIdx.x, NGEMM); }
        if (F.G == 256) { if ((int)blockIdx.x >= NGEMM) p0_expert_weights(F, (int)blockIdx.x - NGEMM, F.G - NGEMM); }
        else p0_expert_weights(F, F.vcu, F.G);
    } SEAM(1);
    if (IN(3)) {
#ifndef SKIP_ML
        for (int u = F.vcu; u < 1024; u += F.G) mlstm_m1_unit(F, u);
#endif
#ifndef SKIP_ATTN
        attn_phase<1, true, false>(F);
#endif
    } SEAM(3);
    if (IN(4)) {
#ifndef SKIP_ML
        mlstm_scan(F);
#endif
#ifndef SKIP_ATTN
        attn_phase<4, false, false>(F);
#endif
    } SEAM(4);
    if (IN(5)) {
#ifndef SKIP_ML
        for (int u = F.vcu; u < 1024; u += F.G) mlstm_m3_unit(F, u);
#endif
#ifndef SKIP_ATTN
        attn_phase<16, false, true>(F);
#endif
    } SEAM(5);
    if (IN(6)) { pg8::Gemm g{(const bf16*)(F.ws + WS_MIX), (const bf16*)(F.ws + WS_WOUT), DM, 0, nullptr, nullptr, nullptr, nullptr}; pg8::StaticOrder S; S.init(NTOK / 256, DM / 256, F.G, (int)blockIdx.x);
        pg8::EpiResid E{F.x, F.out, DM}; pg8::gemm_phase<pg8::EpiResid, false, false, false>(F.lds, g, S, E); } SEAM(6);
    if (IN(7)) { p7_router(F); } SEAM(7);
    if (IN(8)) { p8_dispatch(F); } SEAM(8);
    if (IN(9) || IN(10)) {
        LAS int* te = (LAS int*)(F.lds + MISC_OFF);
        const int* TILEE = (const int*)(F.ws + WS_SMALL + SM_TILEE);
        __syncthreads();
        for (int i = F.tid; i <= MAXRT; i += NTHR) te[i] = (int)__hip_atomic_load(TILEE + i, __ATOMIC_RELAXED, __HIP_MEMORY_SCOPE_AGENT);
        __syncthreads();
        const int NT = te[MAXRT];
        if (IN(9)) { pg8::Gemm g{(const bf16*)(F.ws + WS_XN), (const bf16*)(F.ws + WS_WUP), DM / 2, (size_t)UPW * DM, (const int*)(F.ws + WS_SMALL + SM_ROWTOK), te, F.lds + MISC_OFF + 4096, F.lds + ESTASH_OFF};   pg8::StaticOrder S; S.init(NT, UPW / 256, F.G, (int)blockIdx.x);
            pg8::EpiUp E{F.ws + WS_ACT, F.b_up, (const float*)(F.ws + WS_SMALL + SM_ROWS)}; pg8::gemm_phase<pg8::EpiUp, true, true, true>(F.lds, g, S, E); }
        SEAM(9);
        if (IN(10)) { pg8::Gemm g{(const bf16*)(F.ws + WS_ACT), (const bf16*)(F.ws + WS_WDN), FF / 2, (size_t)DM * FF, nullptr, te, nullptr, F.lds + ESTASH_OFF}; pg8::StaticOrder S; S.init(NT, DM / 256, F.G, (int)blockIdx.x);
            pg8::EpiDown E{F.ws + WS_YB, F.b_down, (const float*)(F.ws + WS_SMALL + SM_ROWW)}; pg8::gemm_phase<pg8::EpiDown, false, true, true>(F.lds, g, S, E); }
    }
    SEAM(10);
    if (IN(11)) { p11_combine(F); }
#undef IN
#undef SEAM
}

extern "C" void kernel_launch(void* const* d_in, const int* in_sizes, int n_in, void* d_out, int out_size, void* d_ws, size_t ws_size, hipStream_t stream) {
    static int grid = 0;
    if (grid == 0) {
        if (n_in != 18 || out_size != NTOK * DM || ws_size < WS_END) { fprintf(stderr, "kernel_launch: unexpected shapes (n_in %d, out %d, ws %zu)\n", n_in, out_size, ws_size); grid = -1; return; }
        int dev = 0, cus = 0, per_cu = 0;
        if (hipGetDevice(&dev) != hipSuccess || hipDeviceGetAttribute(&cus, hipDeviceAttributeMultiprocessorCount, dev) != hipSuccess) { grid = -1; return; }
        if (hipFuncSetAttribute((const void*)mk_fwd, hipFuncAttributeMaxDynamicSharedMemorySize, LDS_BYTES) != hipSuccess) { fprintf(stderr, "kernel_launch: hipFuncSetAttribute failed\n"); grid = -1; return; }
        if (hipOccupancyMaxActiveBlocksPerMultiprocessor(&per_cu, (const void*)mk_fwd, NTHR, LDS_BYTES) != hipSuccess || per_cu < 1) fprintf(stderr, "kernel_launch: occupancy query says %d\n", per_cu);
        (void)hipGetLastError();
        grid = cus;
    }
    if (grid < 0) return;
    (void)hipMemsetAsync((char*)d_ws + WS_CTL, 0, CTL_ZERO_BYTES, stream);
    Args a{};
    for (int i = 0; i < 18; ++i) a.in[i] = (const float*)d_in[i];
    a.out = (float*)d_out; a.ws = (unsigned char*)d_ws;
    if (N_LAUNCHES == 1) { a.ph_lo = 0; a.ph_hi = PH_STOP; hipLaunchKernelGGL(mk_fwd, dim3(grid), dim3(NTHR), LDS_BYTES, stream, a); }
    else { for (int ph = 0; ph < PH_STOP; ++ph) { a.ph_lo = ph; a.ph_hi = ph + 1; hipLaunchKernelGGL(mk_fwd, dim3(grid), dim3(NTHR), LDS_BYTES, stream, a); } }
}
```

```cpp
#include <hip/hip_runtime.h>
#include <cstdio>
#include <cstdint>

#ifndef N_LAUNCHES
#define N_LAUNCHES 1
#endif
#ifndef PH_STOP
#define PH_STOP 12
#endif

#define DI __device__ __forceinline__
#define GAS __attribute__((address_space(1)))
#define LAS __attribute__((address_space(3)))
typedef unsigned short bf16;
typedef short bf16x8 __attribute__((ext_vector_type(8)));
typedef short s16x4 __attribute__((ext_vector_type(4)));
typedef float f32x4 __attribute__((ext_vector_type(4)));
typedef float f32x2 __attribute__((ext_vector_type(2)));
typedef float f32x16 __attribute__((ext_vector_type(16)));
typedef unsigned u32x4 __attribute__((ext_vector_type(4)));
typedef unsigned u32x2 __attribute__((ext_vector_type(2)));
typedef __bf16 bf16x2_t __attribute__((ext_vector_type(2)));
typedef GAS unsigned gu32;

constexpr int SEQ = 16384, NBATCH = 2, NTOK = NBATCH * SEQ, DM = 2048, NPROJ = 6144, INW = 6152;
constexpr int COL_AQ = 0, COL_AK = 1024, COL_AV = 2048, COL_MQ = 3072, COL_MK = 3584, COL_MV = 4096, COL_MO = 5120;
constexpr int NE = 32, FF = 2048, UPW = 4096;
constexpr int MAXRT = 544, MAXSLOT = MAXRT * 256;
constexpr int NCH = 128;
constexpr float EPS = 1e-6f;
constexpr float QSCALE = 0.08838834764831845f;

constexpr size_t MiB = 1u << 20;
constexpr size_t WS_CTL = 0, CTL_ZERO_BYTES = 1 * MiB;
constexpr size_t WS_WIN = 2 * MiB;
constexpr size_t WS_WOUT = 26 * MiB;
constexpr size_t WS_RWT = 34 * MiB;
constexpr size_t WS_GATES = 35 * MiB;
constexpr size_t WS_SMALL = 36 * MiB;
constexpr size_t WS_WUP = 64 * MiB;
constexpr size_t WS_WDN = 576 * MiB;
constexpr size_t WS_XN = 832 * MiB;
constexpr size_t WS_PROJ = 960 * MiB;
constexpr size_t WS_QC = 1344 * MiB;
constexpr size_t WS_KC = 1376 * MiB;
constexpr size_t WS_CLOC = 1408 * MiB;
constexpr size_t WS_CPREV = 1536 * MiB;
constexpr size_t WS_OST = 1600 * MiB;
constexpr size_t WS_ML = 1728 * MiB;
constexpr size_t WS_MIX = 1732 * MiB;
constexpr size_t WS_ACT = 1860 * MiB;
constexpr size_t WS_YB = 2404 * MiB;
constexpr size_t WS_HM = WS_YB + 272 * MiB;
constexpr size_t HM_PLANE = (size_t)NTOK * 1024;
constexpr size_t WS_END = 2948 * MiB;
constexpr size_t SM_NLOC = 0;
constexpr size_t SM_NPREV = 512 * 1024;
constexpr size_t SM_G = 1024 * 1024;
constexpr size_t SM_MLOC = SM_G + 4096;
constexpr size_t SM_MPREV = SM_MLOC + 4096;
constexpr size_t SM_TOPI = SM_MPREV + 4096;
constexpr size_t SM_TOPW = SM_TOPI + 512 * 1024;
constexpr size_t SM_HIST = SM_TOPW + 512 * 1024;
constexpr size_t SM_POS = SM_HIST + 128 * 1024;
constexpr size_t SM_ROWTOK = SM_POS + 512 * 1024;
constexpr size_t SM_ROWW = SM_ROWTOK + 544 * 1024;
constexpr size_t SM_TILEE = SM_ROWW + 544 * 1024;
constexpr size_t SM_RSTD = SM_TILEE + 4096;
constexpr size_t SM_ROWS = SM_RSTD + 128 * 1024;
constexpr size_t SM_ROPE = SM_ROWS + 544 * 1024;
static_assert(SM_ROPE + 2 * MiB <= 16 * MiB, "small tables (WS_SMALL .. WS_WUP is 28 MiB)");
constexpr size_t CTL_HIST = 256 * 1024;
constexpr int CW_BAR = 4096, CW_SUB = 8192;

constexpr int RING_BYTES = 131072, MISC_OFF = RING_BYTES, ESTASH_OFF = MISC_OFF + 16384, LDS_BYTES = ESTASH_OFF + 8 * 768 + 64;
constexpr int NWAVES = 8, NTHR = 512;

DI unsigned cvtpk(float lo, float hi) { f32x2 v = {lo, hi}; bf16x2_t b = __builtin_convertvector(v, bf16x2_t); return __builtin_bit_cast(unsigned, b); }
DI unsigned pk4_fp8(float a, float b, float c, float d) {
    a = fminf(fmaxf(a, -448.f), 448.f); b = fminf(fmaxf(b, -448.f), 448.f); c = fminf(fmaxf(c, -448.f), 448.f); d = fminf(fmaxf(d, -448.f), 448.f);
    int v = __builtin_amdgcn_cvt_pk_fp8_f32(a, b, 0, false); v = __builtin_amdgcn_cvt_pk_fp8_f32(c, d, v, true); return (unsigned)v; }
DI unsigned pk4_fp8m(float a, float b, float c, float d) {
    a = __builtin_amdgcn_fmed3f(a, -448.f, 448.f); b = __builtin_amdgcn_fmed3f(b, -448.f, 448.f); c = __builtin_amdgcn_fmed3f(c, -448.f, 448.f); d = __builtin_amdgcn_fmed3f(d, -448.f, 448.f);
    int v = __builtin_amdgcn_cvt_pk_fp8_f32(a, b, 0, false); v = __builtin_amdgcn_cvt_pk_fp8_f32(c, d, v, true); return (unsigned)v; }
DI void swap32(u32x2& a, u32x2& b) {
    const auto r0 = __builtin_amdgcn_permlane32_swap(a.x, b.x, false, false); const auto r1 = __builtin_amdgcn_permlane32_swap(a.y, b.y, false, false);
    a.x = r0[0]; b.x = r0[1]; a.y = r1[0]; b.y = r1[1]; }
DI float bf2f(unsigned short b) { return __uint_as_float(((unsigned)b) << 16); }
DI float wave_sum(float v) {
#pragma unroll
    for (int o = 1; o < 64; o <<= 1) v += __shfl_xor(v, o);
    return v;
}
DI float wave_max(float v) {
#pragma unroll
    for (int o = 1; o < 64; o <<= 1) v = fmaxf(v, __shfl_xor(v, o));
    return v;
}
DI f32x16 mfma32(bf16x8 a, bf16x8 b, f32x16 c) { return __builtin_amdgcn_mfma_f32_32x32x16_bf16(a, b, c, 0, 0, 0); }
DI int crow(int reg, int h) { return (reg & 3) + 8 * (reg >> 2) + 4 * h; }
DI int img_off(int row, int ch) { return 256 * row + 16 * (ch ^ (((row & 3) << 2) | ((row >> 2) & 3))); }
typedef short v4i16_t __attribute__((ext_vector_type(4)));
DI s16x4 tr16(const LAS unsigned char* p) { return __builtin_bit_cast(s16x4, __builtin_amdgcn_ds_read_tr16_b64_v4i16((LAS v4i16_t*)p)); }
DI bf16x8 tr_frag(const LAS unsigned char* img, int r0a, int r0b, int cch, int q, int p) {
    const s16x4 lo = tr16(img + img_off(r0a + q, cch + (p >> 1)) + 8 * (p & 1));
    const s16x4 hi = tr16(img + img_off(r0b + q, cch + (p >> 1)) + 8 * (p & 1));
    return __builtin_shufflevector(lo, hi, 0, 1, 2, 3, 4, 5, 6, 7);
}
DI int tr_base(int rlane, int cch, int q, int p) { return img_off(rlane + q, cch + (p >> 1)) + 8 * (p & 1); }
DI bf16x8 tr_frag2(const LAS unsigned char* img, int ba, int bb, int off) { const s16x4 lo = tr16(img + ba + off), hi = tr16(img + bb + off); return __builtin_shufflevector(lo, hi, 0, 1, 2, 3, 4, 5, 6, 7); }
DI bf16x8 row_frag(const LAS unsigned char* img, int row, int ch) { return *(const LAS bf16x8*)(img + img_off(row, ch)); }
#define LDS_WAIT() asm volatile("s_waitcnt lgkmcnt(0)" ::: "memory")
#define VM_WAIT() asm volatile("s_waitcnt vmcnt(0)" ::: "memory")

#define XB_TMO      128
#define XB_XCNT(j)  (256  + 64 * (j))
#define XB_XSUB(j)  (1280 + 64 * (j))
#define XB_XGEN(j)  (2304 + 64 * (j))
#define XB_TOP      3328
#define XB_TOPGEN   3392
#define XCD_BAR_WORDS 3456
#define XB_SPIN_CAP (1u << 18)
DI unsigned xb_ld(unsigned* p)              { return __hip_atomic_load(p, __ATOMIC_RELAXED, __HIP_MEMORY_SCOPE_AGENT); }
DI unsigned xb_add(unsigned* p, unsigned v) { return __hip_atomic_fetch_add(p, v, __ATOMIC_RELAXED, __HIP_MEMORY_SCOPE_AGENT); }
DI unsigned xb_xcc_id() { return (unsigned)__builtin_amdgcn_s_getreg((3 << 11) | 20) & 0xFu; }
#define XB_SPIN(cond, bar) do { unsigned _sp = 0; while (cond) { __builtin_amdgcn_s_sleep(1); \
    if ((++_sp & 255u) == 0u) { if (xb_ld(&(bar)[XB_TMO])) break; if (_sp > XB_SPIN_CAP) { atomicAdd(&(bar)[XB_TMO], 1u); break; } } } } while (0)
struct XcdBarrier { unsigned* bar; unsigned x; volatile LAS unsigned* st; };
DI XcdBarrier xcd_barrier_post(unsigned* bar, volatile LAS unsigned* st) {
    XcdBarrier b; b.bar = bar; b.x = xb_xcc_id(); b.st = st;
    if (threadIdx.x == 0) (void)xb_add(&bar[XB_XCNT(b.x)], 1u);
    return b;
}
DI void xcd_barrier_complete(unsigned* bar, unsigned x, unsigned& nloc, unsigned& nx) {
    const unsigned G = gridDim.x * gridDim.y * gridDim.z;
    unsigned sum, cnt, mine, sp = 0u;
    for (;;) {
        sum = 0u; cnt = 0u; mine = 0u;
#pragma unroll
        for (unsigned j = 0; j < 16; ++j) { const unsigned c = xb_ld(&bar[XB_XCNT(j)]); sum += c; cnt += (c > 0u) ? 1u : 0u; mine = (j == x) ? c : mine; }
        if (sum == G) break;
        __builtin_amdgcn_s_sleep(1);
        if ((++sp & 255u) == 0u) { if (xb_ld(&bar[XB_TMO])) break; if (sp > XB_SPIN_CAP) { atomicAdd(&bar[XB_TMO], 1u); break; } }
    }
    nloc = mine > 0u ? mine : 1u; nx = cnt > 0u ? cnt : 1u;
}
DI void xcd_barrier(const XcdBarrier& b) {
    asm volatile("s_waitcnt vmcnt(0)" ::: "memory");
    __syncthreads();
    if (threadIdx.x == 0) {
        unsigned* bar = b.bar;
        __builtin_amdgcn_s_waitcnt(0);
        unsigned nloc = b.st[0], nx = b.st[1];
        if (nloc == 0u) { xcd_barrier_complete(bar, b.x, nloc, nx); b.st[0] = nloc; b.st[1] = nx; }
        const unsigned old = xb_add(&bar[XB_XSUB(b.x)], 1u);
        const unsigned gen = old / nloc;
        if (old + 1u == (gen + 1u) * nloc) {
            __builtin_amdgcn_fence(__ATOMIC_RELEASE, "agent");
            asm volatile("s_waitcnt vmcnt(0)" ::: "memory");
            const unsigned og = xb_add(&bar[XB_TOP], 1u);
            const unsigned tg = og / nx;
            if (og + 1u == (tg + 1u) * nx) xb_add(&bar[XB_TOPGEN], 1u);
            else XB_SPIN(xb_ld(&bar[XB_TOPGEN]) == tg, bar);
            __builtin_amdgcn_fence(__ATOMIC_ACQUIRE, "agent");
            xb_add(&bar[XB_XGEN(b.x)], 1u);
            asm volatile("s_waitcnt vmcnt(0)" ::: "memory");
        } else {
            XB_SPIN(xb_ld(&bar[XB_XGEN(b.x)]) == gen, bar);
            __builtin_amdgcn_fence(__ATOMIC_ACQUIRE, "agent");
            asm volatile("s_waitcnt vmcnt(0)" ::: "memory");
        }
    }
    __syncthreads();
}

struct Args { const float* in[18]; float* out; unsigned char* ws; int ph_lo, ph_hi; };
struct Frame {
    LAS unsigned char* lds; int tid, lane, wave, vcu, G;
    const float *x, *attn_g, *w_in, *qg, *kg, *conv_w, *conv_b, *i_b, *f_b, *mlout_g, *w_out, *ffn_g, *router_w, *router_b, *w_up, *b_up, *w_down, *b_down;
    float* out; unsigned char* ws;
};

namespace pg8 {
typedef int v8i32 __attribute__((ext_vector_type(8)));
constexpr int BM = 256, BK = 64, HALF = 128, HTB = HALF * BK * 2, STAGE_BYTES = 8 * HTB, NXCD = 8, WGM = 8;
DI int lds_byte(int r, int c) { const int st = (r >> 4) * 2 + (c >> 5), rr = r & 15, cc = c & 31, ob = rr * 64 + cc * 2; return st * 1024 + (ob ^ (((ob >> 9) & 1) << 5)); }
DI void stage_rc(int b, int& R, int& C) { const int st = b / 1024, sb = b % 1024, swz = sb ^ (((sb >> 9) & 1) << 5); R = (st >> 1) * 16 + swz / 64; C = (st & 1) * 32 + (swz % 64) / 2; }
DI int perm32(int rho) { const int n = rho >> 4, i = rho & 15; return 8 * (i >> 2) + 4 * n + (i & 3); }
DI const char* sptr(const char* p) { const unsigned long long v = (unsigned long long)p; const unsigned lo = __builtin_amdgcn_readfirstlane((unsigned)v), hi = __builtin_amdgcn_readfirstlane((unsigned)(v >> 32)); return (const char*)(((unsigned long long)hi << 32) | lo); }
struct Unit { int pm, pn, e; };
struct Gemm { const bf16* A; const bf16* Bt; int K; size_t estride; const int* rowtok; const LAS int* tile_e; LAS unsigned char* stash; LAS unsigned char* estash; };
struct StaticOrder {
    int nM, nN, nwg, G, c;
    DI void init(int nM_, int nN_, int G_, int c_) { nM = nM_; nN = nN_; nwg = nM * nN; G = G_; c = c_; }
    DI bool next(int i, Unit& u) const {
        const long L = (long)i * G + c; if (L >= nwg) return false;
        int wgid = (int)L; { const int q = nwg / NXCD, r = nwg % NXCD, xcd = wgid % NXCD, off = wgid / NXCD; wgid = (xcd < r ? xcd * (q + 1) : r * (q + 1) + (xcd - r) * q) + off; }
        const int nig = WGM * nN, gid = wgid / nig, fm = gid * WGM, gsz = (nM - fm) < WGM ? (nM - fm) : WGM;
        u.pm = fm + ((wgid % nig) % gsz); u.pn = (wgid % nig) / gsz; u.e = 0; return true;
    }
};
template <class Epi, bool GATHER, bool EXPERT, bool FP8>
DI void gemm_phase(LAS unsigned char* lds, const Gemm g, const StaticOrder& S, const Epi& E) {
    const int tid = threadIdx.x, wid = __builtin_amdgcn_readfirstlane(tid >> 6), lane = tid & 63, wr = wid >> 2, wc = wid & 3, fr = lane & 15, fq = lane >> 4;
    const int K = g.K, nt = K / BK;
    unsigned voffB[2], coffA[2][2];
    const size_t kstep = (size_t)(BK * 2), hstep = (size_t)HALF * K * 2, tstep = 2 * hstep;
#pragma unroll
    for (int i = 0; i < 2; ++i) { int R, C; stage_rc(tid * 16 + i * 8192, R, C); const int Rb = Epi::PERM ? ((R & ~31) + perm32(R & 31)) : R;
        voffB[i] = (unsigned)(Rb * K + C) * 2u; }
    const unsigned ldsw = (unsigned)wid * 1024u;
    const int aoff = lds_byte(wr * 64 + fr, fq * 8), boff = lds_byte(wc * 32 + fr, fq * 8);
#define PG8_SA(b, h) (((b) * 2 + (h)) * HTB)
#define PG8_SB(b, h) ((4 + (b) * 2 + (h)) * HTB)
#define PG8_GLDS(gp, lp) __builtin_amdgcn_global_load_lds((const unsigned*)(gp), (LAS unsigned*)(lp), 16, 0, 0)
#define PG8_OPQ(x) ({ unsigned o_ = (x); asm volatile("" : "+v"(o_)); o_; })
#define PG8_STAGE_B(bufoff, gbase) do { const char* sb_ = (const char*)(gbase); PG8_GLDS(sb_ + PG8_OPQ(voffB[0]), lds + (bufoff) + ldsw); PG8_GLDS(sb_ + PG8_OPQ(voffB[1]), lds + (bufoff) + ldsw + 8192); } while (0)
#define PG8_STAGE_A(bufoff, gbase, o0, o1) do { const char* sb_ = (const char*)(gbase); PG8_GLDS(sb_ + PG8_OPQ(o0), lds + (bufoff) + ldsw); PG8_GLDS(sb_ + PG8_OPQ(o1), lds + (bufoff) + ldsw + 8192); } while (0)
#define PG8_LDA(dst, b, h) do { _Pragma("unroll") for (int m = 0; m < 4; ++m) _Pragma("unroll") for (int k = 0; k < 2; ++k) dst[m][k] = *(const LAS bf16x8*)(lds + PG8_SA(b, h) + aoff + m * 2048 + k * 1024); } while (0)
#define PG8_LDB(dst, b, h) do { _Pragma("unroll") for (int n = 0; n < 2; ++n) _Pragma("unroll") for (int k = 0; k < 2; ++k) dst[n][k] = *(const LAS bf16x8*)(lds + PG8_SB(b, h) + boff + n * 2048 + k * 1024); } while (0)
#define PG8_CAT(x) __builtin_bit_cast(v8i32, __builtin_shufflevector(x[0], x[1], 0, 1, 2, 3, 4, 5, 6, 7, 8, 9, 10, 11, 12, 13, 14, 15))
#define PG8_MMA(ai, bj, At, Bt) do { __builtin_amdgcn_s_setprio(1); _Pragma("unroll") for (int m = 0; m < 4; ++m) _Pragma("unroll") for (int n = 0; n < 2; ++n) { \
        if (FP8) acc[ai][bj][m][n] = __builtin_amdgcn_mfma_scale_f32_16x16x128_f8f6f4(PG8_CAT(Bt[n]), PG8_CAT(At[m]), acc[ai][bj][m][n], 0, 0, 0, 0x7F7F7F7F, 0, 0x7F7F7F7F); \
        else { _Pragma("unroll") for (int k = 0; k < 2; ++k) acc[ai][bj][m][n] = __builtin_amdgcn_mfma_f32_16x16x32_bf16(Bt[n][k], At[m][k], acc[ai][bj][m][n], 0, 0, 0); } } \
        __builtin_amdgcn_s_setprio(0); \
        asm volatile("" : "+v"(acc[ai][bj][0][0]), "+v"(acc[ai][bj][0][1]), "+v"(acc[ai][bj][1][0]), "+v"(acc[ai][bj][1][1]), "+v"(acc[ai][bj][2][0]), "+v"(acc[ai][bj][2][1]), "+v"(acc[ai][bj][3][0]), "+v"(acc[ai][bj][3][1])); } while (0)
#define PG8_WAIT_V(n) asm volatile("s_waitcnt vmcnt(" #n ")" ::: "memory")
#define PG8_WAIT_L(n) asm volatile("s_waitcnt lgkmcnt(" #n ")" ::: "memory")
#define PG8_BAR __builtin_amdgcn_s_barrier()
#define PG8_SCHED __builtin_amdgcn_sched_barrier(0)
#define PG8_OFFS(dst, pm_) do { int t2_ = threadIdx.x; asm volatile("" : "+v"(t2_)); _Pragma("unroll") for (int i_ = 0; i_ < 2; ++i_) { int R_, C_; stage_rc(t2_ * 16 + i_ * 8192, R_, C_); \
        _Pragma("unroll") for (int h_ = 0; h_ < 2; ++h_) { \
        if (GATHER) dst[h_][i_] = (unsigned)g.rowtok[(pm_) * 256 + h_ * 128 + R_] * (unsigned)(K * 2) + (unsigned)(C_ * 2); \
        else dst[h_][i_] = (unsigned)((h_ * 128 + R_) * K + C_) * 2u; } } } while (0)
    Unit cur, nxt; int ui = 0;
    if (!S.next(0, cur)) return;
    if (EXPERT) cur.e = __builtin_amdgcn_readfirstlane(g.tile_e[cur.pm]);
    f32x4 acc[2][2][4][2];
#pragma unroll
    for (int a = 0; a < 2; ++a)
#pragma unroll
        for (int b = 0; b < 2; ++b)
#pragma unroll
            for (int m = 0; m < 4; ++m)
#pragma unroll
                for (int n = 0; n < 2; ++n) acc[a][b][m][n] = (f32x4){0.f, 0.f, 0.f, 0.f};
    bf16x8 At[4][2], B0[2][2], B1[2][2];
    PG8_OFFS(coffA, cur.pm);
    const char* cA = sptr((const char*)g.A + (GATHER ? (size_t)0 : (size_t)cur.pm * tstep));
    const char* cB = sptr((const char*)g.Bt + (size_t)cur.e * g.estride + (size_t)cur.pn * tstep);
    LAS unsigned char* est = g.estash + wid * 768;
    if (Epi::STASH) E.prefetch(cur, wr, wc, lane, est);
    LAS unsigned char* stash = g.stash + wid * 256;
    PG8_STAGE_B(PG8_SB(0, 0), cB); PG8_STAGE_B(PG8_SB(0, 1), cB + hstep); PG8_STAGE_A(PG8_SA(0, 0), cA, coffA[0][0], coffA[0][1]); PG8_STAGE_A(PG8_SA(0, 1), cA, coffA[1][0], coffA[1][1]);
    if (wr == 1) PG8_BAR;
    PG8_WAIT_V(2); PG8_BAR;
    PG8_STAGE_B(PG8_SB(1, 0), cB + kstep); PG8_STAGE_A(PG8_SA(1, 0), cA + kstep, coffA[0][0], coffA[0][1]); PG8_STAGE_B(PG8_SB(1, 1), cB + hstep + kstep);
    PG8_WAIT_V(6); PG8_BAR;
#define PG8_TRIP(a1, a2, b2, a3, b3, o00, o01, o10, o11) do { \
            PG8_LDB(B0, 0, 0); PG8_LDB(B1, 0, 1); PG8_SCHED; PG8_LDA(At, 0, 0); PG8_STAGE_A(PG8_SA(1, 1), a1, coffA[1][0], coffA[1][1]); \
            PG8_WAIT_V(8); PG8_WAIT_L(0); PG8_BAR; PG8_MMA(0, 0, At, B0); PG8_MMA(0, 1, At, B1); PG8_BAR; PG8_SCHED; \
            PG8_LDA(At, 0, 1); PG8_STAGE_B(PG8_SB(0, 0), b2); PG8_STAGE_B(PG8_SB(0, 1), (b2) + hstep); PG8_STAGE_A(PG8_SA(0, 0), a2, o00, o01); \
            PG8_WAIT_V(8); PG8_WAIT_L(0); PG8_BAR; PG8_MMA(1, 0, At, B0); PG8_MMA(1, 1, At, B1); PG8_BAR; PG8_SCHED; \
            PG8_LDB(B0, 1, 0); PG8_LDB(B1, 1, 1); PG8_SCHED; PG8_LDA(At, 1, 0); PG8_STAGE_A(PG8_SA(0, 1), a2, o10, o11); \
            PG8_WAIT_V(8); PG8_WAIT_L(0); PG8_BAR; PG8_MMA(0, 0, At, B0); PG8_MMA(0, 1, At, B1); PG8_BAR; PG8_SCHED; \
            PG8_LDA(At, 1, 1); PG8_STAGE_B(PG8_SB(1, 0), b3); PG8_STAGE_B(PG8_SB(1, 1), (b3) + hstep); PG8_STAGE_A(PG8_SA(1, 0), a3, o00, o01); \
            PG8_WAIT_V(8); PG8_WAIT_L(0); PG8_BAR; PG8_MMA(1, 0, At, B0); PG8_MMA(1, 1, At, B1); PG8_BAR; PG8_SCHED; } while (0)
    for (;;) {
        const bool has_next = S.next(ui + 1, nxt);
        if (EXPERT) nxt.e = has_next ? __builtin_amdgcn_readfirstlane(g.tile_e[nxt.pm]) : 0;
        const char* nA = sptr(has_next ? (const char*)g.A + (GATHER ? (size_t)0 : (size_t)nxt.pm * tstep) : cA);
        const char* nB = sptr(has_next ? (const char*)g.Bt + (size_t)nxt.e * g.estride + (size_t)nxt.pn * tstep : cB);
        if (GATHER && has_next) {
            int t2_ = threadIdx.x; asm volatile("" : "+v"(t2_));
#pragma unroll
            for (int i_ = 0; i_ < 2; ++i_) { int R_, C_; stage_rc(t2_ * 16 + i_ * 8192, R_, C_);
#pragma unroll
                for (int h_ = 0; h_ < 2; ++h_) __builtin_amdgcn_global_load_lds((const unsigned*)(g.rowtok + nxt.pm * 256 + h_ * 128 + R_), (LAS unsigned*)(stash + (h_ * 2 + i_) * 2048), 4, 0, 0); }
        }
        int C0x2 = 0, C1x2 = 0; const LAS unsigned* sp = nullptr;
        if (GATHER) { int t2_ = threadIdx.x; asm volatile("" : "+v"(t2_)); int R0_, C0_, R1_, C1_; stage_rc(t2_ * 16, R0_, C0_); stage_rc(t2_ * 16 + 8192, R1_, C1_); C0x2 = C0_ * 2; C1x2 = C1_ * 2;
            sp = (const LAS unsigned*)(stash + (t2_ & 63) * 4); }
        asm volatile(".p2align 8" ::: "memory");
#pragma unroll 1
        for (int t = 0; t < nt; t += 2) {
            const bool last = (t == nt - 2);
            const char* a1 = cA + (size_t)(t + 1) * kstep;
            const char* a2 = last ? nA : cA + (size_t)(t + 2) * kstep; const char* b2 = last ? nB : cB + (size_t)(t + 2) * kstep;
            const char* a3 = a2 + kstep; const char* b3 = b2 + kstep;
            unsigned o00 = coffA[0][0], o01 = coffA[0][1], o10 = coffA[1][0], o11 = coffA[1][1];
            if (GATHER && last && has_next) {
                o00 = sp[0] * (unsigned)(K * 2) + (unsigned)C0x2; o01 = sp[512] * (unsigned)(K * 2) + (unsigned)C1x2;
                o10 = sp[1024] * (unsigned)(K * 2) + (unsigned)C0x2; o11 = sp[1536] * (unsigned)(K * 2) + (unsigned)C1x2; }
            PG8_TRIP(a1, a2, b2, a3, b3, o00, o01, o10, o11);
            if (last) { coffA[0][0] = o00; coffA[0][1] = o01; coffA[1][0] = o10; coffA[1][1] = o11; }
        }
        if (wr == 0) PG8_BAR;
        { int l2 = threadIdx.x & 63; asm volatile("" : "+v"(l2)); E(acc, cur, wr, wc, l2 & 15, l2 >> 4, est); }
        if (!has_next) break;
#pragma unroll
        for (int a = 0; a < 2; ++a)
#pragma unroll
            for (int b = 0; b < 2; ++b)
#pragma unroll
                for (int m = 0; m < 4; ++m)
#pragma unroll
                    for (int n = 0; n < 2; ++n) acc[a][b][m][n] = (f32x4){0.f, 0.f, 0.f, 0.f};
        cur = nxt; cA = nA; cB = nB; ++ui;
        if (Epi::STASH) { int l2 = threadIdx.x & 63; asm volatile("" : "+v"(l2)); E.prefetch(cur, wr, wc, l2, est); }
        if (wr == 1) PG8_BAR;
    }
    PG8_WAIT_V(0);
    PG8_BAR;
#undef PG8_TRIP
#undef PG8_SA
#undef PG8_SB
#undef PG8_GLDS
#undef PG8_STAGE_A
#undef PG8_OPQ
#undef PG8_STAGE_B
#undef PG8_LDA
#undef PG8_LDB
#undef PG8_MMA
#undef PG8_CAT
#undef PG8_WAIT_V
#undef PG8_WAIT_L
#undef PG8_BAR
#undef PG8_SCHED
#undef PG8_OFFS
}

struct EpiProj {
    static constexpr bool PERM = true; static constexpr bool STASH = false;
    DI void prefetch(const Unit&, int, int, int, LAS unsigned char*) const {}
    bf16* O; int ldc; const float* qg; const float* kg; const float* rope; LAS float* P; bf16* HM;
    DI void operator()(const f32x4 (&acc)[2][2][4][2], const Unit& u, int wr, int wc, int fr, int fq, const LAS unsigned char* st) const {
        const int row0 = u.pm * BM + wr * 64 + fr, col0 = u.pn * BM + wc * 32 + 8 * fq;
        if (u.pn >= 8) {
#pragma unroll
            for (int ai = 0; ai < 2; ++ai)
#pragma unroll
                for (int m = 0; m < 4; ++m) { const int row = row0 + ai * HALF + m * 16; bf16* rowp = O + (size_t)row * ldc + col0;
                    if (u.pn < 12) rowp = HM + 2 * HM_PLANE + ((size_t)((row >> 14) * 8 + ((2 * u.pn) & 7)) * SEQ + (row & (SEQ - 1))) * 128 + wc * 32 + 8 * fq;
#pragma unroll
                    for (int bj = 0; bj < 2; ++bj) { const f32x4 v0 = acc[ai][bj][m][0], v1 = acc[ai][bj][m][1];
                        u32x4 w; w.x = cvtpk(v0[0], v0[1]); w.y = cvtpk(v0[2], v0[3]); w.z = cvtpk(v1[0], v1[1]); w.w = cvtpk(v1[2], v1[3]);
                        *(u32x4*)(rowp + (u.pn < 12 ? (size_t)bj * SEQ * 128 : (size_t)bj * HALF)) = w; } }
            return;
        }
        f32x4 rc[3][4];
#define EPR_LOAD(it_) do { const int rl_ = ((it_) >> 2) * HALF + wr * 64 + ((it_) & 3) * 16 + fr; const float* tp_ = rope + (size_t)((u.pm * BM + rl_) & (SEQ - 1)) * 32 + 8 * (fq & 1); \
            rc[(it_) % 3][0] = *(const f32x4*)tp_; rc[(it_) % 3][1] = *(const f32x4*)(tp_ + 4); rc[(it_) % 3][2] = *(const f32x4*)(tp_ + 16); rc[(it_) % 3][3] = *(const f32x4*)(tp_ + 20); } while (0)
        if (wc == 0) { EPR_LOAD(0); EPR_LOAD(1); }
#pragma unroll
        for (int ai = 0; ai < 2; ++ai)
#pragma unroll
            for (int m = 0; m < 4; ++m)
#pragma unroll
                for (int bj = 0; bj < 2; ++bj) { const f32x4 v0 = acc[ai][bj][m][0], v1 = acc[ai][bj][m][1];
                    float ss = (v0[0] * v0[0] + v0[1] * v0[1]) + (v0[2] * v0[2] + v0[3] * v0[3]) + (v1[0] * v1[0] + v1[1] * v1[1]) + (v1[2] * v1[2] + v1[3] * v1[3]);
                    ss += __shfl_xor(ss, 16); ss += __shfl_xor(ss, 32);
                    if (fq == 0) P[((ai * HALF + wr * 64 + m * 16 + fr) * 2 + bj) * 4 + wc] = ss; }
        asm volatile("s_waitcnt lgkmcnt(0)" ::: "memory"); __builtin_amdgcn_s_barrier(); asm volatile("" ::: "memory");
        const bool isk = u.pn >= 4; const float* gp = (isk ? kg : qg) + wc * 32 + 8 * fq; const float sc = isk ? 1.0f : QSCALE * 1.4426950408889634f;
        const f32x4 gA = *(const f32x4*)gp, gB = *(const f32x4*)(gp + 4);
#pragma unroll
        for (int ai = 0; ai < 2; ++ai)
#pragma unroll
            for (int m = 0; m < 4; ++m) { const int rl = ai * HALF + wr * 64 + m * 16 + fr; const int row = u.pm * BM + rl;
                bf16* rowp = HM + (isk ? HM_PLANE : (size_t)0) + ((size_t)((row >> 14) * 8 + ((2 * u.pn) & 7)) * SEQ + (row & (SEQ - 1))) * 128 + wc * 32 + 8 * fq;
                f32x4 cA = {1.f, 1.f, 1.f, 1.f}, cB = cA, sA = {0.f, 0.f, 0.f, 0.f}, sB = sA;
                if (wc == 0) { const int it = 4 * ai + m; if (it + 2 < 8) EPR_LOAD(it + 2);
                    cA = rc[it % 3][0]; cB = rc[it % 3][1]; sA = rc[it % 3][2]; sB = rc[it % 3][3]; if (fq < 2) { sA = -sA; sB = -sB; } }
#pragma unroll
                for (int bj = 0; bj < 2; ++bj) { const f32x4 pp = *(const LAS f32x4*)(P + (rl * 2 + bj) * 4);
                    const float rstd = 1.0f / sqrtf(((pp[0] + pp[1]) + (pp[2] + pp[3])) * (1.f / 128.f) + EPS);
                    f32x4 y0 = acc[ai][bj][m][0] * rstd * gA, y1 = acc[ai][bj][m][1] * rstd * gB;
                    if (wc == 0) { f32x4 o0, o1;
#pragma unroll
                        for (int j = 0; j < 4; ++j) { o0[j] = __shfl_xor(y0[j], 32); o1[j] = __shfl_xor(y1[j], 32); }
                        y0 = y0 * cA + o0 * sA; y1 = y1 * cB + o1 * sB; }
                    y0 = y0 * sc; y1 = y1 * sc;
                    u32x4 w; w.x = cvtpk(y0[0], y0[1]); w.y = cvtpk(y0[2], y0[3]); w.z = cvtpk(y1[0], y1[1]); w.w = cvtpk(y1[2], y1[3]);
                    *(u32x4*)(rowp + (size_t)bj * SEQ * 128) = w; } }
#undef EPR_LOAD
    }
};
struct EpiResid {
    static constexpr bool PERM = false; static constexpr bool STASH = false;
    const float* base; float* C; int ldc;
    DI void prefetch(const Unit&, int, int, int, LAS unsigned char*) const {}
    DI void operator()(const f32x4 (&acc)[2][2][4][2], const Unit& u, int wr, int wc, int fr, int fq, const LAS unsigned char* st) const {
        const int row0 = u.pm * BM + wr * 64 + fr, col0 = u.pn * BM + wc * 32 + 4 * fq;
        f32x4 rb[4][4];
#define EPS_LOAD(g_) do { const size_t off_ = (size_t)(row0 + ((g_) >> 2) * HALF + ((g_) & 3) * 16) * ldc + col0; \
            _Pragma("unroll") for (int bj = 0; bj < 2; ++bj) _Pragma("unroll") for (int n = 0; n < 2; ++n) rb[(g_) & 3][2 * bj + n] = *(const f32x4*)(base + off_ + bj * HALF + n * 16); } while (0)
        EPS_LOAD(0); EPS_LOAD(1); EPS_LOAD(2);
#pragma unroll
        for (int ai = 0; ai < 2; ++ai)
#pragma unroll
            for (int m = 0; m < 4; ++m) { const int g = 4 * ai + m; const size_t off = (size_t)(row0 + ai * HALF + m * 16) * ldc + col0;
                if (g + 3 < 8) EPS_LOAD(g + 3);
#pragma unroll
                for (int bj = 0; bj < 2; ++bj)
#pragma unroll
                    for (int n = 0; n < 2; ++n) *(f32x4*)(C + off + bj * HALF + n * 16) = rb[g & 3][2 * bj + n] + acc[ai][bj][m][n]; }
#undef EPS_LOAD
    }
};
DI float swiglu4(float hg, float hl) {
    const float glu = fminf(hg, 7.0f), lin = __builtin_amdgcn_fmed3f(hl, -7.0f, 7.0f);
    const float sg = __builtin_amdgcn_rcpf(1.0f + __builtin_amdgcn_exp2f(glu * (-1.702f * 1.4426950408889634f)));
    return (glu * sg) * __builtin_fmaf(lin, 4.0f, 4.0f);
}
DI f32x2 swiglu4_2(f32x2 hg, f32x2 hl) {
    f32x2 glu, lin, ex, sg;
    glu[0] = fminf(hg[0], 7.0f); glu[1] = fminf(hg[1], 7.0f); lin[0] = __builtin_amdgcn_fmed3f(hl[0], -7.0f, 7.0f); lin[1] = __builtin_amdgcn_fmed3f(hl[1], -7.0f, 7.0f);
    const f32x2 t = glu * (-1.702f * 1.4426950408889634f);
    ex[0] = __builtin_amdgcn_exp2f(t[0]); ex[1] = __builtin_amdgcn_exp2f(t[1]);
    const f32x2 den = ex + 1.0f;
    sg[0] = __builtin_amdgcn_rcpf(den[0]); sg[1] = __builtin_amdgcn_rcpf(den[1]);
    return (glu * sg) * (lin * 4.0f + 4.0f);
}
DI unsigned pk4_fp8n(float a, float b, float c, float d) { int v = __builtin_amdgcn_cvt_pk_fp8_f32(a, b, 0, false); v = __builtin_amdgcn_cvt_pk_fp8_f32(c, d, v, true); return (unsigned)v; }
DI u32x4 pair16(u32x2 a, u32x2 b) {
    const auto r0 = __builtin_amdgcn_permlane16_swap(a.x, b.x, false, false); const auto r1 = __builtin_amdgcn_permlane16_swap(a.y, b.y, false, false);
    u32x4 w; w.x = r0[0]; w.y = r1[0]; w.z = r0[1]; w.w = r1[1]; return w; }
#define PG8_DMA4(gp, lp) __builtin_amdgcn_global_load_lds((const unsigned*)(gp), (LAS unsigned*)(lp), 4, 0, 0)
struct EpiUp {
    static constexpr bool PERM = true; static constexpr bool STASH = true;
    unsigned char* ACT; const float* b_up; const float* rows;
    DI void prefetch(const Unit& u, int wr, int wc, int lane, LAS unsigned char* st) const {
        const float* rp = rows + u.pm * BM + wr * 64 + lane;
        PG8_DMA4(rp, st); PG8_DMA4(rp + HALF, st + 256);
        PG8_DMA4(b_up + (size_t)u.e * UPW + 2 * (u.pn * HALF + wc * 32) + lane, st + 512);
    }
    DI void operator()(const f32x4 (&acc)[2][2][4][2], const Unit& u, int wr, int wc, int fr, int fq, const LAS unsigned char* st) const {
        const int row0 = u.pm * BM + wr * 64 + fr, f0 = u.pn * HALF + wc * 32 + 8 * fq;
        f32x2 bg[4], bl[4];
        { const LAS float* sb = (const LAS float*)(st + 512 + fq * 64);
#pragma unroll
          for (int p = 0; p < 4; ++p) { bg[p][0] = sb[4 * p]; bg[p][1] = sb[4 * p + 2]; bl[p][0] = sb[4 * p + 1]; bl[p][1] = sb[4 * p + 3]; } }
#pragma unroll
        for (int ai = 0; ai < 2; ++ai)
#pragma unroll
            for (int mp = 0; mp < 2; ++mp) {
                u32x2 w2[2];
#pragma unroll
                for (int mm = 0; mm < 2; ++mm) { const int m = 2 * mp + mm; const float ws = *(const LAS float*)(st + ai * 256 + (m * 16 + fr) * 4) * (1.0f / 32.0f);
                    const f32x4 g0 = acc[ai][0][m][0], g1 = acc[ai][0][m][1], l0 = acc[ai][1][m][0], l1 = acc[ai][1][m][1];
                    f32x2 ws2; ws2[0] = ws; ws2[1] = ws;
                    const f32x2 a01 = swiglu4_2(__builtin_shufflevector(g0, g0, 0, 1) * ws2 + bg[0], __builtin_shufflevector(l0, l0, 0, 1) * ws2 + bl[0]);
                    const f32x2 a23 = swiglu4_2(__builtin_shufflevector(g0, g0, 2, 3) * ws2 + bg[1], __builtin_shufflevector(l0, l0, 2, 3) * ws2 + bl[1]);
                    const f32x2 a45 = swiglu4_2(__builtin_shufflevector(g1, g1, 0, 1) * ws2 + bg[2], __builtin_shufflevector(l1, l1, 0, 1) * ws2 + bl[2]);
                    const f32x2 a67 = swiglu4_2(__builtin_shufflevector(g1, g1, 2, 3) * ws2 + bg[3], __builtin_shufflevector(l1, l1, 2, 3) * ws2 + bl[3]);
                    w2[mm].x = pk4_fp8n(a01[0], a01[1], a23[0], a23[1]); w2[mm].y = pk4_fp8n(a45[0], a45[1], a67[0], a67[1]); }
                const u32x4 w = pair16(w2[0], w2[1]);
                *(u32x4*)(ACT + (size_t)(row0 + ai * HALF + (2 * mp + (fq & 1)) * 16) * FF + (f0 - 8 * (fq & 1))) = w; }
    }
};
struct EpiDown {
    static constexpr bool PERM = true; static constexpr bool STASH = true;
    unsigned char* YB; const float* b_down; const float* roww;
    DI void prefetch(const Unit& u, int wr, int wc, int lane, LAS unsigned char* st) const {
        const float* rp = roww + u.pm * BM + wr * 64 + lane;
        PG8_DMA4(rp, st); PG8_DMA4(rp + HALF, st + 256);
        PG8_DMA4(b_down + (size_t)u.e * DM + u.pn * BM + (lane >> 5) * HALF + wc * 32 + (lane & 31), st + 512);
    }
    DI void operator()(const f32x4 (&acc)[2][2][4][2], const Unit& u, int wr, int wc, int fr, int fq, const LAS unsigned char* st) const {
        const int row0 = u.pm * BM + wr * 64 + fr, col0 = u.pn * BM + wc * 32 + 8 * fq;
        f32x4 bv[2][2];
#pragma unroll
        for (int bj = 0; bj < 2; ++bj)
#pragma unroll
            for (int n = 0; n < 2; ++n) bv[bj][n] = *(const LAS f32x4*)(st + 512 + bj * 128 + fq * 32 + 16 * n);
#pragma unroll
        for (int ai = 0; ai < 2; ++ai)
#pragma unroll
            for (int mp = 0; mp < 2; ++mp) {
                const float wA = *(const LAS float*)(st + ai * 256 + ((2 * mp) * 16 + fr) * 4) * 16.0f, wB = *(const LAS float*)(st + ai * 256 + ((2 * mp + 1) * 16 + fr) * 4) * 16.0f;
                unsigned char* rowp = YB + (size_t)(row0 + ai * HALF + (2 * mp + (fq & 1)) * 16) * DM + (col0 - 8 * (fq & 1));
#pragma unroll
                for (int bj = 0; bj < 2; ++bj) { u32x2 w2[2];
#pragma unroll
                    for (int mm = 0; mm < 2; ++mm) { const int m = 2 * mp + mm; const float w8 = mm ? wB : wA;
                        const f32x4 v0 = (acc[ai][bj][m][0] * (1.0f / 128.0f) + bv[bj][0]) * w8, v1 = (acc[ai][bj][m][1] * (1.0f / 128.0f) + bv[bj][1]) * w8;
                        w2[mm].x = pk4_fp8m(v0[0], v0[1], v0[2], v0[3]); w2[mm].y = pk4_fp8m(v1[0], v1[1], v1[2], v1[3]); }
                    *(u32x4*)(rowp + bj * HALF) = pair16(w2[0], w2[1]); } }
    }
};
#undef PG8_DMA4
}

template <int MODE  >
DI void p0_tr_item(const float* W, int ld, bf16* WT, int K, int k0, int n0, LAS unsigned char* img, int lane) {
    const float* wp = W + (size_t)(k0 + (lane >> 5)) * ld + n0 + 4 * (lane & 31);
    const int ioff = img_off(lane >> 5, (lane & 31) >> 1) + (lane & 1) * 8;
#pragma unroll 1
    for (int bt = 0; bt < 4; ++bt) {
        f32x4 v[8];
#pragma unroll
        for (int i = 0; i < 8; ++i) v[i] = *(const f32x4*)(wp + (size_t)(2 * (8 * bt + i)) * ld);
#pragma unroll
        for (int i = 0; i < 8; ++i) { const int kk = 2 * (8 * bt + i) + (lane >> 5), n = 4 * (lane & 31);
            u32x2 pk; pk.x = cvtpk(v[i][0], v[i][1]); pk.y = cvtpk(v[i][2], v[i][3]);
            *(LAS u32x2*)(img + img_off(kk, n >> 3) + (n & 7) * 2) = pk; }
    }
    (void)ioff;
    LDS_WAIT();
    const int g = lane >> 4, i16 = lane & 15, q = i16 >> 2, p = i16 & 3;
#pragma unroll 4
    for (int step = 0; step < 16; ++step) { const int kc = 4 * (step & 1) + g, nb = step >> 1;
        const bf16x8 f = tr_frag(img, 8 * kc, 8 * kc + 4, 2 * nb, q, p);
        const int n = n0 + 16 * nb + i16; int row = n;
        if (MODE == 1) { const int ff = n >> 1; row = 256 * (ff >> 7) + 128 * (n & 1) + (ff & 127); }
        *(bf16x8*)(WT + (size_t)row * K + k0 + 8 * kc) = f; }
    LDS_WAIT();
}
DI float log_sigmoid(float x) { return fminf(x, 0.f) - log1pf(__expf(-fabsf(x))); }
DI void p0_prologue(Frame& F) {
    const int gw = F.vcu * NWAVES + F.wave, NGW = F.G * NWAVES;
    LAS float* lg = (LAS float*)F.lds;
    { float gvv[32];
#pragma unroll
      for (int i = 0; i < 32; ++i) { const int idx = F.tid + NTHR * i; gvv[i] = F.w_in[(size_t)(idx >> 3) * INW + NPROJ + (idx & 7)]; }
#pragma unroll
      for (int i = 0; i < 32; ++i) { const int idx = F.tid + NTHR * i; lg[(idx & 7) * DM + (idx >> 3)] = gvv[i]; } }
    __syncthreads();
    bf16* XN = (bf16*)(F.ws + WS_XN); float* GATES = (float*)(F.ws + WS_GATES);
#define P0_XLOAD(dst, row_) do { const f32x4* xr_ = (const f32x4*)(F.x + (size_t)(row_) * DM) + F.lane; _Pragma("unroll") for (int j = 0; j < 8; ++j) dst[j] = xr_[64 * j]; } while (0)
#define P0_XROW(v, row_) do { float ss = 0.f; \
        _Pragma("unroll") for (int j = 0; j < 8; ++j) ss += (v[j][0] * v[j][0] + v[j][1] * v[j][1]) + (v[j][2] * v[j][2] + v[j][3] * v[j][3]); \
        const float rstd = 1.0f / sqrtf(wave_sum(ss) * (1.f / DM) + EPS); \
        float ga[8]; _Pragma("unroll") for (int c = 0; c < 8; ++c) ga[c] = 0.f; \
        u32x2* o8 = (u32x2*)(XN + (size_t)(row_) * DM) + F.lane; \
        _Pragma("unroll") for (int j = 0; j < 8; ++j) { const f32x4 hh = v[j] * rstd * gnr[j]; \
            u32x2 pk; pk.x = cvtpk(hh[0], hh[1]); pk.y = cvtpk(hh[2], hh[3]); o8[64 * j] = pk; \
            _Pragma("unroll") for (int c = 0; c < 8; ++c) { const f32x4 w = *(const LAS f32x4*)(lg + c * DM + 4 * F.lane + 256 * j); ga[c] += (hh[0] * w[0] + hh[1] * w[1]) + (hh[2] * w[2] + hh[3] * w[3]); } \
            __builtin_amdgcn_sched_barrier(0); } \
        _Pragma("unroll") for (int c = 0; c < 8; ++c) ga[c] = wave_sum(ga[c]); \
        if (F.lane < 8) { float gv = ga[0]; \
            _Pragma("unroll") for (int c = 1; c < 8; ++c) gv = (F.lane == c) ? ga[c] : gv; \
            gv += gbias; \
            GATES[(size_t)(row_) * 8 + F.lane] = gv; } } while (0)
    { f32x4 va[8], vb[8], gnr[8];
#pragma unroll
      for (int j = 0; j < 8; ++j) gnr[j] = ((const f32x4*)F.attn_g)[F.lane + 64 * j];
      const float gbias = (F.lane < 4) ? F.i_b[F.lane & 3] : F.f_b[(F.lane - 4) & 3];
      int row = gw;
      if (row < NTOK) P0_XLOAD(va, row);
#pragma unroll 1
      for (; row < NTOK; row += 2 * NGW) {
          const int row1 = row + NGW, row2 = row + 2 * NGW;
          P0_XLOAD(vb, (row1 < NTOK ? row1 : NTOK - 1));
          __builtin_amdgcn_sched_barrier(0);
          P0_XROW(va, row);
          P0_XLOAD(va, (row2 < NTOK ? row2 : NTOK - 1));
          __builtin_amdgcn_sched_barrier(0);
          if (row1 < NTOK) P0_XROW(vb, row1);
      } }
#undef P0_XLOAD
#undef P0_XROW
    __syncthreads();
    { bf16* RH = (bf16*)(F.ws + WS_RWT); bf16* RL = RH + NE * DM;
      for (int idx = F.vcu * NTHR + F.tid; idx < NE * DM; idx += F.G * NTHR) { const int e = idx & 31, k = idx >> 5; const float w = F.router_w[idx] * F.ffn_g[k];
          const unsigned hi = cvtpk(w, 0.f) & 0xffffu; const float rem = w - __uint_as_float(hi << 16);
          const int off = (((((k >> 6) * 2 + ((k >> 5) & 1)) * 2 + (e >> 4)) * 64) + 16 * ((k >> 3) & 3) + (e & 15)) * 8 + (k & 7);
          RH[off] = (bf16)hi; RL[off] = (bf16)(cvtpk(rem, 0.f) & 0xffffu); } }
    { float* TAB = (float*)(F.ws + WS_SMALL + SM_ROPE);
      for (int idx = F.vcu * NTHR + F.tid; idx < SEQ * 16; idx += F.G * NTHR) { const int pos = idx >> 4, i = idx & 15;
          const float inv = exp2f(-(float)i * (2.0f / 32.0f) * 18.931568569324174f); const float ang = (float)pos * inv; const float nrev = rintf(ang * 0.15915494309189535f);
          const float rr = (float)__builtin_fma(-(double)nrev, 6.283185307179586476925, (double)ang);
          TAB[pos * 32 + i] = cosf(rr); TAB[pos * 32 + 16 + i] = sinf(rr); } }
    LAS unsigned char* img = F.lds + F.wave * 16384;
    constexpr int I_IN = 32 * 48, I_OUT = 32 * 16, NITEMS = I_IN + I_OUT;
    for (int it = gw; it < NITEMS; it += NGW) {
        int r = it;
        if (r < I_IN) { const int kb = r / 48, nb = r % 48; p0_tr_item<0>(F.w_in, INW, (bf16*)(F.ws + WS_WIN), DM, 64 * kb, 128 * nb, img, F.lane); continue; } r -= I_IN;
        { const int kb = r / 16, nb = r % 16; p0_tr_item<0>(F.w_out, DM, (bf16*)(F.ws + WS_WOUT), DM, 64 * kb, 128 * nb, img, F.lane); }
    }
}
template <int MODE>
DI void p0_strip_fp8(const float* W, int ld, unsigned char* WT, int K, int n0, LAS unsigned char* img, int lane) {
    const float* wp = W + (size_t)(lane >> 5) * ld + n0 + 4 * (lane & 31);
    const int g = lane >> 4, i16 = lane & 15, q = i16 >> 2, p = i16 & 3;
    int wb[8];
#pragma unroll
    for (int i = 0; i < 8; ++i) { const int kk = 2 * i + (lane >> 5), n = 4 * (lane & 31); wb[i] = img_off(kk, n >> 3) + (n & 7) * 2; }
    int rb[4], cx[4];
#pragma unroll
    for (int t = 0; t < 4; ++t) { const int M = (q << 2) | t; rb[t] = 256 * (16 * g + 4 * t + q) + 16 * ((p >> 1) ^ (M & 1)) + 8 * (p & 1); cx[t] = M >> 1; }
    int orow[8];
#pragma unroll
    for (int nb = 0; nb < 8; ++nb) { const int n = n0 + 16 * nb + i16; int row = n; if (MODE == 1) { const int ff = n >> 1; row = 256 * (ff >> 7) + 128 * (n & 1) + (ff & 127); } orow[nb] = row * K + 16 * g; }
    f32x4 va[16], vb[16];
#define P0S_LOAD(dst, krow0) do { _Pragma("unroll") for (int i = 0; i < 16; ++i) dst[i] = *(const f32x4*)(wp + (size_t)((krow0) + 2 * i) * ld); } while (0)
#define P0S_PUT(src, r0) do { _Pragma("unroll") for (int i = 0; i < 16; ++i) { \
        u32x2 pk; pk.x = cvtpk(src[i][0], src[i][1]) + 0x02800280u; pk.y = cvtpk(src[i][2], src[i][3]) + 0x02800280u;        \
        *(LAS u32x2*)(img + wb[i & 7] + ((r0) / 16 + (i >> 3)) * 4096) = pk; } } while (0)
#define P0S_F8(lo, hi) pk4_fp8m(__uint_as_float((lo) << 16), __uint_as_float((lo) & 0xffff0000u), __uint_as_float((hi) << 16), __uint_as_float((hi) & 0xffff0000u))
    P0S_LOAD(va, 0);
#pragma unroll 1
    for (int kb = 0; kb < 32; ++kb) {
        P0S_LOAD(vb, 64 * kb + 32);
        P0S_PUT(va, 0);
        if (kb < 31) P0S_LOAD(va, 64 * kb + 64);
        P0S_PUT(vb, 32);
        LDS_WAIT();
#pragma unroll 2
        for (int nb = 0; nb < 8; ++nb) {
            const s16x4 t0 = tr16(img + rb[0] + 32 * (nb ^ cx[0])), t1 = tr16(img + rb[1] + 32 * (nb ^ cx[1])), t2 = tr16(img + rb[2] + 32 * (nb ^ cx[2])), t3 = tr16(img + rb[3] + 32 * (nb ^ cx[3]));
            const u32x2 f0 = __builtin_bit_cast(u32x2, t0), f1 = __builtin_bit_cast(u32x2, t1), f2 = __builtin_bit_cast(u32x2, t2), f3 = __builtin_bit_cast(u32x2, t3);
            u32x4 o; o.x = P0S_F8(f0.x, f0.y); o.y = P0S_F8(f1.x, f1.y); o.z = P0S_F8(f2.x, f2.y); o.w = P0S_F8(f3.x, f3.y);
            *(u32x4*)(WT + (size_t)(unsigned)orow[nb] + 64 * kb) = o; }
        LDS_WAIT();
    }
#undef P0S_LOAD
#undef P0S_PUT
#undef P0S_F8
}
DI void p0_expert_weights(Frame& F, int wk, int nwk) {
    LAS unsigned char* img = F.lds + F.wave * 16384;
    constexpr int C_UP = NE * 32, C_DN = NE * 16, NCH = C_UP + C_DN;
    for (int cx = wk * NWAVES + F.wave; cx < NCH; cx += nwk * NWAVES) {
        if (cx < C_UP) { const int e = cx >> 5, nb = cx & 31; p0_strip_fp8<1>(F.w_up + (size_t)e * DM * UPW, UPW, F.ws + WS_WUP + (size_t)e * UPW * DM, DM, 128 * nb, img, F.lane); }
        else { const int r = cx - C_UP, e = r >> 4, nb = r & 15; p0_strip_fp8<0>(F.w_down + (size_t)e * FF * DM, DM, F.ws + WS_WDN + (size_t)e * DM * FF, FF, 128 * nb, img, F.lane); }
    }
}

DI void p2_conv(Frame& F, int wk, int nwk) {
    bf16* PROJ = (bf16*)(F.ws + WS_PROJ);
    bf16* QC = (bf16*)(F.ws + WS_QC); bf16* KC = (bf16*)(F.ws + WS_KC);
    const int c8 = (F.tid & 127) * 8, tok0 = (wk * NTHR + F.tid) >> 7, tstr = (nwk * NTHR) >> 7;
    float cb[8], cw[4][8];
#pragma unroll
    for (int e = 0; e < 8; ++e) cb[e] = F.conv_b[c8 + e];
#pragma unroll
    for (int j = 0; j < 4; ++j)
#pragma unroll
        for (int e = 0; e < 8; ++e) cw[j][e] = F.conv_w[j * 1024 + c8 + e];
    const float sc = (c8 < 512) ? 1.0f : QSCALE;
#pragma unroll 1
    for (int tokb = tok0; tokb < NTOK; tokb += 4 * tstr) {
        u32x4 raw[4][4];
#pragma unroll
        for (int u = 0; u < 4; ++u) { int tok = tokb + u * tstr; tok = tok < NTOK ? tok : NTOK - 1; const int t = tok & (SEQ - 1);
#pragma unroll
            for (int j = 0; j < 4; ++j) { const int back = (t - 3 + j < 0) ? t : 3 - j;
                raw[u][j] = *(const u32x4*)(PROJ + (size_t)(tok - back) * NPROJ + COL_MQ + c8); } }
#pragma unroll
        for (int u = 0; u < 4; ++u) { const int tok = tokb + u * tstr; const int tc = tok < NTOK ? tok : NTOK - 1; const int t = tc & (SEQ - 1);
            float a[8];
#pragma unroll
            for (int e = 0; e < 8; ++e) a[e] = cb[e];
#pragma unroll
            for (int j = 0; j < 4; ++j) { const float on_ = (t - 3 + j < 0) ? 0.0f : 1.0f;
#pragma unroll
                for (int e = 0; e < 4; ++e) { a[2 * e] += __uint_as_float(raw[u][j][e] << 16) * (cw[j][2 * e] * on_); a[2 * e + 1] += __uint_as_float(raw[u][j][e] & 0xffff0000u) * (cw[j][2 * e + 1] * on_); } }
#pragma unroll
            for (int e = 0; e < 8; ++e) a[e] = a[e] * __builtin_amdgcn_rcpf(1.0f + __expf(-a[e])) * sc;
            u32x4 w; w.x = cvtpk(a[0], a[1]); w.y = cvtpk(a[2], a[3]); w.z = cvtpk(a[4], a[5]); w.w = cvtpk(a[6], a[7]);
            if (tok < NTOK) { if (c8 < 512) *(u32x4*)(QC + (size_t)tok * 512 + c8) = w; else *(u32x4*)(KC + (size_t)tok * 512 + (c8 - 512)) = w; } }
    }
}

template <int DIL, bool FIRST, bool LAST>
DI void attn_phase(Frame& F) {
    constexpr int BPR = 16 / DIL, PRE = 6, NTILE = 36;
    bf16* OST = (bf16*)(F.ws + WS_OST); float* ML = (float*)(F.ws + WS_ML); bf16* MIX = (bf16*)(F.ws + WS_MIX);
    const bf16* HMq = (const bf16*)(F.ws + WS_HM);
    const int lane = F.lane, r = lane & 31, h = lane >> 5, g = lane >> 4, i16 = lane & 15, q4 = i16 >> 2, p4 = i16 & 3;
    const int prow = 4 * F.wave + g, pch = i16 ^ ((g << 2) | (F.wave & 3));
    const unsigned pdst = (unsigned)F.wave * 1024u;
    int vB0[4], vB1[4];
#pragma unroll
    for (int db = 0; db < 4; ++db) { vB0[db] = tr_base(4 * h, 4 * db + 2 * (g & 1), q4, p4); vB1[db] = tr_base(8 + 4 * h, 4 * db + 2 * (g & 1), q4, p4); }
    const int kmask = ((r & 3) << 2) | ((r >> 2) & 3);
    __syncthreads();
    const int nun = (F.vcu < 256) ? (255 - F.vcu) / F.G + 1 : 0;
    if (nun > 0) {
#define ATT_DECODE(k_, b_, hd_, res_, ib_) do { const int u_ = F.vcu + (k_) * F.G; const int bh_ = u_ >> 4, uu_ = u_ & 15; b_ = bh_ >> 3; hd_ = bh_ & 7; res_ = uu_ / BPR; ib_ = (uu_ % BPR) * 1024; } while (0)
        int iu = 0, ij = 0, is = 0, ib_i; const bf16* kv_i;
        { int b_, hd_, res_; ATT_DECODE(0, b_, hd_, res_, ib_i); kv_i = HMq + HM_PLANE + ((size_t)(b_ * 8 + hd_) * SEQ + res_) * 128; }
#define ATT_DMA16(gp, la) asm volatile("s_mov_b32 m0, %1\n\tglobal_load_lds_dwordx4 %0, off" :: "v"(gp), "s"(la) : "memory", "m0")
#define ATT_ISSUE1() do { int ki_ = ib_i - 128 + 32 * ij + prow; ki_ = ki_ < 0 ? 0 : ki_; const bf16* src_ = kv_i + (size_t)ki_ * (DIL * 128) + 8 * pch; \
            const unsigned slot_ = __builtin_amdgcn_readfirstlane((unsigned)(unsigned long long)(F.lds + (is & 7) * 16384 + pdst)); ++is; \
            ATT_DMA16(src_, slot_); ATT_DMA16(src_ + HM_PLANE, slot_ + 8192u); \
            if (++ij == NTILE) { if (iu + 1 < nun) { ++iu; ij = 0; int b_, hd_, res_; ATT_DECODE(iu, b_, hd_, res_, ib_i); kv_i = HMq + HM_PLANE + ((size_t)(b_ * 8 + hd_) * SEQ + res_) * 128; } else ij = NTILE - 1; } } while (0)
        u32x4 qfr[8], on[8]; u32x2 mlx; mlx.x = 0u; mlx.y = 0u;
#define ATT_GLD16(dst, ptr, off) asm volatile("global_load_dwordx4 %0, %1, off offset:%2" : "=v"(dst) : "v"(ptr), "i"(off) : "memory")
#define ATT_PREFETCH(k_, qt_) do { int b_, hd_, res_, ib_; ATT_DECODE(k_, b_, hd_, res_, ib_); const size_t hr_ = (size_t)(b_ * 8 + hd_) * SEQ + (size_t)(ib_ + 32 * (qt_) + r) * DIL + res_; \
            const bf16* qp_ = HMq + hr_ * 128 + 8 * h; _Pragma("unroll") for (int kk = 0; kk < 8; ++kk) ATT_GLD16(qfr[kk], qp_, 32 * kk); \
            if (!FIRST) { const bf16* op_ = OST + hr_ * 128 + 8 * h; _Pragma("unroll") for (int db = 0; db < 4; ++db) _Pragma("unroll") for (int j2 = 0; j2 < 2; ++j2) ATT_GLD16(on[2 * db + j2], op_, 64 * db + 32 * j2); \
                const float* mlq_ = ML + hr_ * 2; asm volatile("global_load_dwordx2 %0, %1, off" : "=v"(mlx) : "v"(mlq_) : "memory"); } } while (0)
        ATT_PREFETCH(0, F.wave);
#pragma unroll
        for (int jt = 0; jt < PRE; ++jt) ATT_ISSUE1();
        int cs = 0;
        f32x16 o[4]; float m = -1e30f, l = 0.f;
#pragma unroll 1
        for (int k = 0; k < nun; ++k) {
            int b, hd, res, ibase; ATT_DECODE(k, b, hd, res, ibase);
#pragma unroll 1
            for (int j = 0; j < NTILE; ++j) {
                ATT_ISSUE1();
                const int dj = j - F.wave, mq = dj >> 3, kt = dj & 7, qt = F.wave + 8 * mq;
                const bool act = dj >= 0 && mq <= 3 && kt <= 4;
                const int i0 = ibase + 32 * qt;
                if (act && kt == 0) asm volatile("s_waitcnt vmcnt(8)" ::: "memory"); else asm volatile("s_waitcnt vmcnt(12)" ::: "memory");
                __builtin_amdgcn_s_barrier(); asm volatile("" ::: "memory");
                if (act) {
                    if (kt == 0) {
                        if (FIRST) {
#pragma unroll
                            for (int db = 0; db < 4; ++db)
#pragma unroll
                                for (int e = 0; e < 16; ++e) o[db][e] = 0.f;
                            m = -1e30f; l = 0.f;
                        } else {
#pragma unroll
                            for (int db = 0; db < 4; ++db)
#pragma unroll
                                for (int j2 = 0; j2 < 2; ++j2) { const u32x4 vv = on[2 * db + j2]; u32x2 va2[2]; va2[0].x = vv.x; va2[0].y = vv.y; va2[1].x = vv.z; va2[1].y = vv.w; swap32(va2[0], va2[1]);
#pragma unroll
                                    for (int q2 = 0; q2 < 2; ++q2) { const int g4 = 2 * j2 + q2; const u32x2 v = va2[q2];
                                        o[db][4 * g4] = __uint_as_float(v.x << 16); o[db][4 * g4 + 1] = __uint_as_float(v.x & 0xffff0000u); o[db][4 * g4 + 2] = __uint_as_float(v.y << 16); o[db][4 * g4 + 3] = __uint_as_float(v.y & 0xffff0000u); } }
                            m = __uint_as_float(mlx.x); l = __uint_as_float(mlx.y);
                        }
                    }
                    const LAS unsigned char* kimg = F.lds + (cs & 7) * 16384; const LAS unsigned char* vi = kimg + 8192;
                    f32x16 s;
#pragma unroll
                    for (int e = 0; e < 16; ++e) s[e] = 0.f;
                    const LAS unsigned char* krow = kimg + 256 * r;
                    bf16x8 ka[8];
#pragma unroll
                    for (int kk = 0; kk < 8; ++kk) ka[kk] = *(const LAS bf16x8*)(krow + 16 * ((2 * kk + h) ^ kmask));
                    __builtin_amdgcn_sched_barrier(0);
#pragma unroll
                    for (int kk = 0; kk < 8; ++kk) s = mfma32(ka[kk], __builtin_bit_cast(bf16x8, qfr[kk]), s);
                    bf16x8 va[2][4];
#pragma unroll
                    for (int s2 = 0; s2 < 2; ++s2)
#pragma unroll
                        for (int db = 0; db < 4; ++db) va[s2][db] = tr_frag2(vi, vB0[db], vB1[db], s2 * 4096);
                    __builtin_amdgcn_sched_barrier(0);
                    { const int kb = i0 - 128 + 32 * kt;
                      if (kt == 0 || kt == 4 || kb < 0) {
#pragma unroll
                        for (int e = 0; e < 16; ++e) { const int ce = crow(e, h); const bool bad = ((kb + ce) < 0) || (kt == 0 && ce < r) || (kt == 4 && ce > r); if (bad) s[e] = -1e30f; } } }
                    float mx = fmaxf(fmaxf(s[0], s[1]), s[2]);
#pragma unroll
                    for (int e = 3; e < 15; e += 2) mx = fmaxf(fmaxf(mx, s[e]), s[e + 1]);
                    mx = fmaxf(mx, s[15]);
                    mx = fmaxf(mx, __shfl_xor(mx, 32));
                    if (__any(mx > m + 8.0f)) { const float mn = fmaxf(m, mx), alpha = __builtin_amdgcn_exp2f(m - mn); l *= alpha; m = mn;
#pragma unroll
                        for (int db = 0; db < 4; ++db)
#pragma unroll
                            for (int e = 0; e < 16; ++e) o[db][e] *= alpha; }
                    float rs = 0.f;
#pragma unroll
                    for (int e = 0; e < 16; ++e) { s[e] = __builtin_amdgcn_exp2f(s[e] - m); rs += s[e]; }
                    rs += __shfl_xor(rs, 32); l += rs;
                    bf16x8 pb[2];
#pragma unroll
                    for (int s2 = 0; s2 < 2; ++s2) { u32x4 w; w.x = cvtpk(s[8 * s2], s[8 * s2 + 1]); w.y = cvtpk(s[8 * s2 + 2], s[8 * s2 + 3]); w.z = cvtpk(s[8 * s2 + 4], s[8 * s2 + 5]); w.w = cvtpk(s[8 * s2 + 6], s[8 * s2 + 7]);
                        pb[s2] = __builtin_bit_cast(bf16x8, w); }
#pragma unroll
                    for (int s2 = 0; s2 < 2; ++s2) {
#pragma unroll
                        for (int db = 0; db < 4; ++db) o[db] = mfma32(va[s2][db], pb[s2], o[db]);
                    }
                    if (kt == 4) {
                        const size_t hrow = (size_t)(b * 8 + hd) * SEQ + (size_t)(i0 + r) * DIL + res;
                        if (LAST) {
                            const size_t rowq = (size_t)b * SEQ + (size_t)(i0 + r) * DIL + res;
                            const float il = 1.0f / l;
                            bf16* mp = MIX + rowq * DM + hd * 128 + 8 * h;
#pragma unroll
                            for (int db = 0; db < 4; ++db)
#pragma unroll
                                for (int j2 = 0; j2 < 2; ++j2) { u32x2 w2[2];
#pragma unroll
                                    for (int q2 = 0; q2 < 2; ++q2) { const int g4 = 2 * j2 + q2; w2[q2].x = cvtpk(o[db][4 * g4] * il, o[db][4 * g4 + 1] * il); w2[q2].y = cvtpk(o[db][4 * g4 + 2] * il, o[db][4 * g4 + 3] * il); }
                                    swap32(w2[0], w2[1]); u32x4 w; w.x = w2[0].x; w.y = w2[0].y; w.z = w2[1].x; w.w = w2[1].y;
                                    *(u32x4*)(mp + 32 * db + 16 * j2) = w; }
                        } else {
                            bf16* ostp = OST + hrow * 128 + 8 * h; float* mlp = ML + hrow * 2;
#pragma unroll
                            for (int db = 0; db < 4; ++db)
#pragma unroll
                                for (int j2 = 0; j2 < 2; ++j2) { u32x2 w2[2];
#pragma unroll
                                    for (int q2 = 0; q2 < 2; ++q2) { const int g4 = 2 * j2 + q2; w2[q2].x = cvtpk(o[db][4 * g4], o[db][4 * g4 + 1]); w2[q2].y = cvtpk(o[db][4 * g4 + 2], o[db][4 * g4 + 3]); }
                                    swap32(w2[0], w2[1]); u32x4 w; w.x = w2[0].x; w.y = w2[0].y; w.z = w2[1].x; w.w = w2[1].y;
                                    *(u32x4*)(ostp + 32 * db + 16 * j2) = w; }
                            if (h == 0) { f32x2 mlv; mlv[0] = m; mlv[1] = l; *(f32x2*)mlp = mlv; }
                        }
                        if (mq < 3) ATT_PREFETCH(k, qt + 8); else if (k + 1 < nun) ATT_PREFETCH(k + 1, F.wave);
                    }
                }
                ++cs;
                __builtin_amdgcn_sched_barrier(0);
            }
        }
#undef ATT_ISSUE1
#undef ATT_DMA16
#undef ATT_PREFETCH
#undef ATT_GLD16
#undef ATT_DECODE
        asm volatile("s_waitcnt vmcnt(0)" ::: "memory");
    }
    __syncthreads();
}

DI float scan_incl_sum(float v, int lane) {
#pragma unroll
    for (int o = 1; o < 64; o <<= 1) { const float t = __shfl_up(v, o); if (lane >= o) v += t; }
    return v;
}
DI float scan_incl_max(float v, int lane) {
#pragma unroll
    for (int o = 1; o < 64; o <<= 1) { const float t = __shfl_up(v, o); if (lane >= o) v = fmaxf(v, t); }
    return v;
}
template <bool SCALE>
DI void load_img128(LAS unsigned char* img, const bf16* src, size_t ldg, const LAS float* rs, int tid) {
#pragma unroll
    for (int it = 0; it < 4; ++it) { const int idx = tid + NTHR * it, row = idx >> 4, ch = idx & 15;
        u32x4 v = *(const u32x4*)(src + (size_t)row * ldg + 8 * ch);
        if (SCALE) { const float w = rs[row];
#pragma unroll
            for (int e = 0; e < 4; ++e) { const float lo = __uint_as_float(v[e] << 16) * w, hi = __uint_as_float(v[e] & 0xffff0000u) * w; v[e] = cvtpk(lo, hi); } }
        *(LAS u32x4*)(img + img_off(row, ch)) = v; }
}
DI void dma_img128(LAS unsigned char* img, const bf16* src, size_t ldg, int wave, int lane) {
    const int g = lane >> 4, i16 = lane & 15;
#pragma unroll
    for (int i = 0; i < 4; ++i) { const int row = (wave * 4 + i) * 4 + g; const int ch = i16 ^ ((g << 2) | i);
        __builtin_amdgcn_global_load_lds((const unsigned*)(src + (size_t)row * ldg + 8 * ch), (LAS unsigned*)(img + (wave * 4 + i) * 1024), 16, 0, 0); }
}
DI void mlstm_m1_unit(Frame& F, int u) {
    const int bh = u >> 7, c = u & 127, b = bh >> 2, hd = bh & 3;
    const int tok0 = b * SEQ + c * 128;
    const float* GATES = (const float*)(F.ws + WS_GATES);
    LAS float* mf = (LAS float*)(F.lds + MISC_OFF);
    LAS unsigned char* imgK = F.lds, *imgV0 = F.lds + 32768, *imgV1 = F.lds + 65536;
    const int lane = F.lane;
    const bf16* KC = (const bf16*)(F.ws + WS_KC); const bf16* PROJ = (const bf16*)(F.ws + WS_PROJ);
    dma_img128(imgV0, PROJ + (size_t)tok0 * NPROJ + COL_MV + hd * 256, NPROJ, F.wave, lane);
    dma_img128(imgV1, PROJ + (size_t)tok0 * NPROJ + COL_MV + hd * 256 + 128, NPROJ, F.wave, lane);
    asm volatile("" ::: "memory");
    u32x4 kreg[4];
#pragma unroll
    for (int it = 0; it < 4; ++it) { const int idx = F.tid + NTHR * it, row = idx >> 4, ch = idx & 15; kreg[it] = *(const u32x4*)(KC + (size_t)(tok0 + row) * 512 + hd * 128 + 8 * ch); }
    if (F.wave == 0) {
        const int s0 = 2 * lane;
        const float ig0 = GATES[(size_t)(tok0 + s0) * 8 + hd], fg0 = GATES[(size_t)(tok0 + s0) * 8 + 4 + hd];
        const float ig1 = GATES[(size_t)(tok0 + s0 + 1) * 8 + hd], fg1 = GATES[(size_t)(tok0 + s0 + 1) * 8 + 4 + hd];
        const float lf0 = log_sigmoid(fg0), lf1 = log_sigmoid(fg1);
        const float b1 = scan_incl_sum(lf0 + lf1, lane), b0 = b1 - lf1;
        const float gt = __shfl(b1, 63);
        const float a0 = gt - b0 + ig0, a1 = gt - b1 + ig1;
        const float ml = wave_max(fmaxf(a0, a1));
        mf[s0] = __expf(a0 - ml); mf[s0 + 1] = __expf(a1 - ml);
        if (lane == 0) { ((float*)(F.ws + WS_SMALL + SM_G))[u] = gt; ((float*)(F.ws + WS_SMALL + SM_MLOC))[u] = ml; }
    }
    asm volatile("s_waitcnt vmcnt(4)" ::: "memory");
    __syncthreads();
#pragma unroll
    for (int it = 0; it < 4; ++it) { const int idx = F.tid + NTHR * it, row = idx >> 4, ch = idx & 15; const float w = mf[row]; u32x4 v = kreg[it];
#pragma unroll
        for (int e = 0; e < 4; ++e) { const float lo = __uint_as_float(v[e] << 16) * w, hi = __uint_as_float(v[e] & 0xffff0000u) * w; v[e] = cvtpk(lo, hi); }
        *(LAS u32x4*)(imgK + img_off(row, ch)) = v; }
    __syncthreads();
    { const int dk = F.tid & 127, part = F.tid >> 7; float a = 0.f;
      for (int s = 32 * part; s < 32 * part + 32; ++s) a += bf2f(*(const LAS unsigned short*)(imgK + img_off(s, dk >> 3) + (dk & 7) * 2));
      mf[1024 + 128 * part + dk] = a; }
    const int mb = F.wave >> 1, nh = F.wave & 1, r = lane & 31, h = lane >> 5, g = lane >> 4, i16 = lane & 15, q4 = i16 >> 2, p4 = i16 & 3;
    LAS unsigned char* imgV = nh ? imgV1 : imgV0;
    f32x16 acc[4];
#pragma unroll
    for (int nb = 0; nb < 4; ++nb)
#pragma unroll
        for (int e = 0; e < 16; ++e) acc[nb][e] = 0.f;
    const int aA0 = tr_base(8 * h, 4 * mb + 2 * (g & 1), q4, p4), aA1 = tr_base(8 * h + 4, 4 * mb + 2 * (g & 1), q4, p4);
    int bB0[4], bB1[4];
#pragma unroll
    for (int nb = 0; nb < 4; ++nb) { bB0[nb] = tr_base(8 * h, 4 * nb + 2 * (g & 1), q4, p4); bB1[nb] = tr_base(8 * h + 4, 4 * nb + 2 * (g & 1), q4, p4); }
#pragma unroll
    for (int ks = 0; ks < 8; ++ks) {
        const bf16x8 a = tr_frag2(imgK, aA0, aA1, ks * 4096);
#pragma unroll
        for (int nb = 0; nb < 4; ++nb) { const bf16x8 bfr = tr_frag2(imgV, bB0[nb], bB1[nb], ks * 4096);
            acc[nb] = mfma32(a, bfr, acc[nb]); }
        __builtin_amdgcn_sched_barrier(0);
    }
    bf16* CL = (bf16*)(F.ws + WS_CLOC) + (size_t)u * 128 * 256;
    __syncthreads();
    if (F.tid < 128) ((float*)(F.ws + WS_SMALL + SM_NLOC))[(size_t)u * 128 + F.tid] = (mf[1024 + F.tid] + mf[1152 + F.tid]) + (mf[1280 + F.tid] + mf[1408 + F.tid]);
    { LAS unsigned char* stg = F.lds + (size_t)(32 * mb) * 528 + (128 * nh + r) * 2;
#pragma unroll
      for (int nb = 0; nb < 4; ++nb)
#pragma unroll
          for (int e = 0; e < 16; ++e) *(LAS unsigned short*)(stg + crow(e, h) * 528 + 64 * nb) = (unsigned short)(cvtpk(acc[nb][e], 0.f) & 0xffffu); }
    __syncthreads();
#pragma unroll
    for (int i = 0; i < 8; ++i) { const int p = F.tid + NTHR * i, row = p >> 5, ch = p & 31; *(u32x4*)(CL + (size_t)row * 256 + 8 * ch) = *(const LAS u32x4*)(F.lds + row * 528 + 16 * ch); }
    __syncthreads();
}
DI void mlstm_scan(Frame& F) {
    const float* Gv = (const float*)(F.ws + WS_SMALL + SM_G); const float* MLv = (const float*)(F.ws + WS_SMALL + SM_MLOC);
    float* MP = (float*)(F.ws + WS_SMALL + SM_MPREV); const float* NL = (const float*)(F.ws + WS_SMALL + SM_NLOC); float* NP = (float*)(F.ws + WS_SMALL + SM_NPREV);
    const bf16* CL = (const bf16*)(F.ws + WS_CLOC); bf16* CP = (bf16*)(F.ws + WS_CPREV);
    const int lane = F.lane;
    for (int t = F.vcu + F.G * F.wave; t < 512; t += F.G * NWAVES) {
        const int bh = t >> 6, dk = (t & 63) * 2 + (lane >> 5), dv = (lane & 31) * 8;
        const float g0 = Gv[bh * 128 + lane], g1 = Gv[bh * 128 + 64 + lane], l0 = MLv[bh * 128 + lane], l1 = MLv[bh * 128 + 64 + lane];
        const size_t e0 = (size_t)bh * 128 * 32768 + (size_t)dk * 256 + dv;
        float st[8];
#pragma unroll
        for (int e = 0; e < 8; ++e) st[e] = 0.f;
        float m = 0.f, ns = 0.f;
        u32x4 cla[16], clb[16]; float nla[16], nlb[16];
#define SC_LOAD(cl_, nl_, cb_) do { _Pragma("unroll") for (int i = 0; i < 16; ++i) cl_[i] = *(const u32x4*)(CL + e0 + (size_t)((cb_) + i) * 32768); \
            _Pragma("unroll") for (int i = 0; i < 16; ++i) nl_[i] = NL[(size_t)(bh * 128 + (cb_) + i) * 128 + dk]; } while (0)
#define SC_BATCH(cl_, nl_, cb_) do { _Pragma("unroll") for (int i = 0; i < 16; ++i) { const int c = (cb_) + i; \
                const float gc = __uint_as_float(__builtin_amdgcn_readlane(__float_as_uint((cb_) < 64 ? g0 : g1), c & 63)), ml = __uint_as_float(__builtin_amdgcn_readlane(__float_as_uint((cb_) < 64 ? l0 : l1), c & 63)); \
                const float mn = fmaxf(gc + m, ml), dold = __expf(gc + m - mn), dnew = __expf(ml - mn); \
                u32x4 w; w.x = cvtpk(st[0], st[1]); w.y = cvtpk(st[2], st[3]); w.z = cvtpk(st[4], st[5]); w.w = cvtpk(st[6], st[7]); \
                *(u32x4*)(CP + e0 + (size_t)c * 32768) = w;                                          \
                _Pragma("unroll") for (int e = 0; e < 4; ++e) { st[2 * e] = dold * st[2 * e] + dnew * __uint_as_float(cl_[i][e] << 16); st[2 * e + 1] = dold * st[2 * e + 1] + dnew * __uint_as_float(cl_[i][e] & 0xffff0000u); } \
                if ((lane & 31) == 0) { const float nl = nl_[i]; NP[(size_t)(bh * 128 + c) * 128 + dk] = ns; ns = dold * ns + dnew * nl; } \
                if ((t & 63) == 0 && lane == 0) MP[bh * 128 + c] = m; \
                m = mn; } } while (0)
        SC_LOAD(cla, nla, 0);
#pragma unroll 1
        for (int cb = 0; cb < NCH; cb += 32) {
            SC_LOAD(clb, nlb, cb + 16);
            __builtin_amdgcn_sched_barrier(0);
            SC_BATCH(cla, nla, cb);
            { const int cn = cb + 32 < NCH ? cb + 32 : cb; SC_LOAD(cla, nla, cn); }
            __builtin_amdgcn_sched_barrier(0);
            SC_BATCH(clb, nlb, cb + 16);
        }
#undef SC_LOAD
#undef SC_BATCH
    }
}
DI void mlstm_m3_unit(Frame& F, int u) {
    const int bh = u >> 7, c = u & 127, b = bh >> 2, hd = bh & 3;
    const int tok0 = b * SEQ + c * 128;
    const float* GATES = (const float*)(F.ws + WS_GATES);
    LAS float* mf = (LAS float*)(F.lds + MISC_OFF);
    LAS unsigned char* imgV0 = F.lds, *imgV1 = F.lds + 32768, *imgC0 = F.lds + 65536, *imgC1 = F.lds + 98304, *imgK = F.lds + 65536;
    int lane_ = F.lane; asm volatile("" : "+v"(lane_));
    const int lane = lane_, tid_ = F.wave * 64 + lane, r = lane & 31, h = lane >> 5, g = lane >> 4, i16 = lane & 15, q4 = i16 >> 2, p4 = i16 & 3;
    const bf16* QC = (const bf16*)(F.ws + WS_QC); const bf16* KC = (const bf16*)(F.ws + WS_KC); const bf16* PROJ = (const bf16*)(F.ws + WS_PROJ);
    const bf16* CP = (const bf16*)(F.ws + WS_CPREV) + (size_t)u * 32768;
    dma_img128(imgV0, PROJ + (size_t)tok0 * NPROJ + COL_MV + hd * 256, NPROJ, F.wave, lane);
    dma_img128(imgV1, PROJ + (size_t)tok0 * NPROJ + COL_MV + hd * 256 + 128, NPROJ, F.wave, lane);
    dma_img128(imgC0, CP, 256, F.wave, lane);
    dma_img128(imgC1, CP + 128, 256, F.wave, lane);
    asm volatile("" ::: "memory");
    const int tb = F.wave & 3, dh = F.wave >> 2;
    const int tl = 32 * tb + r;
    bf16x8 qf[8];
    { const bf16* qp = QC + (size_t)(tok0 + tl) * 512 + hd * 128 + 8 * h;
#pragma unroll
      for (int kk = 0; kk < 8; ++kk) qf[kk] = *(const bf16x8*)(qp + 16 * kk); }
    u32x4 kreg[4];
#pragma unroll
    for (int it = 0; it < 4; ++it) { const int idx = tid_ + NTHR * it, row = idx >> 4, ch = idx & 15; kreg[it] = *(const u32x4*)(KC + (size_t)(tok0 + row) * 512 + hd * 128 + 8 * ch); }
    asm volatile("" ::: "memory");
    const float m_prev = ((const float*)(F.ws + WS_SMALL + SM_MPREV))[u];
    if (F.wave == 0) {
        const int s0 = 2 * lane;
        const float ig0 = GATES[(size_t)(tok0 + s0) * 8 + hd], fg0 = GATES[(size_t)(tok0 + s0) * 8 + 4 + hd];
        const float ig1 = GATES[(size_t)(tok0 + s0 + 1) * 8 + hd], fg1 = GATES[(size_t)(tok0 + s0 + 1) * 8 + 4 + hd];
        const float lf0 = log_sigmoid(fg0), lf1 = log_sigmoid(fg1);
        const float b1 = scan_incl_sum(lf0 + lf1, lane), b0 = b1 - lf1;
        const float u0 = ig0 - b0, u1 = ig1 - b1;
        const float im = scan_incl_max(fmaxf(u0, u1), lane);
        float ex = __shfl_up(im, 1); if (lane == 0) ex = -1e30f;
        const float cm0 = fmaxf(ex, u0), cm1 = im;
        const float M0 = fmaxf(m_prev, cm0), M1 = fmaxf(m_prev, cm1);
        mf[s0] = u0; mf[s0 + 1] = u1; mf[128 + s0] = M0; mf[128 + s0 + 1] = M1;
        mf[256 + s0] = __expf(m_prev - M0); mf[256 + s0 + 1] = __expf(m_prev - M1);
        mf[384 + s0] = __expf(-(b0 + M0)); mf[384 + s0 + 1] = __expf(-(b1 + M1));
    }
    if (F.wave == 1) { const float* NP = (const float*)(F.ws + WS_SMALL + SM_NPREV) + (size_t)u * 128; mf[512 + lane] = NP[lane]; mf[512 + 64 + lane] = NP[64 + lane]; }
    asm volatile("s_waitcnt vmcnt(4)" ::: "memory");
    __syncthreads();
    LAS unsigned char* imgC = dh ? imgC1 : imgC0; LAS unsigned char* imgV = dh ? imgV1 : imgV0;
    f32x16 acc[4];
#pragma unroll
    for (int nb = 0; nb < 4; ++nb)
#pragma unroll
        for (int e = 0; e < 16; ++e) acc[nb][e] = 0.f;
    int cB0[4], cB1[4];
#pragma unroll
    for (int nb = 0; nb < 4; ++nb) { cB0[nb] = tr_base(8 * h, 4 * nb + 2 * (g & 1), q4, p4); cB1[nb] = tr_base(8 * h + 4, 4 * nb + 2 * (g & 1), q4, p4); }
#pragma unroll
    for (int kk = 0; kk < 8; ++kk) {
#pragma unroll
        for (int nb = 0; nb < 4; ++nb) { const bf16x8 a = tr_frag2(imgC, cB0[nb], cB1[nb], kk * 4096);
            acc[nb] = mfma32(a, qf[kk], acc[nb]); }
        __builtin_amdgcn_sched_barrier(0);
    }
    const float wi = mf[256 + tl], Mt = mf[128 + tl], en = mf[384 + tl];
#pragma unroll
    for (int nb = 0; nb < 4; ++nb)
#pragma unroll
        for (int e = 0; e < 16; ++e) acc[nb][e] *= wi;
    float qn = 0.f;
#pragma unroll
    for (int kk = 0; kk < 8; ++kk) { const f32x4 n0 = *(const LAS f32x4*)(mf + 512 + 16 * kk + 8 * h), n1 = *(const LAS f32x4*)(mf + 512 + 16 * kk + 8 * h + 4);
        const u32x4 qq = __builtin_bit_cast(u32x4, qf[kk]);
        qn += __uint_as_float(qq[0] << 16) * n0[0] + __uint_as_float(qq[0] & 0xffff0000u) * n0[1] + __uint_as_float(qq[1] << 16) * n0[2] + __uint_as_float(qq[1] & 0xffff0000u) * n0[3];
        qn += __uint_as_float(qq[2] << 16) * n1[0] + __uint_as_float(qq[2] & 0xffff0000u) * n1[1] + __uint_as_float(qq[3] << 16) * n1[2] + __uint_as_float(qq[3] & 0xffff0000u) * n1[3]; }
    qn += __shfl_xor(qn, 32);
    __syncthreads();
#pragma unroll
    for (int it = 0; it < 4; ++it) { const int idx = tid_ + NTHR * it, row = idx >> 4, ch = idx & 15; *(LAS u32x4*)(imgK + img_off(row, ch)) = kreg[it]; }
    __syncthreads();
    u32x4 moreg[8];
    { const bf16* mop = PROJ + (size_t)(tok0 + tl) * NPROJ + COL_MO + hd * 256 + 128 * dh + 8 * h;
#pragma unroll
      for (int nb = 0; nb < 4; ++nb)
#pragma unroll
          for (int j2 = 0; j2 < 2; ++j2) moreg[2 * nb + j2] = *(const u32x4*)(mop + 32 * nb + 16 * j2); }
    float den = 0.f;
    int vB0[4], vB1[4];
#pragma unroll
    for (int nb = 0; nb < 4; ++nb) { vB0[nb] = tr_base(4 * h, 4 * nb + 2 * (g & 1), q4, p4); vB1[nb] = tr_base(8 + 4 * h, 4 * nb + 2 * (g & 1), q4, p4); }
    const int kmask = ((r & 3) << 2) | ((r >> 2) & 3);
#pragma unroll 1
    for (int sb = 0; sb <= tb; ++sb) {
        f32x16 s;
#pragma unroll
        for (int e = 0; e < 16; ++e) s[e] = 0.f;
        const LAS unsigned char* krow = imgK + 256 * (32 * sb + r);
#pragma unroll
        for (int kk = 0; kk < 8; ++kk) { const bf16x8 a = *(const LAS bf16x8*)(krow + 16 * ((2 * kk + h) ^ kmask)); s = mfma32(a, qf[kk], s); }
        __builtin_amdgcn_sched_barrier(0);
#pragma unroll
        for (int g4 = 0; g4 < 4; ++g4) { const f32x4 uu = *(const LAS f32x4*)(mf + 32 * sb + 8 * g4 + 4 * h);
#pragma unroll
            for (int j = 0; j < 4; ++j) { const int e = 4 * g4 + j; const int sl = 32 * sb + 8 * g4 + 4 * h + j;
                const float w = (sl <= tl) ? __expf(uu[j] - Mt) : 0.f; s[e] *= w; den += s[e]; } }
        bf16x8 pb[2];
#pragma unroll
        for (int s2 = 0; s2 < 2; ++s2) { u32x4 w; w.x = cvtpk(s[8 * s2], s[8 * s2 + 1]); w.y = cvtpk(s[8 * s2 + 2], s[8 * s2 + 3]); w.z = cvtpk(s[8 * s2 + 4], s[8 * s2 + 5]); w.w = cvtpk(s[8 * s2 + 6], s[8 * s2 + 7]);
            pb[s2] = __builtin_bit_cast(bf16x8, w); }
        const LAS unsigned char* vsb = imgV + 8192 * sb;
#pragma unroll
        for (int s2 = 0; s2 < 2; ++s2) {
#pragma unroll
            for (int nb = 0; nb < 4; ++nb) { const bf16x8 va = tr_frag2(vsb, vB0[nb], vB1[nb], s2 * 4096);
                acc[nb] = mfma32(va, pb[s2], acc[nb]); }
        }
        __builtin_amdgcn_sched_barrier(0);
    }
    f32x4 ggr[16];
    { const float* gq = F.mlout_g + hd * 256 + 128 * dh + 4 * h;
#pragma unroll
      for (int nb = 0; nb < 4; ++nb)
#pragma unroll
          for (int g4 = 0; g4 < 4; ++g4) ggr[4 * nb + g4] = *(const f32x4*)(gq + 32 * nb + 8 * g4); }
    den += __shfl_xor(den, 32);
    const float dt = wi * qn + den;
    const float inv = 1.0f / fmaxf(fabsf(dt), en);
    float ss = 0.f;
#pragma unroll
    for (int nb = 0; nb < 4; ++nb)
#pragma unroll
        for (int e = 0; e < 16; ++e) { acc[nb][e] *= inv; ss += acc[nb][e] * acc[nb][e]; }
    ss += __shfl_xor(ss, 32);
    if (h == 0) mf[640 + dh * 128 + tl] = ss;
    __syncthreads();
    const float rstd = 1.0f / sqrtf((mf[640 + tl] + mf[640 + 128 + tl]) * (1.f / 256.f) + EPS);
    const size_t tokr = (size_t)(tok0 + tl);
    const float* gp = F.mlout_g + hd * 256 + 128 * dh + 4 * h;
    bf16* outp = (bf16*)(F.ws + WS_MIX) + tokr * DM + 1024 + hd * 256 + 128 * dh + 8 * h;
#pragma unroll
    for (int nb = 0; nb < 4; ++nb)
#pragma unroll
        for (int j2 = 0; j2 < 2; ++j2) { const u32x4 mv = moreg[2 * nb + j2]; u32x2 mo2[2], w2[2]; mo2[0].x = mv.x; mo2[0].y = mv.y; mo2[1].x = mv.z; mo2[1].y = mv.w; swap32(mo2[0], mo2[1]);
#pragma unroll
            for (int q2 = 0; q2 < 2; ++q2) { const int g4 = 2 * j2 + q2; const u32x2 mo = mo2[q2]; const f32x4 gg = ggr[4 * nb + g4];
                const float z0 = __uint_as_float(mo.x << 16), z1 = __uint_as_float(mo.x & 0xffff0000u), z2 = __uint_as_float(mo.y << 16), z3 = __uint_as_float(mo.y & 0xffff0000u);
                const float y0 = acc[nb][4 * g4] * rstd * gg[0] * __builtin_amdgcn_rcpf(1.0f + __expf(-z0)), y1 = acc[nb][4 * g4 + 1] * rstd * gg[1] * __builtin_amdgcn_rcpf(1.0f + __expf(-z1));
                const float y2 = acc[nb][4 * g4 + 2] * rstd * gg[2] * __builtin_amdgcn_rcpf(1.0f + __expf(-z2)), y3 = acc[nb][4 * g4 + 3] * rstd * gg[3] * __builtin_amdgcn_rcpf(1.0f + __expf(-z3));
                w2[q2].x = cvtpk(y0, y1); w2[q2].y = cvtpk(y2, y3); }
            swap32(w2[0], w2[1]); u32x4 w; w.x = w2[0].x; w.y = w2[0].y; w.z = w2[1].x; w.w = w2[1].y;
            *(u32x4*)(outp + 32 * nb + 16 * j2) = w; }
    __syncthreads();
}

DI void p7_router(Frame& F) {
    const float* X1 = F.out; unsigned char* H2 = F.ws + WS_XN;
    const bf16* RH = (const bf16*)(F.ws + WS_RWT); const bf16* RL = RH + NE * DM;
    int* TOPI = (int*)(F.ws + WS_SMALL + SM_TOPI); float* TOPW = (float*)(F.ws + WS_SMALL + SM_TOPW); int* HIST = (int*)(F.ws + WS_CTL + CTL_HIST); float* RSTD = (float*)(F.ws + WS_SMALL + SM_RSTD);
    const int lane = F.lane, g4 = lane >> 4, c = lane & 15;
    LAS unsigned char* himg = F.lds + F.wave * 6144; LAS unsigned char* limg = himg + 2304;
    LAS float* lr = (LAS float*)(himg + 4608);
    LAS unsigned char* fimg = himg + 5120;
    LAS float* gl = (LAS float*)(F.lds + 49152);
    LAS unsigned char* wbuf = F.lds + 57344;
    __syncthreads();
    *(LAS f32x4*)(gl + 4 * F.tid) = *(const f32x4*)(F.ffn_g + 4 * F.tid);
    const char* rhb = (const char*)RH + F.tid * 16; const char* rlb = (const char*)RL + F.tid * 16;
#define P7_G16(gp, la) asm volatile("s_mov_b32 m0, %1\n\tglobal_load_lds_dwordx4 %0, off" :: "v"(gp), "s"(la) : "memory", "m0")
#define P7_DMA(s_) do { const unsigned d_ = __builtin_amdgcn_readfirstlane((unsigned)(unsigned long long)(wbuf + ((s_) & 1) * 32768 + F.wave * 1024)); const size_t so_ = (size_t)(s_) * 16384; \
        P7_G16(rhb + so_, d_); P7_G16(rhb + so_ + 8192, d_ + 8192u); P7_G16(rlb + so_, d_ + 16384u); P7_G16(rlb + so_ + 8192, d_ + 24576u); } while (0)
#define P7_LOADX(slot, ch_) do { xv[slot][0] = *(const f32x4*)(xp + 64 * (ch_)); xv[slot][1] = *(const f32x4*)(xp + 64 * (ch_) + 4 * DM); xv[slot][2] = *(const f32x4*)(xp + 64 * (ch_) + 8 * DM); xv[slot][3] = *(const f32x4*)(xp + 64 * (ch_) + 12 * DM); } while (0)
    for (int t0 = F.vcu * NWAVES; t0 < NTOK / 16; t0 += F.G * NWAVES) {
        const int tile = t0 + F.wave;
        const int tok0 = 16 * tile;
        f32x4 acc0 = {0.f, 0.f, 0.f, 0.f}, acc1 = {0.f, 0.f, 0.f, 0.f};
        float ss0 = 0.f, ss1 = 0.f, ss2 = 0.f, ss3 = 0.f;
        const float* xp = X1 + (size_t)(tok0 + g4) * DM + 4 * c;
        unsigned char* hp = H2 + (size_t)(tok0 + (lane >> 2)) * DM + 16 * (lane & 3);
        f32x4 xv[4][4];
        P7_DMA(0);
        P7_LOADX(0, 0); P7_LOADX(1, 1); P7_LOADX(2, 2);
#pragma unroll 2
        for (int sl = 0; sl < 8; ++sl) {
            asm volatile("s_waitcnt vmcnt(12) lgkmcnt(0)" ::: "memory");
            __builtin_amdgcn_s_barrier(); asm volatile("" ::: "memory");
            if (sl + 1 < 8) P7_DMA(sl + 1);
            const LAS unsigned char* wsl = wbuf + (sl & 1) * 32768 + lane * 16;
#pragma unroll
            for (int u = 0; u < 4; ++u) {
                const int ch = 4 * sl + u;
                { const int cn = (ch + 3 < 32) ? ch + 3 : 31; P7_LOADX((u + 3) & 3, cn); }
                __builtin_amdgcn_sched_barrier(0);
                const f32x4 gv = *(const LAS f32x4*)(gl + 64 * ch + 4 * c);
#define P7_ROW(v, i, ssacc) do { ssacc += (v[0] * v[0] + v[1] * v[1]) + (v[2] * v[2] + v[3] * v[3]); const f32x4 y = v * gv; \
                *(LAS unsigned*)(fimg + (4 * (i) + g4) * 64 + 4 * c) = pk4_fp8(y[0], y[1], y[2], y[3]); \
                u32x2 hi, lo; hi.x = cvtpk(v[0], v[1]); hi.y = cvtpk(v[2], v[3]); \
                lo.x = cvtpk(v[0] - __uint_as_float(hi.x << 16), v[1] - __uint_as_float(hi.x & 0xffff0000u)); lo.y = cvtpk(v[2] - __uint_as_float(hi.y << 16), v[3] - __uint_as_float(hi.y & 0xffff0000u)); \
                *(LAS u32x2*)(himg + (4 * (i) + g4) * 144 + 8 * c) = hi; *(LAS u32x2*)(limg + (4 * (i) + g4) * 144 + 8 * c) = lo; } while (0)
                P7_ROW(xv[u][0], 0, ss0); P7_ROW(xv[u][1], 1, ss1); P7_ROW(xv[u][2], 2, ss2); P7_ROW(xv[u][3], 3, ss3);
#undef P7_ROW
                *(u32x4*)(hp + 64 * ch) = *(const LAS u32x4*)(fimg + 16 * lane);
#pragma unroll
                for (int kk = 0; kk < 2; ++kk) {
                    const bf16x8 bh_ = *(const LAS bf16x8*)(himg + c * 144 + (32 * kk + 8 * g4) * 2), bl_ = *(const LAS bf16x8*)(limg + c * 144 + (32 * kk + 8 * g4) * 2);
                    const bf16x8 ah0 = *(const LAS bf16x8*)(wsl + u * 4096 + (kk * 2) * 1024), ah1 = *(const LAS bf16x8*)(wsl + u * 4096 + (kk * 2 + 1) * 1024);
                    const bf16x8 al0 = *(const LAS bf16x8*)(wsl + 16384 + u * 4096 + (kk * 2) * 1024), al1 = *(const LAS bf16x8*)(wsl + 16384 + u * 4096 + (kk * 2 + 1) * 1024);
                    acc0 = __builtin_amdgcn_mfma_f32_16x16x32_bf16(ah0, bh_, acc0, 0, 0, 0); acc0 = __builtin_amdgcn_mfma_f32_16x16x32_bf16(ah0, bl_, acc0, 0, 0, 0); acc0 = __builtin_amdgcn_mfma_f32_16x16x32_bf16(al0, bh_, acc0, 0, 0, 0);
                    acc1 = __builtin_amdgcn_mfma_f32_16x16x32_bf16(ah1, bh_, acc1, 0, 0, 0); acc1 = __builtin_amdgcn_mfma_f32_16x16x32_bf16(ah1, bl_, acc1, 0, 0, 0); acc1 = __builtin_amdgcn_mfma_f32_16x16x32_bf16(al1, bh_, acc1, 0, 0, 0);
                }
                __builtin_amdgcn_sched_barrier(0);
            }
        }
#undef P7_LOADX
#undef P7_DMA
#undef P7_G16
#define P7_RED(x) do { x += __shfl_xor(x, 1); x += __shfl_xor(x, 2); x += __shfl_xor(x, 4); x += __shfl_xor(x, 8); x = 1.0f / sqrtf(x * (1.f / DM) + EPS); } while (0)
        P7_RED(ss0); P7_RED(ss1); P7_RED(ss2); P7_RED(ss3);
#undef P7_RED
        if (c == 0) { lr[g4] = ss0; lr[4 + g4] = ss1; lr[8 + g4] = ss2; lr[12 + g4] = ss3;
            RSTD[tok0 + g4] = ss0; RSTD[tok0 + 4 + g4] = ss1; RSTD[tok0 + 8 + g4] = ss2; RSTD[tok0 + 12 + g4] = ss3; }
        const float rs = lr[c];
        float v[8];
#pragma unroll
        for (int j = 0; j < 4; ++j) { v[j] = acc0[j] * rs + F.router_b[4 * g4 + j]; v[4 + j] = acc1[j] * rs + F.router_b[16 + 4 * g4 + j]; }
        float sv[4]; int si[4];
#pragma unroll
        for (int k = 0; k < 4; ++k) {
            float bv = v[0]; int bi = 4 * g4;
#pragma unroll
            for (int j = 1; j < 8; ++j) { const int ce = (j < 4) ? (4 * g4 + j) : (16 + 4 * g4 + j - 4); if (v[j] > bv) { bv = v[j]; bi = ce; } }
            { const float ov = __shfl_xor(bv, 16); const int oi = __shfl_xor(bi, 16); if (ov > bv || (ov == bv && oi < bi)) { bv = ov; bi = oi; } }
            { const float ov = __shfl_xor(bv, 32); const int oi = __shfl_xor(bi, 32); if (ov > bv || (ov == bv && oi < bi)) { bv = ov; bi = oi; } }
            sv[k] = bv; si[k] = bi;
#pragma unroll
            for (int j = 0; j < 8; ++j) { const int ce = (j < 4) ? (4 * g4 + j) : (16 + 4 * g4 + j - 4); if (ce == bi) v[j] = -3.0e38f; }
        }
        const float e1 = __expf(sv[1] - sv[0]), e2 = __expf(sv[2] - sv[0]), e3 = __expf(sv[3] - sv[0]);
        const float isum = 1.0f / (1.0f + e1 + e2 + e3);
        const int tok = tok0 + c;
        if (g4 == 0) { *(int4*)(TOPI + (size_t)tok * 4) = make_int4(si[0], si[1], si[2], si[3]); *(f32x4*)(TOPW + (size_t)tok * 4) = (f32x4){isum, e1 * isum, e2 * isum, e3 * isum}; }
        int cnt = 0;
#pragma unroll 4
        for (int e = 0; e < 32; ++e) { const bool has = (g4 == 0) && (si[0] == e || si[1] == e || si[2] == e || si[3] == e);
            const unsigned long long bm = __ballot(has); if (lane == e) cnt = __popcll(bm); }
        if (lane < 32 && cnt > 0) atomicAdd(HIST + (tile >> 1) * 32 + lane, cnt);
    }
}

DI void p8_dispatch(Frame& F) {
    const int* TOPI = (const int*)(F.ws + WS_SMALL + SM_TOPI); const float* TOPW = (const float*)(F.ws + WS_SMALL + SM_TOPW); const int* HIST = (const int*)(F.ws + WS_CTL + CTL_HIST); const float* RSTD = (const float*)(F.ws + WS_SMALL + SM_RSTD); float* ROWS = (float*)(F.ws + WS_SMALL + SM_ROWS);
    int* POS = (int*)(F.ws + WS_SMALL + SM_POS); int* ROWTOK = (int*)(F.ws + WS_SMALL + SM_ROWTOK); float* ROWW = (float*)(F.ws + WS_SMALL + SM_ROWW); int* TILEE = (int*)(F.ws + WS_SMALL + SM_TILEE);
    LAS int* pre = (LAS int*)F.lds;
    LAS int* seg = (LAS int*)(F.lds + MISC_OFF);
    for (int i = F.tid; i < 1024 * 32; i += NTHR) pre[i] = HIST[i];
    __syncthreads();
    { const int e = F.tid & 31, sg = F.tid >> 5; int run = 0;
      for (int i = 0; i < 64; ++i) { const int idx = (sg * 64 + i) * 32 + e; const int v = pre[idx]; pre[idx] = run; run += v; }
      seg[sg * 32 + e] = run; }
    __syncthreads();
    { const int e = F.tid & 31, sg = F.tid >> 5; int base = 0;
      for (int j = 0; j < sg; ++j) base += seg[j * 32 + e];
      for (int i = 0; i < 64; ++i) pre[(sg * 64 + i) * 32 + e] += base;
      if (sg == 15) seg[512 + e] = base + seg[15 * 32 + e]; }
    __syncthreads();
    if (F.tid == 0) { int ps = 0; for (int e = 0; e < 32; ++e) { const int c = seg[512 + e], pc = (c + 255) & ~255; seg[544 + e] = ps; seg[576 + e] = pc; ps += pc; } seg[608] = ps >> 8; }
    __syncthreads();
    const int NT = seg[608];
    const int gw = F.vcu * NWAVES + F.wave, NGW = F.G * NWAVES, lane = F.lane;
    for (int tile = gw; tile < 1024; tile += NGW) {
        const int tok = 32 * tile + (lane & 31);
        const int4 ti = *(const int4*)(TOPI + (size_t)tok * 4); const f32x4 tw = *(const f32x4*)(TOPW + (size_t)tok * 4);
        const int ek = (lane < 32) ? ti.x : ti.y, ek2 = (lane < 32) ? ti.z : ti.w;
        int rk = 0, rk2 = 0;
        for (int e = 0; e < 32; ++e) { const bool has = (lane < 32) && (ti.x == e || ti.y == e || ti.z == e || ti.w == e);
            const unsigned long long bm = __ballot(has); const int below = __popcll(bm & ((1ull << (lane & 31)) - 1ull));
            if (ek == e) rk = below; if (ek2 == e) rk2 = below; }
        const int d1 = seg[544 + ek] + pre[tile * 32 + ek] + rk, d2 = seg[544 + ek2] + pre[tile * 32 + ek2] + rk2;
        const int k1 = (lane < 32) ? 0 : 1, k2 = k1 + 2;
        const float rsd = RSTD[tok];
        ROWTOK[d1] = tok; ROWW[d1] = (lane < 32) ? tw[0] : tw[1]; ROWS[d1] = rsd; POS[(size_t)tok * 4 + k1] = d1;
        ROWTOK[d2] = tok; ROWW[d2] = (lane < 32) ? tw[2] : tw[3]; ROWS[d2] = rsd; POS[(size_t)tok * 4 + k2] = d2;
    }
    if (F.vcu < 32) { const int e = F.vcu, c = seg[512 + e], ps = seg[544 + e], pc = seg[576 + e];
        for (int i = c + F.tid; i < pc; i += NTHR) { ROWTOK[ps + i] = 0; ROWW[ps + i] = 0.f; ROWS[ps + i] = 0.f; } }
    if (F.vcu == 32 % F.G) { for (int rt = F.tid; rt < MAXRT; rt += NTHR) { int e = 31; for (int j = 31; j >= 0; --j) if (rt * 256 < seg[544 + j] + seg[576 + j] && seg[576 + j] > 0 && rt * 256 >= seg[544 + j]) e = j; TILEE[rt] = e; }
        if (F.tid == 0) TILEE[MAXRT] = NT; }
    __syncthreads();
}

DI void p11_combine(Frame& F) {
    const int* POS = (const int*)(F.ws + WS_SMALL + SM_POS); const unsigned char* YB = F.ws + WS_YB;
    const int gw = F.vcu * NWAVES + F.wave, NGW = F.G * NWAVES;
    int4 ps = *(const int4*)(POS + (size_t)(gw < NTOK ? gw : 0) * 4);
#pragma unroll 1
    for (int tok = gw; tok < NTOK; tok += NGW) {
        const int tn = tok + NGW < NTOK ? tok + NGW : tok;
        const int4 psn = *(const int4*)(POS + (size_t)tn * 4);
        f32x4* orow = (f32x4*)(F.out + (size_t)tok * DM) + F.lane;
        const unsigned* y0 = (const unsigned*)(YB + (size_t)ps.x * DM) + F.lane; const unsigned* y1 = (const unsigned*)(YB + (size_t)ps.y * DM) + F.lane;
        const unsigned* y2 = (const unsigned*)(YB + (size_t)ps.z * DM) + F.lane; const unsigned* y3 = (const unsigned*)(YB + (size_t)ps.w * DM) + F.lane;
        f32x4 v[8]; unsigned qa[8], qb[8], qc[8], qd[8];
#pragma unroll
        for (int j = 0; j < 8; ++j) { v[j] = orow[64 * j]; qa[j] = y0[64 * j]; qb[j] = y1[64 * j]; qc[j] = y2[64 * j]; qd[j] = y3[64 * j]; }
        __builtin_amdgcn_sched_barrier(0);
#pragma unroll
        for (int j = 0; j < 8; ++j) { const unsigned a = qa[j], bq = qb[j], cq = qc[j], dq = qd[j];
            const f32x2 a0 = __builtin_amdgcn_cvt_pk_f32_fp8((int)a, false), a1 = __builtin_amdgcn_cvt_pk_f32_fp8((int)a, true), b0 = __builtin_amdgcn_cvt_pk_f32_fp8((int)bq, false), b1 = __builtin_amdgcn_cvt_pk_f32_fp8((int)bq, true);
            const f32x2 c0 = __builtin_amdgcn_cvt_pk_f32_fp8((int)cq, false), c1 = __builtin_amdgcn_cvt_pk_f32_fp8((int)cq, true), d0 = __builtin_amdgcn_cvt_pk_f32_fp8((int)dq, false), d1 = __builtin_amdgcn_cvt_pk_f32_fp8((int)dq, true);
            f32x4 vv = v[j];
            vv[0] += (((a0[0] + b0[0]) + c0[0]) + d0[0]) * 0.0625f; vv[1] += (((a0[1] + b0[1]) + c0[1]) + d0[1]) * 0.0625f;
            vv[2] += (((a1[0] + b1[0]) + c1[0]) + d1[0]) * 0.0625f; vv[3] += (((a1[1] + b1[1]) + c1[1]) + d1[1]) * 0.0625f; orow[64 * j] = vv; }
        ps = psn;
    }
}

constexpr int NPHASE = 12;
__global__ void __launch_bounds__(NTHR, 2) mk_fwd(Args args) {
    extern __shared__ __attribute__((aligned(16))) unsigned char lds_raw[];
    Frame F;
    F.lds = (LAS unsigned char*)lds_raw;
    F.tid = threadIdx.x; F.lane = F.tid & 63; F.wave = __builtin_amdgcn_readfirstlane(F.tid >> 6);
    F.G = gridDim.x; { const int bx = blockIdx.x; F.vcu = (F.G % 8 == 0) ? (bx % 8) * (F.G / 8) + bx / 8 : bx; }
    F.x = args.in[0]; F.attn_g = args.in[1]; F.w_in = args.in[2]; F.qg = args.in[3]; F.kg = args.in[4]; F.conv_w = args.in[5]; F.conv_b = args.in[6]; F.i_b = args.in[7]; F.f_b = args.in[8];
    F.mlout_g = args.in[9]; F.w_out = args.in[10]; F.ffn_g = args.in[11]; F.router_w = args.in[12]; F.router_b = args.in[13]; F.w_up = args.in[14]; F.b_up = args.in[15]; F.w_down = args.in[16]; F.b_down = args.in[17];
    F.out = args.out; F.ws = args.ws;
    volatile LAS unsigned* MISCW = (volatile LAS unsigned*)(F.lds + LDS_BYTES - 64);
    if (F.tid < 16) MISCW[F.tid] = 0u;
    __syncthreads();
    XcdBarrier bar; bar.bar = (unsigned*)(F.ws + WS_CTL) + CW_BAR; bar.x = 0; bar.st = nullptr;
    if (N_LAUNCHES == 1) bar = xcd_barrier_post((unsigned*)(F.ws + WS_CTL) + CW_BAR, MISCW);
    const int lo = args.ph_lo, hi = args.ph_hi;
#ifndef PHASE_MASK
#define PHASE_MASK 0xfff
#endif
#define IN(k) ((((PHASE_MASK) >> (k)) & 1) && lo <= (k) && (k) < hi)
#define SEAM(k) do { if (IN(k) && IN((k) + 1)) xcd_barrier(bar); } while (0)

    if (IN(0)) { p0_prologue(F); } SEAM(0);
    if (IN(1)) {
        const int NGEMM = (F.G == 256) ? 192 : F.G;
        if ((int)blockIdx.x < NGEMM) { pg8::Gemm g{(const bf16*)(F.ws + WS_XN), (const bf16*)(F.ws + WS_WIN), DM, 0, nullptr, nullptr, nullptr, nullptr}; pg8::StaticOrder S; S.init(NTOK / 256, NPROJ / 256, NGEMM, (int)blockIdx.x);
            pg8::EpiProj E{(bf16*)(F.ws + WS_PROJ), NPROJ, F.qg, F.kg, (const float*)(F.ws + WS_SMALL + SM_ROPE), (LAS float*)(F.lds + MISC_OFF), (bf16*)(F.ws + WS_HM)}; pg8::gemm_phase<pg8::EpiProj, false, false, false>(F.lds, g, S, E);
            { VM_WAIT(); __syncthreads();
              if (F.tid == 0) { unsigned* ctr = (unsigned*)(F.ws + WS_CTL) + CW_SUB; __builtin_amdgcn_fence(__ATOMIC_RELEASE, "agent"); VM_WAIT(); xb_add(ctr, 1u);
                  unsigned sp = 0; while (xb_ld(ctr) < (unsigned)NGEMM) { __builtin_amdgcn_s_sleep(2); if (++sp > (1u << 22)) break; }
                  __builtin_amdgcn_fence(__ATOMIC_ACQUIRE, "agent"); VM_WAIT(); }
              __syncthreads(); }
            p2_conv(F, (int)blockIdx.x, NGEMM); }
        if (F.G == 256) { if ((int)blockIdx.x >= NGEMM) p0_expert_weights(F, (int)blockIdx.x - NGEMM, F.G - NGEMM); }
        else p0_expert_weights(F, F.vcu, F.G);
    } SEAM(1);
    if (IN(3)) {
#ifndef SKIP_ML
        for (int u = F.vcu; u < 1024; u += F.G) mlstm_m1_unit(F, u);
#endif
#ifndef SKIP_ATTN
        attn_phase<1, true, false>(F);
#endif
    } SEAM(3);
    if (IN(4)) {
#ifndef SKIP_ML
        mlstm_scan(F);
#endif
#ifndef SKIP_ATTN
        attn_phase<4, false, false>(F);
#endif
    } SEAM(4);
    if (IN(5)) {
#ifndef SKIP_ML
        for (int u = F.vcu; u < 1024; u += F.G) mlstm_m3_unit(F, u);
#endif
#ifndef SKIP_ATTN
        attn_phase<16, false, true>(F);
#endif
    } SEAM(5);
    if (IN(6)) { pg8::Gemm g{(const bf16*)(F.ws + WS_MIX), (const bf16*)(F.ws + WS_WOUT), DM, 0, nullptr, nullptr, nullptr, nullptr}; pg8::StaticOrder S; S.init(NTOK / 256, DM / 256, F.G, (int)blockIdx.x);
        pg8::EpiResid E{F.x, F.out, DM}; pg8::gemm_phase<pg8::EpiResid, false, false, false>(F.lds, g, S, E); } SEAM(6);
    if (IN(7)) { p7_router(F); } SEAM(7);
    if (IN(8)) { p8_dispatch(F); } SEAM(8);
    if (IN(9) || IN(10)) {
        LAS int* te = (LAS int*)(F.lds + MISC_OFF);
        const int* TILEE = (const int*)(F.ws + WS_SMALL + SM_TILEE);
        __syncthreads();
        for (int i = F.tid; i <= MAXRT; i += NTHR) te[i] = (int)__hip_atomic_load(TILEE + i, __ATOMIC_RELAXED, __HIP_MEMORY_SCOPE_AGENT);
        __syncthreads();
        const int NT = te[MAXRT];
        if (IN(9)) { pg8::Gemm g{(const bf16*)(F.ws + WS_XN), (const bf16*)(F.ws + WS_WUP), DM / 2, (size_t)UPW * DM, (const int*)(F.ws + WS_SMALL + SM_ROWTOK), te, F.lds + MISC_OFF + 4096, F.lds + ESTASH_OFF};   pg8::StaticOrder S; S.init(NT, UPW / 256, F.G, (int)blockIdx.x);
            pg8::EpiUp E{F.ws + WS_ACT, F.b_up, (const float*)(F.ws + WS_SMALL + SM_ROWS)}; pg8::gemm_phase<pg8::EpiUp, true, true, true>(F.lds, g, S, E); }
        SEAM(9);
        if (IN(10)) { pg8::Gemm g{(const bf16*)(F.ws + WS_ACT), (const bf16*)(F.ws + WS_WDN), FF / 2, (size_t)DM * FF, nullptr, te, nullptr, F.lds + ESTASH_OFF}; pg8::StaticOrder S; S.init(NT, DM / 256, F.G, (int)blockIdx.x);
            pg8::EpiDown E{F.ws + WS_YB, F.b_down, (const float*)(F.ws + WS_SMALL + SM_ROWW)}; pg8::gemm_phase<pg8::EpiDown, false, true, true>(F.lds, g, S, E); }
    }
    SEAM(10);
    if (IN(11)) { p11_combine(F); }
#undef IN
#undef SEAM
}

extern "C" void kernel_launch(void* const* d_in, const int* in_sizes, int n_in, void* d_out, int out_size, void* d_ws, size_t ws_size, hipStream_t stream) {
    static int grid = 0;
    if (grid == 0) {
        if (n_in != 18 || out_size != NTOK * DM || ws_size < WS_END) { fprintf(stderr, "kernel_launch: unexpected shapes (n_in %d, out %d, ws %zu)\n", n_in, out_size, ws_size); grid = -1; return; }
        int dev = 0, cus = 0, per_cu = 0;
        if (hipGetDevice(&dev) != hipSuccess || hipDeviceGetAttribute(&cus, hipDeviceAttributeMultiprocessorCount, dev) != hipSuccess) { grid = -1; return; }
        if (hipFuncSetAttribute((const void*)mk_fwd, hipFuncAttributeMaxDynamicSharedMemorySize, LDS_BYTES) != hipSuccess) { fprintf(stderr, "kernel_launch: hipFuncSetAttribute failed\n"); grid = -1; return; }
        if (hipOccupancyMaxActiveBlocksPerMultiprocessor(&per_cu, (const void*)mk_fwd, NTHR, LDS_BYTES) != hipSuccess || per_cu < 1) fprintf(stderr, "kernel_launch: occupancy query says %d\n", per_cu);
        (void)hipGetLastError();
        grid = cus;
    }
    if (grid < 0) return;
    (void)hipMemsetAsync((char*)d_ws + WS_CTL, 0, CTL_ZERO_BYTES, stream);
    Args a{};
    for (int i = 0; i < 18; ++i) a.in[i] = (const float*)d_in[i];
    a.out = (float*)d_out; a.ws = (unsigned char*)d_ws;
    if (N_LAUNCHES == 1) { a.ph_lo = 0; a.ph_hi = PH_STOP; hipLaunchKernelGGL(mk_fwd, dim3(grid), dim3(NTHR), LDS_BYTES, stream, a); }
    else { for (int ph = 0; ph < PH_STOP; ++ph) { a.ph_lo = ph; a.ph_hi = ph + 1; hipLaunchKernelGGL(mk_fwd, dim3(grid), dim3(NTHR), LDS_BYTES, stream, a); } }
}
```
